# Optimizing an MI355X kernel written in HIP

```python
import math
import jax, jax.numpy as jnp
from jax import lax
import numpy as np

D_MODEL = 1024
BATCH = 4
SEQ = 4096
DEPTH = 2
DEC_BATCH = 128
DEC_SEQ = 4
PAST_LEN = 2048
PAGE_SIZE = 128

CONV_W = D_MODEL // 4
POOL_W = D_MODEL // 4
N_HEADS = 8
HEAD_DIM = (D_MODEL - CONV_W - POOL_W) // N_HEADS
NSA_W = N_HEADS * HEAD_DIM
KV_HEADS = 2
GQA_GROUP = N_HEADS // KV_HEADS
KV_W = KV_HEADS * HEAD_DIM
CONV_WIDTH = 31
CONV_BUF = CONV_WIDTH - 1
POOL_WINDOWS = (2, 4, 8, 16)
POOL_GROUP_W = POOL_W // len(POOL_WINDOWS)
POOL_BUF = max(POOL_WINDOWS) - 1
CMP_STRIDE = 16
CMP_BLOCK = 2 * CMP_STRIDE
SLC_BLOCK = 64
SLC_TOPK = 16
WINDOW = 512
Q_BLOCK = 128
NUM_BUCKETS = 32
MAX_DISTANCE = 128
D_FF = -(-(8 * D_MODEL) // (3 * 256)) * 256
EPS = 1e-6
NEG = -1e30
FORCE = 1e4

OFF_POOL = 2 * CONV_W
OFF_Q = OFF_POOL + POOL_W
OFF_KV = OFF_Q + NSA_W
OFF_GATE = OFF_KV + 6 * KV_W
IN_W = OFF_GATE + 3 * N_HEADS

kernel_name = 'hybrid_conv_pool_nsa_decoder_step'


def rmsnorm(x, g):
    xf = x.astype(jnp.float32)
    y = xf * lax.rsqrt(jnp.mean(xf * xf, axis=-1, keepdims=True) + EPS)
    return (y * g.astype(jnp.float32)).astype(x.dtype)


def layernorm(x, g, b):
    xf = x.astype(jnp.float32)
    mu = jnp.mean(xf, axis=-1, keepdims=True)
    xc = xf - mu
    var = jnp.mean(xc * xc, axis=-1, keepdims=True)
    return (xc * lax.rsqrt(var + EPS) * g.astype(jnp.float32) + b.astype(jnp.float32)).astype(x.dtype)


def t5_bucket(dist):
    n = jnp.maximum(dist, 0)
    max_exact = NUM_BUCKETS // 2
    nf = jnp.maximum(n, 1).astype(jnp.float32)
    large = max_exact + (jnp.log(nf / max_exact) / math.log(MAX_DISTANCE / max_exact)
                         * (NUM_BUCKETS - max_exact)).astype(jnp.int32)
    large = jnp.minimum(large, NUM_BUCKETS - 1)
    return jnp.where(n < max_exact, n, large)


def masked_softmax(s, mask):
    s = jnp.where(mask, s.astype(jnp.float32), NEG)
    p = jax.nn.softmax(s, axis=-1)
    return p * jnp.any(mask, axis=-1, keepdims=True)


def project(h, w_in):
    B, T, _ = h.shape
    z = h @ w_in
    glu = z[..., :CONV_W] * jax.nn.sigmoid(z[..., CONV_W:OFF_POOL])
    u = z[..., OFF_POOL:OFF_Q]
    q = z[..., OFF_Q:OFF_KV].reshape(B, T, KV_HEADS, GQA_GROUP, HEAD_DIM)
    kv = z[..., OFF_KV:OFF_GATE].reshape(B, T, 3, 2, KV_HEADS, HEAD_DIM)
    gates = jax.nn.sigmoid(z[..., OFF_GATE:]).reshape(B, T, 3, KV_HEADS, GQA_GROUP, 1)
    return glu, u, q, kv, gates


def conv_mix(glu_ext, dw, b, ln_g, ln_b):
    y = lax.conv_general_dilated(glu_ext, dw[:, None, :], window_strides=(1,), padding='VALID',
                                 dimension_numbers=('NWC', 'WIO', 'NWC'),
                                 feature_group_count=CONV_W)
    return jax.nn.silu(layernorm(y + b, ln_g, ln_b))


def pool_mix(u_ext, pos0, w_pool, scale):
    B, L, _ = u_ext.shape
    T = L - POOL_BUF
    cs = jnp.pad(jnp.cumsum(u_ext.astype(jnp.float32), axis=1), ((0, 0), (1, 0), (0, 0)))
    end = cs[:, POOL_BUF + 1:POOL_BUF + 1 + T]
    u = u_ext[:, POOL_BUF:].astype(jnp.float32)
    t = pos0 + jnp.arange(T, dtype=jnp.int32)
    diffs = []
    for g, w in enumerate(POOL_WINDOWS):
        sl = slice(g * POOL_GROUP_W, (g + 1) * POOL_GROUP_W)
        start = cs[:, POOL_BUF + 1 - w:POOL_BUF + 1 - w + T, sl]
        cnt = jnp.minimum(w, t + 1).astype(jnp.float32)[:, None]
        diffs.append((end[..., sl] - start) / cnt - u[..., sl])
    d = jnp.stack(diffs, axis=2)
    y = jnp.einsum('btgc,gce->btge', d, w_pool.astype(jnp.float32)).reshape(B, T, POOL_W)
    return (y * scale.astype(jnp.float32)).astype(u_ext.dtype)


def compress(k, pe, w):
    B, L = k.shape[:2]
    Lp = -(-L // CMP_STRIDE) * CMP_STRIDE
    k = jnp.pad(k, ((0, 0), (0, Lp - L), (0, 0), (0, 0)))
    sub = k.reshape(B, Lp // CMP_STRIDE, CMP_STRIDE, KV_HEADS, HEAD_DIM)
    blocks = jnp.concatenate([sub[:, :-1], sub[:, 1:]], axis=2)
    return jnp.einsum('bnlgd,lde->bnge', blocks + pe[:, None, :], w)


def to_blocks(k):
    B, L = k.shape[:2]
    Lp = -(-L // SLC_BLOCK) * SLC_BLOCK
    k = jnp.pad(k, ((0, 0), (0, Lp - L), (0, 0), (0, 0)))
    return k.reshape(B, Lp // SLC_BLOCK, SLC_BLOCK, KV_HEADS, HEAD_DIM).transpose(0, 3, 1, 2, 4)


def nsa_attend(q, q_pos, kc, vc, ks, vs, kw, vw, kw_pos, tbl):
    B, Q = q.shape[:2]
    scale = HEAD_DIM ** -0.5
    n_cmp, n_slc = kc.shape[1], ks.shape[2]
    c_end = jnp.arange(n_cmp, dtype=jnp.int32) * CMP_STRIDE + (CMP_BLOCK - 1)
    dist = q_pos[:, None] - c_end[None, :]
    s = jnp.einsum('bqgrd,bngd->bgrqn', q, kc).astype(jnp.float32) * scale + tbl[:, :, t5_bucket(dist)]
    p_cmp = masked_softmax(s, dist >= 0)
    o_cmp = jnp.einsum('bgrqn,bngd->bqgrd', p_cmp.astype(vc.dtype), vc)
    c_start = jnp.arange(n_cmp, dtype=jnp.int32) * CMP_STRIDE
    s_start = jnp.arange(n_slc, dtype=jnp.int32) * SLC_BLOCK
    overlap = ((c_start[:, None] < s_start[None, :] + SLC_BLOCK)
               & (c_start[:, None] + CMP_BLOCK > s_start[None, :])).astype(jnp.float32)
    p_slc = jnp.einsum('bgrqn,nj->bgqj', p_cmp, overlap)
    blk = jnp.arange(n_slc, dtype=jnp.int32)[None, :]
    cur = (q_pos // SLC_BLOCK)[:, None]
    forced = (blk == 0) | (blk == cur) | (blk == cur - 1)
    score = jnp.where(forced, FORCE, jnp.where(blk <= cur, p_slc, NEG))
    _, idx = lax.top_k(score, min(SLC_TOPK, n_slc))
    n_sel = idx.shape[-1]
    M = n_sel * SLC_BLOCK
    bi = jnp.arange(B)[:, None, None, None]
    gi = jnp.arange(KV_HEADS)[None, :, None, None]
    kg = ks[bi, gi, idx].reshape(B, KV_HEADS, Q, M, HEAD_DIM)
    vg = vs[bi, gi, idx].reshape(B, KV_HEADS, Q, M, HEAD_DIM)
    pos = (idx[..., None] * SLC_BLOCK + jnp.arange(SLC_BLOCK, dtype=jnp.int32)).reshape(B, KV_HEADS, Q, M)
    dist = q_pos[None, None, :, None] - pos
    bias = tbl[gi[..., None], jnp.arange(GQA_GROUP)[None, None, :, None, None], t5_bucket(dist)[:, :, None]]
    s = jnp.einsum('bqgrd,bgqmd->bgrqm', q, kg).astype(jnp.float32) * scale + bias
    p = masked_softmax(s, (dist >= 0)[:, :, None])
    o_slc = jnp.einsum('bgrqm,bgqmd->bqgrd', p.astype(vg.dtype), vg)
    dist = q_pos[:, None] - kw_pos[None, :]
    mask = (dist >= 0) & (dist < WINDOW) & (kw_pos[None, :] >= 0)
    s = jnp.einsum('bqgrd,bkgd->bgrqk', q, kw).astype(jnp.float32) * scale + tbl[:, :, t5_bucket(dist)]
    p = masked_softmax(s, mask)
    o_win = jnp.einsum('bgrqk,bkgd->bqgrd', p.astype(vw.dtype), vw)
    return o_cmp, o_slc, o_win


def gate_sum(gates, o_cmp, o_slc, o_win):
    return gates[:, :, 0] * o_cmp + gates[:, :, 1] * o_slc + gates[:, :, 2] * o_win


def nsa_prompt(q, kv, gates, pe_k, wk, pe_v, wv, tbl):
    B, T = q.shape[:2]
    kc = compress(kv[:, :, 0, 0], pe_k, wk)
    vc = compress(kv[:, :, 0, 1], pe_v, wv)
    ks = to_blocks(kv[:, :, 1, 0])
    vs = to_blocks(kv[:, :, 1, 1])
    pad = ((0, 0), (WINDOW, 0), (0, 0), (0, 0))
    kw = jnp.pad(kv[:, :, 2, 0], pad)
    vw = jnp.pad(kv[:, :, 2, 1], pad)

    def block(i):
        q0 = i * Q_BLOCK
        qb = lax.dynamic_slice_in_dim(q, q0, Q_BLOCK, axis=1)
        gb = lax.dynamic_slice_in_dim(gates, q0, Q_BLOCK, axis=1)
        kwb = lax.dynamic_slice_in_dim(kw, q0, WINDOW + Q_BLOCK, axis=1)
        vwb = lax.dynamic_slice_in_dim(vw, q0, WINDOW + Q_BLOCK, axis=1)
        q_pos = q0 + jnp.arange(Q_BLOCK, dtype=jnp.int32)
        kw_pos = q0 - WINDOW + jnp.arange(WINDOW + Q_BLOCK, dtype=jnp.int32)
        return gate_sum(gb, *nsa_attend(qb, q_pos, kc, vc, ks, vs, kwb, vwb, kw_pos, tbl))

    o = lax.map(block, jnp.arange(T // Q_BLOCK, dtype=jnp.int32))
    return jnp.moveaxis(o, 0, 1).reshape(B, T, NSA_W)


def nsa_sample(q, kv, gates, cmp_pages, slc_pages, win_buf, page_table, pe_k, wk, pe_v, wv, tbl):
    B, S = q.shape[:2]
    past = page_table.shape[1] * cmp_pages.shape[1]
    cmp_full = jnp.concatenate([cmp_pages[page_table].reshape(B, past, 2, KV_HEADS, HEAD_DIM), kv[:, :, 0]], axis=1)
    slc_full = jnp.concatenate([slc_pages[page_table].reshape(B, past, 2, KV_HEADS, HEAD_DIM), kv[:, :, 1]], axis=1)
    win = jnp.concatenate([win_buf, kv[:, :, 2]], axis=1)
    wb = win_buf.shape[1]
    kc = compress(cmp_full[:, :, 0], pe_k, wk)
    vc = compress(cmp_full[:, :, 1], pe_v, wv)
    ks = to_blocks(slc_full[:, :, 0])
    vs = to_blocks(slc_full[:, :, 1])
    q_pos = past + jnp.arange(S, dtype=jnp.int32)
    kw_pos = past - wb + jnp.arange(wb + S, dtype=jnp.int32)
    o = gate_sum(gates, *nsa_attend(q, q_pos, kc, vc, ks, vs, win[:, :, 0], win[:, :, 1], kw_pos, tbl))
    return o.reshape(B, S, NSA_W), win[:, S:]


def residual_update(x, conv_o, pool_o, nsa_o, w_out, g2, w_gu, w_down):
    x = x + jnp.concatenate([conv_o, pool_o, nsa_o], axis=-1) @ w_out
    gu = rmsnorm(x, g2) @ w_gu
    return x + (jax.nn.silu(gu[..., :D_FF]) * gu[..., D_FF:]) @ w_down


def setup_inputs(seed: int = 0) -> dict:
    key = jax.random.key(seed)
    k = jax.random.split(key, 26)
    f32 = jnp.float32

    def nrm(kk, shape, s):
        return jax.random.normal(kk, shape, f32) * s

    n_pages = PAST_LEN // PAGE_SIZE
    n_used = DEC_BATCH * n_pages
    n_phys = n_used + max(1, n_used // 4)
    win_len = min(WINDOW, PAST_LEN)
    page_table = jax.random.permutation(k[7], n_phys)[:n_used].reshape(DEC_BATCH, n_pages).astype(jnp.int32)
    return {
        'x_prompt': nrm(k[0], (BATCH, SEQ, D_MODEL), 1.0),
        'x_sample': nrm(k[1], (DEC_BATCH, DEC_SEQ, D_MODEL), 1.0),
        'cache_cmp_kv': nrm(k[2], (DEPTH, n_phys, PAGE_SIZE, 2, KV_HEADS, HEAD_DIM), 1.0),
        'cache_slc_kv': nrm(k[3], (DEPTH, n_phys, PAGE_SIZE, 2, KV_HEADS, HEAD_DIM), 1.0),
        'cache_win_kv': nrm(k[4], (DEPTH, DEC_BATCH, win_len, 2, KV_HEADS, HEAD_DIM), 1.0),
        'state_conv': nrm(k[5], (DEPTH, DEC_BATCH, CONV_BUF, CONV_W), 0.5),
        'state_pool': nrm(k[6], (DEPTH, DEC_BATCH, POOL_BUF, POOL_W), 1.0),
        'page_table': page_table,
        'rel_bias': nrm(k[8], (NUM_BUCKETS, N_HEADS), 0.5),
        'norm1': 1.0 + nrm(k[9], (DEPTH, D_MODEL), 0.02),
        'w_in': nrm(k[10], (DEPTH, D_MODEL, IN_W), D_MODEL ** -0.5),
        'conv_dw': nrm(k[11], (DEPTH, CONV_WIDTH, CONV_W), CONV_WIDTH ** -0.5),
        'conv_b': nrm(k[12], (DEPTH, CONV_W), 0.02),
        'conv_ln_g': 1.0 + nrm(k[13], (DEPTH, CONV_W), 0.02),
        'conv_ln_b': nrm(k[14], (DEPTH, CONV_W), 0.02),
        'pool_w': nrm(k[15], (DEPTH, len(POOL_WINDOWS), POOL_GROUP_W, POOL_GROUP_W), POOL_GROUP_W ** -0.5),
        'pool_scale': 1.0 + nrm(k[16], (DEPTH, POOL_W), 0.1),
        'cmp_pe_k': nrm(k[17], (DEPTH, CMP_BLOCK, HEAD_DIM), 0.02),
        'cmp_wk': nrm(k[18], (DEPTH, CMP_BLOCK, HEAD_DIM, HEAD_DIM), (CMP_BLOCK * HEAD_DIM) ** -0.5),
        'cmp_pe_v': nrm(k[19], (DEPTH, CMP_BLOCK, HEAD_DIM), 0.02),
        'cmp_wv': nrm(k[20], (DEPTH, CMP_BLOCK, HEAD_DIM, HEAD_DIM), (CMP_BLOCK * HEAD_DIM) ** -0.5),
        'w_out': nrm(k[21], (DEPTH, CONV_W + POOL_W + NSA_W, D_MODEL), D_MODEL ** -0.5),
        'norm2': 1.0 + nrm(k[22], (DEPTH, D_MODEL), 0.02),
        'w_gu': nrm(k[23], (DEPTH, D_MODEL, 2 * D_FF), D_MODEL ** -0.5),
        'w_down': nrm(k[24], (DEPTH, D_FF, D_MODEL), D_FF ** -0.5),
        'final_norm': 1.0 + nrm(k[25], (D_MODEL,), 0.02),
    }


def reference(x_prompt, x_sample, cache_cmp_kv, cache_slc_kv, cache_win_kv, state_conv, state_pool,
              page_table, rel_bias, norm1, w_in, conv_dw, conv_b, conv_ln_g, conv_ln_b, pool_w,
              pool_scale, cmp_pe_k, cmp_wk, cmp_pe_v, cmp_wv, w_out, norm2, w_gu, w_down, final_norm):
    tbl = rel_bias.reshape(NUM_BUCKETS, KV_HEADS, GQA_GROUP).transpose(1, 2, 0)
    T = x_prompt.shape[1]
    past = page_table.shape[1] * cache_cmp_kv.shape[2]
    xp, xs = x_prompt, x_sample
    p_cmp, p_slc, p_win, p_conv, p_pool = [], [], [], [], []
    s_cmp, s_slc, s_win, s_conv, s_pool = [], [], [], [], []
    for l in range(DEPTH):
        glu, u, q, kv, gates = project(rmsnorm(xp, norm1[l]), w_in[l])
        glu_ext = jnp.pad(glu, ((0, 0), (CONV_BUF, 0), (0, 0)))
        u_ext = jnp.pad(u, ((0, 0), (POOL_BUF, 0), (0, 0)))
        conv_o = conv_mix(glu_ext, conv_dw[l], conv_b[l], conv_ln_g[l], conv_ln_b[l])
        pool_o = pool_mix(u_ext, 0, pool_w[l], pool_scale[l])
        nsa_o = nsa_prompt(q, kv, gates, cmp_pe_k[l], cmp_wk[l], cmp_pe_v[l], cmp_wv[l], tbl)
        xp = residual_update(xp, conv_o, pool_o, nsa_o, w_out[l], norm2[l], w_gu[l], w_down[l])
        p_cmp.append(kv[:, :, 0])
        p_slc.append(kv[:, :, 1])
        p_win.append(kv[:, T - min(WINDOW, T):, 2])
        p_conv.append(glu_ext[:, -CONV_BUF:])
        p_pool.append(u_ext[:, -POOL_BUF:])
        glu, u, q, kv, gates = project(rmsnorm(xs, norm1[l]), w_in[l])
        glu_ext = jnp.concatenate([state_conv[l], glu], axis=1)
        u_ext = jnp.concatenate([state_pool[l], u], axis=1)
        conv_o = conv_mix(glu_ext, conv_dw[l], conv_b[l], conv_ln_g[l], conv_ln_b[l])
        pool_o = pool_mix(u_ext, past, pool_w[l], pool_scale[l])
        nsa_o, new_win = nsa_sample(q, kv, gates, cache_cmp_kv[l], cache_slc_kv[l], cache_win_kv[l],
                                    page_table, cmp_pe_k[l], cmp_wk[l], cmp_pe_v[l], cmp_wv[l], tbl)
        xs = residual_update(xs, conv_o, pool_o, nsa_o, w_out[l], norm2[l], w_gu[l], w_down[l])
        s_cmp.append(kv[:, :, 0])
        s_slc.append(kv[:, :, 1])
        s_win.append(new_win)
        s_conv.append(glu_ext[:, -CONV_BUF:])
        s_pool.append(u_ext[:, -POOL_BUF:])
    y_prompt = rmsnorm(xp, final_norm)
    y_sample = rmsnorm(xs, final_norm)
    return (y_prompt, y_sample,
            jnp.stack(p_cmp), jnp.stack(p_slc), jnp.stack(p_win), jnp.stack(p_conv), jnp.stack(p_pool),
            jnp.stack(s_cmp), jnp.stack(s_slc), jnp.stack(s_win), jnp.stack(s_conv), jnp.stack(s_pool))
```

```cpp
#include <hip/hip_runtime.h>
#include <stdint.h>
#include <stdio.h>

typedef unsigned short bf16_t;
#define DEV __device__ __forceinline__

constexpr int D_ = 1024, NB_ = 4, T_ = 4096, NL_ = 2, NREQ = 128, NS_ = 4, PAST_ = 2048, NPG = 16, NPHYS = 2560;
constexpr int MP = NB_ * T_, MS = NREQ * NS_, M_ = MP + MS;
constexpr int NIN = 2304, DFF = 2816, NGU = 5632, INW = 2072;
constexpr float QSCALE = 0.18033688011112042f;
constexpr float LOG2E = 1.4426950408889634f;

constexpr size_t O_YP = 0, O_YS = O_YP + (size_t)MP * D_, O_CMPP = O_YS + (size_t)MS * D_, O_SLCP = O_CMPP + (size_t)NL_ * NB_ * T_ * 256,
                 O_WINP = O_SLCP + (size_t)NL_ * NB_ * T_ * 256, O_CONVP = O_WINP + (size_t)NL_ * NB_ * 512 * 256, O_POOLP = O_CONVP + (size_t)NL_ * NB_ * 30 * 256,
                 O_CMPS = O_POOLP + (size_t)NL_ * NB_ * 15 * 256, O_SLCS = O_CMPS + (size_t)NL_ * NREQ * 4 * 256, O_WINS = O_SLCS + (size_t)NL_ * NREQ * 4 * 256,
                 O_CONVS = O_WINS + (size_t)NL_ * NREQ * 512 * 256, O_POOLS = O_CONVS + (size_t)NL_ * NREQ * 30 * 256, O_END = O_POOLS + (size_t)NL_ * NREQ * 15 * 256;

__device__ const unsigned char kBucket[128] = {0, 1, 2, 3, 4, 5, 6, 7, 8, 9, 10, 11, 12, 13, 14, 15, 16, 16, 16, 17, 17, 18, 18, 18, 19, 19, 19, 20, 20, 20, 20, 21, 21, 21, 21, 22, 22, 22, 22, 22, 23, 23, 23, 23, 23, 23, 24, 24, 24, 24, 24, 24, 25, 25, 25, 25, 25, 25, 25, 26, 26, 26, 26, 26, 26, 26, 26, 27, 27, 27, 27, 27, 27, 27, 27, 27, 27, 28, 28, 28, 28, 28, 28, 28, 28, 28, 28, 29, 29, 29, 29, 29, 29, 29, 29, 29, 29, 29, 29, 30, 30, 30, 30, 30, 30, 30, 30, 30, 30, 30, 30, 30, 30, 31, 31, 31, 31, 31, 31, 31, 31, 31, 31, 31, 31, 31, 31, 31};

struct Prm {
    const float *x_prompt, *x_sample, *cache_cmp, *cache_slc, *cache_win, *state_conv, *state_pool;
    const int* page_table;
    const float *rel_bias, *norm1, *w_in, *conv_dw, *conv_b, *conv_ln_g, *conv_ln_b, *pool_w, *pool_scale, *pe_k, *wk, *pe_v, *wv, *w_out, *norm2, *w_gu, *w_down, *final_norm;
    float* out;
    unsigned* bar;
    bf16_t *Wt_in, *Wt_out, *Wt_gu, *Wt_down, *Wct;
    float* cb;
    bf16_t* XB;
    float *SSa, *SSb, *G, *U;
    bf16_t *Q, *KVB;
    float* GATES;
    bf16_t *KC, *KCS, *MIX;
    float *X1, *X2;
    bf16_t* ACT;
    float* BIASL2;
};

DEV float bf2f(bf16_t v) { return __uint_as_float((unsigned)v << 16); }
DEV bf16_t f2bf(float f) { unsigned u = __float_as_uint(f); u += 0x7fffu + ((u >> 16) & 1u); return (bf16_t)(u >> 16); }
DEV unsigned pack2(float a, float b) { return (unsigned)f2bf(a) | ((unsigned)f2bf(b) << 16); }
DEV float wave_sum(float v) { for (int o = 32; o > 0; o >>= 1) v += __shfl_xor(v, o); return v; }
DEV float wave_max(float v) { for (int o = 32; o > 0; o >>= 1) v = fmaxf(v, __shfl_xor(v, o)); return v; }
DEV float sigmoidf_(float x) { return 1.f / (1.f + __expf(-x)); }

DEV int srccol(int mode, int n) {
    if (mode == 0) { if (n < 512) { const int t = n >> 8, j = n & 255; return j < 128 ? 128 * t + j : 256 + 128 * t + (j - 128); } return n < INW ? n : -1; }
    if (mode == 2) { const int t = n >> 8, j = n & 255; return j < 128 ? 128 * t + j : DFF + 128 * t + (j - 128); }
    return n;
}
__global__ void prep_w(const float* __restrict__ src, const float* __restrict__ gain, bf16_t* __restrict__ dst, int K, int Ns, int mode) {
    __shared__ float tile[32][33];
    const int n0 = blockIdx.x * 32, k0 = blockIdx.y * 32, tx = threadIdx.x, ty = threadIdx.y;
    const int sc = srccol(mode, n0 + tx);
#pragma unroll
    for (int i = 0; i < 4; ++i) { const int k = k0 + ty + 8 * i; float v = 0.f; if (sc >= 0) v = src[(size_t)k * Ns + sc] * (gain ? gain[k] : 1.f); tile[ty + 8 * i][tx] = v; }
    __syncthreads();
#pragma unroll
    for (int i = 0; i < 4; ++i) { const int nn = n0 + ty + 8 * i; dst[(size_t)nn * K + k0 + tx] = f2bf(tile[tx][ty + 8 * i]); }
}
__global__ void prep_cmp(Prm p) {
    const int idx = blockIdx.x * 256 + threadIdx.x; if (idx >= 2 * 2 * 128 * 1024) return;
    const int k = idx & 1023, n = (idx >> 10) & 127, type = (idx >> 17) & 1, l = idx >> 18;
    const float* src = (type ? p.wv : p.wk) + (size_t)l * 32 * 64 * 64; const int half = n >> 6, e = n & 63;
    p.Wct[idx] = f2bf(src[(size_t)(half * 1024 + k) * 64 + e]);
}
__global__ void prep_cb(Prm p) {
    const int lt = blockIdx.x, l = lt >> 1, type = lt & 1, e = threadIdx.x;
    const float* w = (type ? p.wv : p.wk) + (size_t)l * 32 * 64 * 64; const float* pe = (type ? p.pe_v : p.pe_k) + (size_t)l * 32 * 64;
    float acc = 0.f; for (int k = 0; k < 2048; ++k) acc += pe[k] * w[(size_t)k * 64 + e];
    p.cb[lt * 64 + e] = acc;
}
__global__ void prep_x(Prm p) {
    const int m = blockIdx.x, tid = threadIdx.x;
    const float* x = m < MP ? p.x_prompt + (size_t)m * D_ : p.x_sample + (size_t)(m - MP) * D_;
    const float4 v = *(const float4*)(x + tid * 4);
    uint2 w; w.x = pack2(v.x, v.y); w.y = pack2(v.z, v.w); *(uint2*)(p.XB + (size_t)m * D_ + tid * 4) = w;
    float s = wave_sum(v.x * v.x + v.y * v.y + v.z * v.z + v.w * v.w);
    __shared__ float red[4]; if ((tid & 63) == 0) red[tid >> 6] = s; __syncthreads();
    if (tid < 16) p.SSb[(size_t)m * 16 + tid] = tid == 0 ? (red[0] + red[1]) + (red[2] + red[3]) : 0.f;
}
__global__ void prep_bias(Prm p) {
    const int idx = blockIdx.x * 256 + threadIdx.x; if (idx >= 1024) return;
    const int dist = idx & 127, gr = idx >> 7;
    p.BIASL2[idx] = p.rel_bias[kBucket[dist] * 8 + gr] * LOG2E;
}

DEV float row_rs(const float* SS, int m) { float s = 0.f; for (int i = 0; i < 16; ++i) s += SS[(size_t)m * 16 + i]; return rsqrtf(s * (1.f / 1024.f) + 1e-6f); }
DEV void st8f(float* dst, const float (&v)[8]) { *(float4*)dst = make_float4(v[0], v[1], v[2], v[3]); *(float4*)(dst + 4) = make_float4(v[4], v[5], v[6], v[7]); }
DEV void st8b(bf16_t* dst, const float (&v)[8]) { uint4 w; w.x = pack2(v[0], v[1]); w.y = pack2(v[2], v[3]); w.z = pack2(v[4], v[5]); w.w = pack2(v[6], v[7]); *(uint4*)dst = w; }

struct EpiIn {
    static constexpr bool HAS_SS = false;
    Prm p; long long l; float* ss;
    DEV float apply(int m, int pn, int j, const float (&lo_)[8], const float (&hi_)[8]) const {
        const float rs = row_rs(p.SSb, m);
        float lo[8], hi[8];
#pragma unroll
        for (int i = 0; i < 8; ++i) { lo[i] = lo_[i] * rs; hi[i] = hi_[i] * rs; }
        const bool samp = m >= MP; const int b = m / T_, t = m % T_, req = (m - MP) >> 2, s = (m - MP) & 3;
        if (pn < 2) {
            float g[8];
#pragma unroll
            for (int i = 0; i < 8; ++i) g[i] = lo[i] * sigmoidf_(hi[i]);
            const int c = 128 * pn + j;
            st8f(p.G + (size_t)m * 256 + c, g);
            if (!samp) { if (t >= T_ - 30) st8f(p.out + O_CONVP + ((size_t)(l * NB_ + b) * 30 + (t - (T_ - 30))) * 256 + c, g); }
            else st8f(p.out + O_CONVS + ((size_t)(l * NREQ + req) * 30 + 26 + s) * 256 + c, g);
        } else if (pn == 2) {
            st8f(p.U + (size_t)m * 256 + j, lo); st8f(p.U + (size_t)m * 256 + 128 + j, hi);
            if (!samp) { if (t >= T_ - 15) { float* o = p.out + O_POOLP + ((size_t)(l * NB_ + b) * 15 + (t - (T_ - 15))) * 256; st8f(o + j, lo); st8f(o + 128 + j, hi); } }
            else { float* o = p.out + O_POOLS + ((size_t)(l * NREQ + req) * 15 + 11 + s) * 256; st8f(o + j, lo); st8f(o + 128 + j, hi); }
        } else if (pn < 5) {
            const int g = pn - 3; float a[8], c[8];
#pragma unroll
            for (int i = 0; i < 8; ++i) { a[i] = lo[i] * QSCALE; c[i] = hi[i] * QSCALE; }
            st8b(p.Q + (size_t)m * 512 + g * 256 + j, a); st8b(p.Q + (size_t)m * 512 + g * 256 + 128 + j, c);
        } else if (pn < 8) {
            const int br = pn - 5, g = j >> 6, d = j & 63;
            float* o;
            if (!samp) {
                if (br == 0) o = p.out + O_CMPP + ((size_t)(l * NB_ + b) * T_ + t) * 256;
                else if (br == 1) o = p.out + O_SLCP + ((size_t)(l * NB_ + b) * T_ + t) * 256;
                else o = t >= T_ - 512 ? p.out + O_WINP + ((size_t)(l * NB_ + b) * 512 + (t - (T_ - 512))) * 256 : nullptr;
            } else {
                if (br == 0) o = p.out + O_CMPS + ((size_t)(l * NREQ + req) * 4 + s) * 256;
                else if (br == 1) o = p.out + O_SLCS + ((size_t)(l * NREQ + req) * 4 + s) * 256;
                else o = p.out + O_WINS + ((size_t)(l * NREQ + req) * 512 + 508 + s) * 256;
            }
            if (o) { st8f(o + j, lo); st8f(o + 128 + j, hi); }
            if (!samp) {
                st8b(p.KVB + ((((size_t)(br * 2 + 0) * NB_ + b) * 2 + g) * T_ + t) * 64 + d, lo);
                st8b(p.KVB + ((((size_t)(br * 2 + 1) * NB_ + b) * 2 + g) * T_ + t) * 64 + d, hi);
            }
        } else {
            if (j < 24) {
#pragma unroll
                for (int i = 0; i < 8; ++i) p.GATES[(size_t)m * 24 + j + i] = sigmoidf_(lo[i]);
            }
        }
        return 0.f;
    }
};
struct EpiRes {
    static constexpr bool HAS_SS = true;
    Prm p; long long mode;
    float* ss;
    DEV float apply(int m, int pn, int j, const float (&lo)[8], const float (&hi)[8]) const {
        const float* rb = mode == 0 ? (m < MP ? p.x_prompt + (size_t)m * D_ : p.x_sample + (size_t)(m - MP) * D_) : (mode == 1 ? p.X2 + (size_t)m * D_ : p.X1 + (size_t)m * D_);
        float* xo = (mode == 2 ? p.X2 : p.X1) + (size_t)m * D_;
        const int c = pn * 256 + j;
        float a[8], h[8]; float sq = 0.f;
        const float4 r0 = *(const float4*)(rb + c), r1 = *(const float4*)(rb + c + 4), r2 = *(const float4*)(rb + c + 128), r3 = *(const float4*)(rb + c + 132);
        a[0] = lo[0] + r0.x; a[1] = lo[1] + r0.y; a[2] = lo[2] + r0.z; a[3] = lo[3] + r0.w; a[4] = lo[4] + r1.x; a[5] = lo[5] + r1.y; a[6] = lo[6] + r1.z; a[7] = lo[7] + r1.w;
        h[0] = hi[0] + r2.x; h[1] = hi[1] + r2.y; h[2] = hi[2] + r2.z; h[3] = hi[3] + r2.w; h[4] = hi[4] + r3.x; h[5] = hi[5] + r3.y; h[6] = hi[6] + r3.z; h[7] = hi[7] + r3.w;
#pragma unroll
        for (int i = 0; i < 8; ++i) sq += a[i] * a[i] + h[i] * h[i];
        st8f(xo + c, a); st8f(xo + c + 128, h);
        st8b(p.XB + (size_t)m * D_ + c, a); st8b(p.XB + (size_t)m * D_ + c + 128, h);
        return sq;
    }
};
struct EpiGU {
    static constexpr bool HAS_SS = false;
    Prm p; float* ss;
    DEV float apply(int m, int pn, int j, const float (&lo)[8], const float (&hi)[8]) const {
        const float rs = row_rs(p.SSa, m); float a[8];
#pragma unroll
        for (int i = 0; i < 8; ++i) { const float g = lo[i] * rs, u = hi[i] * rs; a[i] = g * sigmoidf_(g) * u; }
        st8b(p.ACT + (size_t)m * DFF + pn * 128 + j, a);
        return 0.f;
    }
};

template <class Epi>
__global__ void __launch_bounds__(256) gemm_naive(const bf16_t* __restrict__ A, const bf16_t* __restrict__ Bt, int K, int ntn, Epi epi) {
    const int tid = threadIdx.x, pn = blockIdx.x % ntn, m = (blockIdx.x / ntn) * 16 + (tid >> 4), j = (tid & 15) * 8;
    float lo[8], hi[8];
#pragma unroll
    for (int i = 0; i < 8; ++i) { lo[i] = 0.f; hi[i] = 0.f; }
    const bf16_t* a = A + (size_t)m * K; const bf16_t* bl = Bt + (size_t)(pn * 256 + j) * K; const bf16_t* bh = bl + (size_t)128 * K;
    for (int k = 0; k < K; k += 8) {
        const uint4 av = *(const uint4*)(a + k);
        float af[8]; af[0] = __uint_as_float(av.x << 16); af[1] = __uint_as_float(av.x & 0xffff0000u); af[2] = __uint_as_float(av.y << 16); af[3] = __uint_as_float(av.y & 0xffff0000u);
        af[4] = __uint_as_float(av.z << 16); af[5] = __uint_as_float(av.z & 0xffff0000u); af[6] = __uint_as_float(av.w << 16); af[7] = __uint_as_float(av.w & 0xffff0000u);
#pragma unroll
        for (int c = 0; c < 8; ++c) {
            const uint4 b0 = *(const uint4*)(bl + (size_t)c * K + k), b1 = *(const uint4*)(bh + (size_t)c * K + k);
            lo[c] += af[0] * __uint_as_float(b0.x << 16) + af[1] * __uint_as_float(b0.x & 0xffff0000u) + af[2] * __uint_as_float(b0.y << 16) + af[3] * __uint_as_float(b0.y & 0xffff0000u)
                   + af[4] * __uint_as_float(b0.z << 16) + af[5] * __uint_as_float(b0.z & 0xffff0000u) + af[6] * __uint_as_float(b0.w << 16) + af[7] * __uint_as_float(b0.w & 0xffff0000u);
            hi[c] += af[0] * __uint_as_float(b1.x << 16) + af[1] * __uint_as_float(b1.x & 0xffff0000u) + af[2] * __uint_as_float(b1.y << 16) + af[3] * __uint_as_float(b1.y & 0xffff0000u)
                   + af[4] * __uint_as_float(b1.z << 16) + af[5] * __uint_as_float(b1.z & 0xffff0000u) + af[6] * __uint_as_float(b1.w << 16) + af[7] * __uint_as_float(b1.w & 0xffff0000u);
        }
    }
    float sq = epi.apply(m, pn, j, lo, hi);
    if (Epi::HAS_SS) { sq += __shfl_xor(sq, 1); sq += __shfl_xor(sq, 2); if ((tid & 3) == 0) epi.ss[(size_t)m * 16 + pn * 4 + (j >> 5)] = sq; }
}

__global__ void __launch_bounds__(512) k_convpool(Prm p, int l) {
    extern __shared__ float sm[];
    float* buf = sm; float* yb = sm + 62 * 256;
    const int item = blockIdx.x, tid = threadIdx.x, c = tid & 255, half = tid >> 8, wave = tid >> 6, lane = tid & 63;
    const bool samp = item >= 512; const int NT = samp ? 4 : 32, ntok = NT / 2;
    int m0, t0 = 0, req = 0;
    if (!samp) { m0 = item * 32; t0 = m0 % T_; } else { req = item - 512; m0 = MP + req * 4; }
    for (int idx = tid; idx < (NT + 30) * 64; idx += 512) {
        const int r = idx >> 6, c4 = (idx & 63) * 4, rel = r - 30; float4 v = make_float4(0.f, 0.f, 0.f, 0.f);
        if (!samp) { if (t0 + rel >= 0) v = *(const float4*)(p.G + (size_t)(m0 + rel) * 256 + c4); }
        else { if (rel < 0) v = *(const float4*)(p.state_conv + ((size_t)(l * NREQ + req) * 30 + r) * 256 + c4); else v = *(const float4*)(p.G + (size_t)(m0 + rel) * 256 + c4); }
        *(float4*)(buf + r * 256 + c4) = v;
    }
    __syncthreads();
    {
        const float cbias = p.conv_b[l * 256 + c];
        for (int k = 0; k < ntok; ++k) {
            const int tok = half * ntok + k; float acc = cbias;
#pragma unroll
            for (int w = 0; w < 31; ++w) acc += buf[(tok + w) * 256 + c] * p.conv_dw[(size_t)(l * 31 + w) * 256 + c];
            yb[tok * 256 + c] = acc;
        }
    }
    __syncthreads();
    for (int tok = wave; tok < NT; tok += 8) {
        const float4 v = *(const float4*)(yb + tok * 256 + lane * 4);
        const float mean = wave_sum((v.x + v.y) + (v.z + v.w)) * (1.f / 256.f);
        const float x0 = v.x - mean, x1 = v.y - mean, x2 = v.z - mean, x3 = v.w - mean;
        const float var = wave_sum((x0 * x0 + x1 * x1) + (x2 * x2 + x3 * x3)) * (1.f / 256.f);
        const float r = rsqrtf(var + 1e-6f);
        const float4 g = *(const float4*)(p.conv_ln_g + l * 256 + lane * 4), bb = *(const float4*)(p.conv_ln_b + l * 256 + lane * 4);
        float y0 = x0 * r * g.x + bb.x, y1 = x1 * r * g.y + bb.y, y2 = x2 * r * g.z + bb.z, y3 = x3 * r * g.w + bb.w;
        y0 *= sigmoidf_(y0); y1 *= sigmoidf_(y1); y2 *= sigmoidf_(y2); y3 *= sigmoidf_(y3);
        uint2 w; w.x = pack2(y0, y1); w.y = pack2(y2, y3);
        *(uint2*)(p.MIX + (size_t)(m0 + tok) * D_ + lane * 4) = w;
    }
    if (samp) for (int idx = tid; idx < 26 * 256; idx += 512) p.out[O_CONVS + ((size_t)(l * NREQ + req) * 30) * 256 + idx] = buf[4 * 256 + idx];
    __syncthreads();
    for (int idx = tid; idx < (NT + 15) * 64; idx += 512) {
        const int r = idx >> 6, c4 = (idx & 63) * 4, rel = r - 15; float4 v = make_float4(0.f, 0.f, 0.f, 0.f);
        if (!samp) { if (t0 + rel >= 0) v = *(const float4*)(p.U + (size_t)(m0 + rel) * 256 + c4); }
        else { if (rel < 0) v = *(const float4*)(p.state_pool + ((size_t)(l * NREQ + req) * 15 + r) * 256 + c4); else v = *(const float4*)(p.U + (size_t)(m0 + rel) * 256 + c4); }
        *(float4*)(buf + r * 256 + c4) = v;
    }
    __syncthreads();
    {
        const int w = 2 << (c >> 6);
        for (int k = 0; k < ntok; ++k) {
            const int tok = half * ntok + k; float s = 0.f;
            for (int i = 0; i < w; ++i) s += buf[(tok + 15 - i) * 256 + c];
            const int cnt = samp ? w : min(w, t0 + tok + 1);
            yb[tok * 256 + c] = s / (float)cnt - buf[(tok + 15) * 256 + c];
        }
    }
    __syncthreads();
    {
        const int e = tid & 63, g = (tid >> 6) & 3; const float sc = p.pool_scale[l * 256 + g * 64 + e];
        const float* wp = p.pool_w + (size_t)(l * 4 + g) * 64 * 64 + e;
        for (int k = 0; k < ntok; ++k) {
            const int tok = half * ntok + k; float acc = 0.f;
#pragma unroll 8
            for (int cc = 0; cc < 64; ++cc) acc += yb[tok * 256 + g * 64 + cc] * wp[cc * 64];
            p.MIX[(size_t)(m0 + tok) * D_ + 256 + g * 64 + e] = f2bf(acc * sc);
        }
    }
    if (samp) for (int idx = tid; idx < 11 * 256; idx += 512) p.out[O_POOLS + ((size_t)(l * NREQ + req) * 15) * 256 + idx] = buf[4 * 256 + idx];
}

__global__ void __launch_bounds__(64) k_cmp_prompt(Prm p, int l) {
    const int n = blockIdx.x % 255, type = (blockIdx.x / 255) & 1, g = (blockIdx.x / 510) & 1, b = blockIdx.x / 1020, e = threadIdx.x;
    const bf16_t* kv = p.KVB + ((((size_t)(0 * 2 + type) * NB_ + b) * 2 + g) * T_ + 16 * n) * 64;
    const bf16_t* w = p.Wct + (size_t)(l * 2 + type) * 128 * 1024;
    float acc = p.cb[(l * 2 + type) * 64 + e];
    for (int k = 0; k < 1024; ++k) acc += bf2f(kv[k]) * bf2f(w[(size_t)e * 1024 + k]) + bf2f(kv[1024 + k]) * bf2f(w[(size_t)(64 + e) * 1024 + k]);
    p.KC[((((size_t)b * 2 + g) * 2 + type) * 256 + n) * 64 + e] = f2bf(acc);
}
__global__ void __launch_bounds__(64) k_cmp_sample(Prm p, int l) {
    const int n = blockIdx.x % 127, type = (blockIdx.x / 127) & 1, g = (blockIdx.x / 254) & 1, req = blockIdx.x / 508, e = threadIdx.x;
    const bf16_t* w = p.Wct + (size_t)(l * 2 + type) * 128 * 1024;
    float acc = p.cb[(l * 2 + type) * 64 + e];
    for (int ll = 0; ll < 32; ++ll) {
        const int pos = 16 * n + ll; const int page = p.page_table[req * NPG + (pos >> 7)];
        const float* row = p.cache_cmp + (((((size_t)l * NPHYS + page) * 128 + (pos & 127)) * 2 + type) * 2 + g) * 64;
        const bf16_t* wr = w + (size_t)((ll >> 4) * 64 + e) * 1024 + (ll & 15) * 64;
        for (int d = 0; d < 64; ++d) acc += bf2f(f2bf(row[d])) * bf2f(wr[d]);
    }
    p.KCS[((((size_t)req * 2 + g) * 2 + type) * 128 + n) * 64 + e] = f2bf(acc);
}
__global__ void k_wincopy(Prm p, int l) {
    const size_t idx = (size_t)blockIdx.x * 256 + threadIdx.x; if (idx >= (size_t)NREQ * 508 * 64) return;
    const size_t req = idx / (508 * 64), rem = idx % (508 * 64);
    const float4 v = *(const float4*)(p.cache_win + ((size_t)(l * NREQ + req) * 512 + 4) * 256 + rem * 4);
    *(float4*)(p.out + O_WINS + ((size_t)(l * NREQ + req) * 512) * 256 + rem * 4) = v;
}

template <bool SAMPLE> struct KVAcc {
    const Prm& p; int l, bq, g;
    DEV float kc(int type, int n, int d) const {
        if (!SAMPLE) return bf2f(p.KC[((((size_t)bq * 2 + g) * 2 + type) * 256 + n) * 64 + d]);
        return bf2f(p.KCS[((((size_t)bq * 2 + g) * 2 + type) * 128 + n) * 64 + d]);
    }
    DEV float slc(int kv, int pos, int d) const {
        if (!SAMPLE) return bf2f(p.KVB[((((size_t)(1 * 2 + kv) * NB_ + bq) * 2 + g) * T_ + pos) * 64 + d]);
        if (pos < PAST_) { const int page = p.page_table[bq * NPG + (pos >> 7)]; return p.cache_slc[(((((size_t)l * NPHYS + page) * 128 + (pos & 127)) * 2 + kv) * 2 + g) * 64 + d]; }
        return p.out[O_SLCS + ((size_t)(l * NREQ + bq) * 4 + (pos - PAST_)) * 256 + kv * 128 + g * 64 + d];
    }
    DEV float win(int kv, int pos, int d) const {
        if (!SAMPLE) return bf2f(p.KVB[((((size_t)(2 * 2 + kv) * NB_ + bq) * 2 + g) * T_ + pos) * 64 + d]);
        const int idx = pos - (PAST_ - 512);
        if (idx < 512) return p.cache_win[((((size_t)(l * NREQ + bq) * 512 + idx) * 2 + kv) * 2 + g) * 64 + d];
        return p.out[O_WINS + ((size_t)(l * NREQ + bq) * 512 + 508 + (idx - 512)) * 256 + kv * 128 + g * 64 + d];
    }
};
template <bool SAMPLE>
__global__ void __launch_bounds__(256) k_attn_naive(Prm p, int l) {
    __shared__ float sc[4][1024]; __shared__ float pslc[64]; __shared__ int sel[16]; __shared__ float qs[4][64];
    const int tid = threadIdx.x, r = tid >> 6, lane = tid & 63, bid = blockIdx.x;
    int bq, g, m, qpos, ncmp, nslc;
    if (!SAMPLE) { const int t = bid % T_; g = (bid / T_) & 1; bq = bid / (2 * T_); m = bq * T_ + t; qpos = t; ncmp = 255; nslc = 64; }
    else { const int s = bid & 3; g = (bid >> 2) & 1; bq = bid >> 3; m = MP + bq * 4 + s; qpos = PAST_ + s; ncmp = 127; nslc = 33; }
    const KVAcc<SAMPLE> kv{p, l, bq, g};
    qs[r][lane] = bf2f(p.Q[(size_t)m * 512 + g * 256 + r * 64 + lane]);
    __syncthreads();
    const float* btab = p.BIASL2 + (g * 4 + r) * 128;
    const int nvis = qpos >= 31 ? min((qpos - 31) / 16 + 1, ncmp) : 0;
    float mx = -1e30f;
    for (int n = lane; n < nvis; n += 64) { float dot = 0.f; for (int d = 0; d < 64; ++d) dot += qs[r][d] * kv.kc(0, n, d); const float s = dot + btab[min(qpos - (16 * n + 31), 127)]; sc[r][n] = s; mx = fmaxf(mx, s); }
    mx = wave_max(mx);
    float sum = 0.f;
    for (int n = lane; n < nvis; n += 64) { const float e = exp2f(sc[r][n] - mx); sc[r][n] = e; sum += e; }
    sum = wave_sum(sum);
    const float inv = nvis > 0 ? 1.f / sum : 0.f;
    for (int n = lane; n < nvis; n += 64) sc[r][n] *= inv;
    __syncthreads();
    float ocmp = 0.f;
    for (int n = 0; n < nvis; ++n) ocmp += sc[r][n] * kv.kc(1, n, lane);
    if (tid < 64) { const int j = tid; float ps = 0.f; for (int n = max(0, 4 * j - 1); n <= 4 * j + 3; ++n) if (n < nvis) ps += (sc[0][n] + sc[1][n]) + (sc[2][n] + sc[3][n]); pslc[j] = ps; }
    __syncthreads();
    const int cur = qpos >> 6;
    if (tid < 64) {
        const int j = tid; const bool forced = (j == 0) || (j == cur) || (j == cur - 1);
        float v = j >= nslc ? -INFINITY : (forced ? 1e4f : (j <= cur ? pslc[j] : -1e30f));
        for (int k = 0; k < 16; ++k) { const float mv = wave_max(v); const unsigned long long bal = __ballot(v == mv); const int idx = __ffsll((long long)bal) - 1; if (lane == 0) sel[k] = idx; if (lane == idx) v = -INFINITY; }
    }
    __syncthreads();
    mx = -1e30f;
    for (int i = lane; i < 1024; i += 64) { const int pos = sel[i >> 6] * 64 + (i & 63); float s = -1e30f;
        if (pos <= qpos) { float dot = 0.f; for (int d = 0; d < 64; ++d) dot += qs[r][d] * kv.slc(0, pos, d); s = dot + btab[min(qpos - pos, 127)]; mx = fmaxf(mx, s); }
        sc[r][i] = s; }
    mx = wave_max(mx); sum = 0.f;
    for (int i = lane; i < 1024; i += 64) { const float s = sc[r][i]; const float e = s > -1e29f ? exp2f(s - mx) : 0.f; sc[r][i] = e; sum += e; }
    sum = wave_sum(sum);
    __syncthreads();
    float oslc = 0.f;
    for (int i = 0; i < 1024; ++i) { const float pr = sc[r][i]; if (pr != 0.f) oslc += pr * kv.slc(1, sel[i >> 6] * 64 + (i & 63), lane); }
    oslc = sum > 0.f ? oslc / sum : 0.f;
    __syncthreads();
    mx = -1e30f;
    for (int i = lane; i < 512; i += 64) { const int pos = qpos - 511 + i; float s = -1e30f;
        if (pos >= 0) { float dot = 0.f; for (int d = 0; d < 64; ++d) dot += qs[r][d] * kv.win(0, pos, d); s = dot + btab[min(511 - i, 127)]; mx = fmaxf(mx, s); }
        sc[r][i] = s; }
    mx = wave_max(mx); sum = 0.f;
    for (int i = lane; i < 512; i += 64) { const float s = sc[r][i]; const float e = s > -1e29f ? exp2f(s - mx) : 0.f; sc[r][i] = e; sum += e; }
    sum = wave_sum(sum);
    __syncthreads();
    float owin = 0.f;
    for (int i = 0; i < 512; ++i) { const float pr = sc[r][i]; if (pr != 0.f) owin += pr * kv.win(1, qpos - 511 + i, lane); }
    owin = sum > 0.f ? owin / sum : 0.f;
    const float gc = p.GATES[(size_t)m * 24 + 0 + g * 4 + r], gs = p.GATES[(size_t)m * 24 + 8 + g * 4 + r], gw = p.GATES[(size_t)m * 24 + 16 + g * 4 + r];
    p.MIX[(size_t)m * D_ + 512 + g * 256 + r * 64 + lane] = f2bf(gc * ocmp + gs * oslc + gw * owin);
}

__global__ void k_final(Prm p) {
    const int m = blockIdx.x, tid = threadIdx.x;
    const float rs = row_rs(p.SSb, m);
    const float4 v = *(const float4*)(p.X2 + (size_t)m * D_ + tid * 4), g = *(const float4*)(p.final_norm + tid * 4);
    *(float4*)(p.out + (size_t)m * D_ + tid * 4) = make_float4(v.x * rs * g.x, v.y * rs * g.y, v.z * rs * g.z, v.w * rs * g.w);
}

static size_t carve(size_t& off, size_t bytes) { const size_t o = off; off += (bytes + 255) & ~(size_t)255; return o; }
extern "C" void kernel_launch(void* const* d_in, const int* in_sizes, int n_in, void* d_out, int out_size, void* d_ws, size_t ws_size, hipStream_t stream) {
    Prm p{};
    p.x_prompt = (const float*)d_in[0]; p.x_sample = (const float*)d_in[1]; p.cache_cmp = (const float*)d_in[2]; p.cache_slc = (const float*)d_in[3]; p.cache_win = (const float*)d_in[4];
    p.state_conv = (const float*)d_in[5]; p.state_pool = (const float*)d_in[6]; p.page_table = (const int*)d_in[7]; p.rel_bias = (const float*)d_in[8]; p.norm1 = (const float*)d_in[9];
    p.w_in = (const float*)d_in[10]; p.conv_dw = (const float*)d_in[11]; p.conv_b = (const float*)d_in[12]; p.conv_ln_g = (const float*)d_in[13]; p.conv_ln_b = (const float*)d_in[14];
    p.pool_w = (const float*)d_in[15]; p.pool_scale = (const float*)d_in[16]; p.pe_k = (const float*)d_in[17]; p.wk = (const float*)d_in[18]; p.pe_v = (const float*)d_in[19]; p.wv = (const float*)d_in[20];
    p.w_out = (const float*)d_in[21]; p.norm2 = (const float*)d_in[22]; p.w_gu = (const float*)d_in[23]; p.w_down = (const float*)d_in[24]; p.final_norm = (const float*)d_in[25];
    p.out = (float*)d_out;
    char* ws = (char*)d_ws; size_t off = 0;
    p.bar = (unsigned*)(ws + carve(off, 16384));
    p.Wt_in = (bf16_t*)(ws + carve(off, (size_t)NL_ * NIN * D_ * 2)); p.Wt_out = (bf16_t*)(ws + carve(off, (size_t)NL_ * D_ * D_ * 2));
    p.Wt_gu = (bf16_t*)(ws + carve(off, (size_t)NL_ * NGU * D_ * 2)); p.Wt_down = (bf16_t*)(ws + carve(off, (size_t)NL_ * D_ * DFF * 2));
    p.Wct = (bf16_t*)(ws + carve(off, (size_t)2 * 2 * 128 * 1024 * 2)); p.cb = (float*)(ws + carve(off, 256 * 4));
    p.XB = (bf16_t*)(ws + carve(off, (size_t)M_ * D_ * 2)); p.SSa = (float*)(ws + carve(off, (size_t)M_ * 16 * 4)); p.SSb = (float*)(ws + carve(off, (size_t)M_ * 16 * 4));
    p.G = (float*)(ws + carve(off, (size_t)M_ * 256 * 4)); p.U = (float*)(ws + carve(off, (size_t)M_ * 256 * 4));
    p.Q = (bf16_t*)(ws + carve(off, (size_t)M_ * 512 * 2)); p.KVB = (bf16_t*)(ws + carve(off, (size_t)3 * 2 * NB_ * 2 * T_ * 64 * 2));
    p.GATES = (float*)(ws + carve(off, (size_t)M_ * 24 * 4));
    p.KC = (bf16_t*)(ws + carve(off, (size_t)NB_ * 2 * 2 * 256 * 64 * 2)); p.KCS = (bf16_t*)(ws + carve(off, (size_t)NREQ * 2 * 2 * 128 * 64 * 2));
    p.MIX = (bf16_t*)(ws + carve(off, (size_t)M_ * D_ * 2)); p.X1 = (float*)(ws + carve(off, (size_t)M_ * D_ * 4)); p.X2 = (float*)(ws + carve(off, (size_t)M_ * D_ * 4));
    p.ACT = (bf16_t*)(ws + carve(off, (size_t)M_ * DFF * 2)); p.BIASL2 = (float*)(ws + carve(off, 1024 * 4));
    if (off > ws_size || out_size != (int)O_END) { fprintf(stderr, "kernel_launch: bad sizes (ws %zu need %zu, out %d expect %zu)\n", ws_size, off, out_size, (size_t)O_END); return; }
    static bool attr = false;
    if (!attr) { hipFuncSetAttribute((const void*)k_convpool, hipFuncAttributeMaxDynamicSharedMemorySize, 94 * 1024); attr = true; }

    for (int l = 0; l < NL_; ++l) {
        prep_w<<<dim3(NIN / 32, D_ / 32), dim3(32, 8), 0, stream>>>(p.w_in + (size_t)l * D_ * INW, p.norm1 + l * D_, p.Wt_in + (size_t)l * NIN * D_, D_, INW, 0);
        prep_w<<<dim3(D_ / 32, D_ / 32), dim3(32, 8), 0, stream>>>(p.w_out + (size_t)l * D_ * D_, nullptr, p.Wt_out + (size_t)l * D_ * D_, D_, D_, 1);
        prep_w<<<dim3(NGU / 32, D_ / 32), dim3(32, 8), 0, stream>>>(p.w_gu + (size_t)l * D_ * NGU, p.norm2 + l * D_, p.Wt_gu + (size_t)l * NGU * D_, D_, NGU, 2);
        prep_w<<<dim3(D_ / 32, DFF / 32), dim3(32, 8), 0, stream>>>(p.w_down + (size_t)l * DFF * D_, nullptr, p.Wt_down + (size_t)l * D_ * DFF, DFF, D_, 1);
    }
    prep_cmp<<<2 * 2 * 128 * 1024 / 256, 256, 0, stream>>>(p);
    prep_cb<<<4, 64, 0, stream>>>(p);
    prep_x<<<M_, 256, 0, stream>>>(p);
    prep_bias<<<4, 256, 0, stream>>>(p);
    for (int l = 0; l < NL_; ++l) {
        { EpiIn e{p, l, nullptr}; gemm_naive<EpiIn><<<(M_ / 16) * 9, 256, 0, stream>>>(p.XB, p.Wt_in + (size_t)l * NIN * D_, D_, 9, e); }
        k_wincopy<<<(NREQ * 508 * 64 + 255) / 256, 256, 0, stream>>>(p, l);
        k_cmp_prompt<<<NB_ * 2 * 2 * 255, 64, 0, stream>>>(p, l);
        k_cmp_sample<<<NREQ * 2 * 2 * 127, 64, 0, stream>>>(p, l);
        k_convpool<<<512 + NREQ, 512, 94 * 1024, stream>>>(p, l);
        k_attn_naive<false><<<NB_ * 2 * T_, 256, 0, stream>>>(p, l);
        k_attn_naive<true><<<NREQ * 2 * 4, 256, 0, stream>>>(p, l);
        { EpiRes e{p, l == 0 ? 0 : 1, p.SSa}; gemm_naive<EpiRes><<<(M_ / 16) * 4, 256, 0, stream>>>(p.MIX, p.Wt_out + (size_t)l * D_ * D_, D_, 4, e); }
        { EpiGU e{p, nullptr}; gemm_naive<EpiGU><<<(M_ / 16) * 22, 256, 0, stream>>>(p.XB, p.Wt_gu + (size_t)l * NGU * D_, D_, 22, e); }
        { EpiRes e{p, 2, p.SSb}; gemm_naive<EpiRes><<<(M_ / 16) * 4, 256, 0, stream>>>(p.ACT, p.Wt_down + (size_t)l * D_ * DFF, DFF, 4, e); }
    }
    k_final<<<M_, 256, 0, stream>>>(p);
}
```

```cpp
#include <hip/hip_runtime.h>
#include <stdint.h>
#include <stdio.h>

typedef unsigned short bf16_t;
#define DEV __device__ __forceinline__

constexpr int D_ = 1024, NB_ = 4, T_ = 4096, NL_ = 2, NREQ = 128, NS_ = 4, PAST_ = 2048, NPG = 16, NPHYS = 2560;
constexpr int MP = NB_ * T_, MS = NREQ * NS_, M_ = MP + MS;
constexpr int NIN = 2304, DFF = 2816, NGU = 5632, INW = 2072;
constexpr float QSCALE = 0.18033688011112042f;
constexpr float LOG2E = 1.4426950408889634f;

constexpr size_t O_YP = 0, O_YS = O_YP + (size_t)MP * D_, O_CMPP = O_YS + (size_t)MS * D_, O_SLCP = O_CMPP + (size_t)NL_ * NB_ * T_ * 256,
                 O_WINP = O_SLCP + (size_t)NL_ * NB_ * T_ * 256, O_CONVP = O_WINP + (size_t)NL_ * NB_ * 512 * 256, O_POOLP = O_CONVP + (size_t)NL_ * NB_ * 30 * 256,
                 O_CMPS = O_POOLP + (size_t)NL_ * NB_ * 15 * 256, O_SLCS = O_CMPS + (size_t)NL_ * NREQ * 4 * 256, O_WINS = O_SLCS + (size_t)NL_ * NREQ * 4 * 256,
                 O_CONVS = O_WINS + (size_t)NL_ * NREQ * 512 * 256, O_POOLS = O_CONVS + (size_t)NL_ * NREQ * 30 * 256, O_END = O_POOLS + (size_t)NL_ * NREQ * 15 * 256;

__device__ const unsigned char kBucket[128] = {0, 1, 2, 3, 4, 5, 6, 7, 8, 9, 10, 11, 12, 13, 14, 15, 16, 16, 16, 17, 17, 18, 18, 18, 19, 19, 19, 20, 20, 20, 20, 21, 21, 21, 21, 22, 22, 22, 22, 22, 23, 23, 23, 23, 23, 23, 24, 24, 24, 24, 24, 24, 25, 25, 25, 25, 25, 25, 25, 26, 26, 26, 26, 26, 26, 26, 26, 27, 27, 27, 27, 27, 27, 27, 27, 27, 27, 28, 28, 28, 28, 28, 28, 28, 28, 28, 28, 29, 29, 29, 29, 29, 29, 29, 29, 29, 29, 29, 29, 30, 30, 30, 30, 30, 30, 30, 30, 30, 30, 30, 30, 30, 30, 31, 31, 31, 31, 31, 31, 31, 31, 31, 31, 31, 31, 31, 31, 31};

struct Prm {
    const float *x_prompt, *x_sample, *cache_cmp, *cache_slc, *cache_win, *state_conv, *state_pool;
    const int* page_table;
    const float *rel_bias, *norm1, *w_in, *conv_dw, *conv_b, *conv_ln_g, *conv_ln_b, *pool_w, *pool_scale, *pe_k, *wk, *pe_v, *wv, *w_out, *norm2, *w_gu, *w_down, *final_norm;
    float* out;
    unsigned* bar;
    bf16_t *Wt_in, *Wt_out, *Wt_gu, *Wt_down, *Wct;
    float* cb;
    bf16_t* XB;
    float *SSa, *SSb, *G, *U;
    bf16_t *Q, *KVB;
    float* GATES;
    bf16_t *KC, *KCS, *MIX;
    float *X1, *X2;
    bf16_t* ACT;
    float* BIASL2;
    float* SLAB;
};

DEV int opaque_tid() { int t = threadIdx.x; asm volatile("" : "+v"(t)); return t; }
DEV float bf2f(bf16_t v) { return __uint_as_float((unsigned)v << 16); }
DEV bf16_t f2bf(float f) { unsigned u = __float_as_uint(f); u += 0x7fffu + ((u >> 16) & 1u); return (bf16_t)(u >> 16); }
DEV unsigned cvt_pk_bf16(float lo, float hi) { unsigned r; asm("v_cvt_pk_bf16_f32 %0, %1, %2\n\ts_nop 1" : "=v"(r) : "v"(lo), "v"(hi)); return r; }
DEV unsigned pack2(float a, float b) { return cvt_pk_bf16(a, b); }
DEV float wave_sum(float v) { for (int o = 32; o > 0; o >>= 1) v += __shfl_xor(v, o); return v; }
DEV float wave_max(float v) { for (int o = 32; o > 0; o >>= 1) v = fmaxf(v, __shfl_xor(v, o)); return v; }
DEV float sigmoidf_(float x) { return __builtin_amdgcn_rcpf(1.f + __builtin_amdgcn_exp2f(-1.4426950408889634f * x)); }

constexpr int NTHR = 512;
constexpr int LDS_BYTES = 147456;

#define XB_TMO      128
#define XB_XCNT(j)  (256  + 64 * (j))
#define XB_XSUB(j)  (1280 + 64 * (j))
#define XB_XGEN(j)  (2304 + 64 * (j))
#define XB_TOP      3328
#define XB_TOPGEN   3392
#define XCD_BAR_WORDS 3456
#define XB_SPIN_CAP (1u << 24)
#define LAS __attribute__((address_space(3)))
__device__ __forceinline__ unsigned xb_ld(unsigned* p)              { return __hip_atomic_load(p, __ATOMIC_RELAXED, __HIP_MEMORY_SCOPE_AGENT); }
__device__ __forceinline__ unsigned xb_add(unsigned* p, unsigned v) { return __hip_atomic_fetch_add(p, v, __ATOMIC_RELAXED, __HIP_MEMORY_SCOPE_AGENT); }
__device__ __forceinline__ unsigned xb_xcc_id() { return (unsigned)__builtin_amdgcn_s_getreg((3 << 11) | 20) & 0xFu; }
#define XB_SPIN(cond, bar) do { unsigned _sp = 0; while (cond) { __builtin_amdgcn_s_sleep(1); \
    if ((++_sp & 255u) == 0u) { if (xb_ld(&(bar)[XB_TMO])) break; if (_sp > XB_SPIN_CAP) { atomicAdd(&(bar)[XB_TMO], 1u); break; } } } } while (0)
struct XcdBarrier { unsigned* bar; unsigned x; volatile LAS unsigned* st; };
__device__ __forceinline__ XcdBarrier xcd_barrier_post(unsigned* bar, volatile LAS unsigned* st) {
    XcdBarrier b; b.bar = bar; b.x = xb_xcc_id(); b.st = st;
    if (threadIdx.x == 0) (void)xb_add(&bar[XB_XCNT(b.x)], 1u);
    return b;
}
__device__ __forceinline__ void xcd_barrier_complete(unsigned* bar, unsigned x, unsigned& nloc, unsigned& nx) {
    const unsigned G = gridDim.x * gridDim.y * gridDim.z;
    unsigned sum, cnt, mine, sp = 0u;
    for (;;) {
        sum = 0u; cnt = 0u; mine = 0u;
#pragma unroll
        for (unsigned j = 0; j < 16; ++j) { const unsigned c = xb_ld(&bar[XB_XCNT(j)]); sum += c; cnt += (c > 0u) ? 1u : 0u; mine = (j == x) ? c : mine; }
        if (sum == G) break;
        __builtin_amdgcn_s_sleep(1);
        if ((++sp & 255u) == 0u) { if (xb_ld(&bar[XB_TMO])) break; if (sp > XB_SPIN_CAP) { atomicAdd(&bar[XB_TMO], 1u); break; } }
    }
    nloc = mine > 0u ? mine : 1u; nx = cnt > 0u ? cnt : 1u;
}
__device__ __forceinline__ void xcd_barrier(const XcdBarrier& b) {
    asm volatile("s_waitcnt vmcnt(0)" ::: "memory");
    __syncthreads();
    if (threadIdx.x == 0) {
        unsigned* bar = b.bar;
        __builtin_amdgcn_s_waitcnt(0);
        unsigned nloc = b.st[0], nx = b.st[1];
        if (nloc == 0u) { xcd_barrier_complete(bar, b.x, nloc, nx); b.st[0] = nloc; b.st[1] = nx; }
        const unsigned old = xb_add(&bar[XB_XSUB(b.x)], 1u);
        const unsigned gen = old / nloc;
        if (old + 1u == (gen + 1u) * nloc) {
            __builtin_amdgcn_fence(__ATOMIC_RELEASE, "agent");
            asm volatile("s_waitcnt vmcnt(0)" ::: "memory");
            const unsigned og = xb_add(&bar[XB_TOP], 1u);
            const unsigned tg = og / nx;
            if (og + 1u == (tg + 1u) * nx) xb_add(&bar[XB_TOPGEN], 1u);
            else XB_SPIN(xb_ld(&bar[XB_TOPGEN]) == tg, bar);
            __builtin_amdgcn_fence(__ATOMIC_ACQUIRE, "agent");
            xb_add(&bar[XB_XGEN(b.x)], 1u);
            asm volatile("s_waitcnt vmcnt(0)" ::: "memory");
        } else {
            XB_SPIN(xb_ld(&bar[XB_XGEN(b.x)]) == gen, bar);
            __builtin_amdgcn_fence(__ATOMIC_ACQUIRE, "agent");
            asm volatile("s_waitcnt vmcnt(0)" ::: "memory");
        }
    }
    __syncthreads();
}

DEV int srccol(int mode, int n) {
    if (mode == 0) { if (n < 512) { const int t = n >> 8, j = n & 255; return j < 128 ? 128 * t + j : 256 + 128 * t + (j - 128); } return n < INW ? n : -1; }
    if (mode == 2) { const int t = n >> 8, j = n & 255; return j < 128 ? 128 * t + j : DFF + 128 * t + (j - 128); }
    return n;
}
#define WDESC(tg) \
    const int l_ = (tg) / TPL, r_ = (tg) % TPL, which = r_ < 576 ? 0 : (r_ < 832 ? 1 : (r_ < 2240 ? 2 : 3)), tl = r_ - (which == 0 ? 0 : (which == 1 ? 576 : (which == 2 ? 832 : 2240))); \
    const float* src = which == 0 ? p.w_in + (size_t)l_ * D_ * INW : (which == 1 ? p.w_out + (size_t)l_ * D_ * D_ : (which == 2 ? p.w_gu + (size_t)l_ * D_ * NGU : p.w_down + (size_t)l_ * DFF * D_)); \
    const float* gain = which == 0 ? p.norm1 + l_ * D_ : (which == 2 ? p.norm2 + l_ * D_ : nullptr); \
    bf16_t* dst = which == 0 ? p.Wt_in + (size_t)l_ * NIN * D_ : (which == 1 ? p.Wt_out + (size_t)l_ * D_ * D_ : (which == 2 ? p.Wt_gu + (size_t)l_ * NGU * D_ : p.Wt_down + (size_t)l_ * D_ * DFF)); \
    const int K = which == 3 ? DFF : D_, Ns = which == 0 ? INW : (which == 2 ? NGU : D_), ntn = which == 0 ? NIN / 64 : (which == 2 ? NGU / 64 : D_ / 64), mode = which == 0 ? 0 : (which == 2 ? 2 : 1); \
    const int n0 = (tl % ntn) * 64, k0 = (tl / ntn) * 64;
DEV void prep_weights(const Prm& p, float* sm, int vb_first, int vb_end, int bidx, int nblk) {
    const int tid = opaque_tid();
    constexpr int TPL = (NIN / 64) * 16 + 16 * 16 + (NGU / 64) * 16 + 16 * (DFF / 64);
    static_assert(TPL == 2944, "tile counts");
    for (int vb = vb_first + bidx; vb < vb_end; vb += nblk) {
        float4 v[8];
#pragma unroll
        for (int q = 0; q < 4; ++q) {
            WDESC(vb * 4 + q)
#pragma unroll
            for (int i = 0; i < 2; ++i) { const int idx = tid + 512 * i, k = idx >> 4, n4 = (idx & 15) * 4; const int sc = srccol(mode, n0 + n4);
                float4 x = make_float4(0.f, 0.f, 0.f, 0.f);
                if (sc >= 0) { x = *(const float4*)(src + (size_t)(k0 + k) * Ns + sc); if (gain) { const float gk = gain[k0 + k]; x.x *= gk; x.y *= gk; x.z *= gk; x.w *= gk; } }
                v[q * 2 + i] = x; }
            (void)dst; (void)K;
        }
        __syncthreads();
#pragma unroll
        for (int q = 0; q < 4; ++q)
#pragma unroll
            for (int i = 0; i < 2; ++i) { const int idx = tid + 512 * i, k = idx >> 4, n4 = (idx & 15) * 4; float* t = sm + q * (64 * 65) + k * 65 + n4; t[0] = v[q * 2 + i].x; t[1] = v[q * 2 + i].y; t[2] = v[q * 2 + i].z; t[3] = v[q * 2 + i].w; }
        __syncthreads();
#pragma unroll
        for (int q = 0; q < 4; ++q) {
            WDESC(vb * 4 + q)
            const int k8 = tid & 7, n = tid >> 3; const float* t = sm + q * (64 * 65) + (8 * k8) * 65 + n;
            uint4 w; w.x = pack2(t[0], t[65]); w.y = pack2(t[130], t[195]); w.z = pack2(t[260], t[325]); w.w = pack2(t[390], t[455]);
            *(uint4*)(dst + (size_t)(n0 + n) * K + k0 + 8 * k8) = w;
            (void)src; (void)gain; (void)Ns; (void)mode;
        }
    }
}
#undef WDESC
DEV float cb_val(const float* cb, int i) { return ((cb[i] + cb[256 + i]) + cb[512 + i]) + cb[768 + i]; }
DEV void phase_prep(const Prm& p, float* sm) {
    const int tid = opaque_tid(); const size_t gt = (size_t)blockIdx.x * NTHR + tid, gn = (size_t)gridDim.x * NTHR;
    for (size_t base = gt; base < (size_t)2 * 2 * 128 * 1024; base += gn * 4) {
        float v[4];
#pragma unroll
        for (int i = 0; i < 4; ++i) { const size_t idx = base + gn * i; v[i] = 0.f;
            if (idx < (size_t)2 * 2 * 128 * 1024) { const int k = idx & 1023, n = (idx >> 10) & 127, type = (idx >> 17) & 1, l = (int)(idx >> 18);
                const float* src = (type ? p.wv : p.wk) + (size_t)l * 32 * 64 * 64; const int half = n >> 6, e = n & 63; v[i] = src[(size_t)(half * 1024 + k) * 64 + e]; } }
#pragma unroll
        for (int i = 0; i < 4; ++i) { const size_t idx = base + gn * i; if (idx < (size_t)2 * 2 * 128 * 1024) p.Wct[idx] = f2bf(v[i]); }
    }
    if ((int)blockIdx.x >= (int)gridDim.x - 16) {
        const int wq = (int)blockIdx.x - ((int)gridDim.x - 16), lt = wq >> 2, qk = wq & 3, l = lt >> 1, type = lt & 1, e = tid & 63, kq = tid >> 6;
        const float* w = (type ? p.wv : p.wk) + (size_t)l * 32 * 64 * 64; const float* pe = (type ? p.pe_v : p.pe_k) + (size_t)l * 32 * 64;
        float acc = 0.f;
#pragma unroll 1
        for (int k0 = qk * 512 + kq * 64; k0 < qk * 512 + kq * 64 + 64; k0 += 64) {
            float wv[64];
#pragma unroll
            for (int i = 0; i < 64; ++i) wv[i] = w[(size_t)(k0 + i) * 64 + e];
#pragma unroll
            for (int i = 0; i < 64; ++i) acc += pe[k0 + i] * wv[i];
        }
        sm[tid] = acc; __syncthreads();
        if (tid < 64) { float a = 0.f; for (int q = 0; q < 8; ++q) a += sm[q * 64 + tid]; p.cb[qk * 256 + lt * 64 + tid] = a; }
        __syncthreads(); }
    if (gt < 1024) { const int dist = (int)gt & 127, gr = (int)gt >> 7; p.BIASL2[gt] = p.rel_bias[kBucket[dist] * 8 + gr] * LOG2E; }
    {
        const int wv = tid >> 6, lane = tid & 63;
        for (int m0 = (blockIdx.x * 8 + wv) * 2; m0 < M_; m0 += gridDim.x * 16) {
            float4 v[2][4];
#pragma unroll
            for (int rr = 0; rr < 2; ++rr) { const int m = m0 + rr; const float* x = m < MP ? p.x_prompt + (size_t)m * D_ : p.x_sample + (size_t)(m - MP) * D_;
#pragma unroll
                for (int i = 0; i < 4; ++i) v[rr][i] = *(const float4*)(x + i * 256 + lane * 4); }
#pragma unroll
            for (int rr = 0; rr < 2; ++rr) { const int m = m0 + rr; float sq = 0.f;
#pragma unroll
                for (int i = 0; i < 4; ++i) { const float4 a = v[rr][i]; sq += (a.x * a.x + a.y * a.y) + (a.z * a.z + a.w * a.w); uint2 w; w.x = pack2(a.x, a.y); w.y = pack2(a.z, a.w); *(uint2*)(p.XB + (size_t)m * D_ + i * 256 + lane * 4) = w; }
                sq = wave_sum(sq);
                if (lane < 16) p.SSb[(size_t)m * 16 + lane] = lane == 0 ? sq : 0.f; }
        }
    }
    prep_weights(p, sm, 0, 576 / 4, (int)blockIdx.x, (int)gridDim.x);
}
DEV float row_rs(const float* SS, int m) {
    const float4* q = (const float4*)(SS + (size_t)m * 16); const float4 a = q[0], b = q[1], c = q[2], d = q[3];
    float s = 0.f; s += a.x; s += a.y; s += a.z; s += a.w; s += b.x; s += b.y; s += b.z; s += b.w; s += c.x; s += c.y; s += c.z; s += c.w; s += d.x; s += d.y; s += d.z; s += d.w;
    return rsqrtf(s * (1.f / 1024.f) + 1e-6f); }
DEV void st8f(float* dst, const float (&v)[8]) { *(float4*)dst = make_float4(v[0], v[1], v[2], v[3]); *(float4*)(dst + 4) = make_float4(v[4], v[5], v[6], v[7]); }
DEV void st8b(bf16_t* dst, const float (&v)[8]) { uint4 w; w.x = pack2(v[0], v[1]); w.y = pack2(v[2], v[3]); w.z = pack2(v[4], v[5]); w.w = pack2(v[6], v[7]); *(uint4*)dst = w; }

struct EpiIn {
    static constexpr bool HAS_SS = false, USE_RS = true, HAS_AUX = false;
    const Prm& p; int l; float* ss;
    DEV const float* ss_src() const { return p.SSb; }
    DEV float apply(int m, int pn, int j, const float (&lo_)[8], const float (&hi_)[8], float rs) const {
        float lo[8], hi[8];
#pragma unroll
        for (int i = 0; i < 8; ++i) { lo[i] = lo_[i] * rs; hi[i] = hi_[i] * rs; }
        const bool samp = m >= MP; const int b = m / T_, t = m % T_, req = (m - MP) >> 2, s = (m - MP) & 3;
        if (pn < 2) {
            float g[8];
#pragma unroll
            for (int i = 0; i < 8; ++i) g[i] = lo[i] * sigmoidf_(hi[i]);
            const int c = 128 * pn + j;
            st8f(p.G + (size_t)m * 256 + c, g);
            if (!samp) { if (t >= T_ - 30) st8f(p.out + O_CONVP + ((size_t)(l * NB_ + b) * 30 + (t - (T_ - 30))) * 256 + c, g); }
            else st8f(p.out + O_CONVS + ((size_t)(l * NREQ + req) * 30 + 26 + s) * 256 + c, g);
        } else if (pn == 2) {
            st8f(p.U + (size_t)m * 256 + j, lo); st8f(p.U + (size_t)m * 256 + 128 + j, hi);
            if (!samp) { if (t >= T_ - 15) { float* o = p.out + O_POOLP + ((size_t)(l * NB_ + b) * 15 + (t - (T_ - 15))) * 256; st8f(o + j, lo); st8f(o + 128 + j, hi); } }
            else { float* o = p.out + O_POOLS + ((size_t)(l * NREQ + req) * 15 + 11 + s) * 256; st8f(o + j, lo); st8f(o + 128 + j, hi); }
        } else if (pn < 5) {
            const int g = pn - 3; float a[8], c[8];
#pragma unroll
            for (int i = 0; i < 8; ++i) { a[i] = lo[i] * QSCALE; c[i] = hi[i] * QSCALE; }
            st8b(p.Q + (size_t)m * 512 + g * 256 + j, a); st8b(p.Q + (size_t)m * 512 + g * 256 + 128 + j, c);
        } else if (pn < 8) {
            const int br = pn - 5, g = j >> 6, d = j & 63;
            long long oo;
            if (!samp) oo = br == 0 ? (long long)(O_CMPP + ((size_t)(l * NB_ + b) * T_ + t) * 256) : (br == 1 ? (long long)(O_SLCP + ((size_t)(l * NB_ + b) * T_ + t) * 256)
                          : (t >= T_ - 512 ? (long long)(O_WINP + ((size_t)(l * NB_ + b) * 512 + (t - (T_ - 512))) * 256) : -1ll));
            else oo = br == 0 ? (long long)(O_CMPS + ((size_t)(l * NREQ + req) * 4 + s) * 256) : (br == 1 ? (long long)(O_SLCS + ((size_t)(l * NREQ + req) * 4 + s) * 256)
                          : (long long)(O_WINS + ((size_t)(l * NREQ + req) * 512 + 508 + s) * 256));
            if (oo >= 0) { st8f(p.out + oo + j, lo); st8f(p.out + oo + 128 + j, hi); }
            if (!samp) {
                bf16_t* kb = p.KVB + ((((size_t)(br * 2) * NB_ + b) * 2 + g) * T_ + t) * 64 + d;
                st8b(kb, lo); st8b(kb + (size_t)NB_ * 2 * T_ * 64, hi);
            }
        } else {
            if (j < 24) {
#pragma unroll
                for (int i = 0; i < 8; ++i) p.GATES[(size_t)m * 24 + j + i] = sigmoidf_(lo[i]);
            }
        }
        return 0.f;
    }
};
struct EpiRes {
    static constexpr bool HAS_SS = true, USE_RS = false, HAS_AUX = true;
    const Prm& p; int mode;
    float* ss; bool keep_f32;
    struct Aux { float4 r0, r1, r2, r3; };
    DEV Aux fetch(int m, int pn, int j) const {
        const int c = pn * 256 + j; Aux a;
        if (mode == 0) {
            const float* rb = (m < MP ? p.x_prompt + (size_t)m * D_ : p.x_sample + (size_t)(m - MP) * D_) + c;
            a.r0 = *(const float4*)(rb); a.r1 = *(const float4*)(rb + 4); a.r2 = *(const float4*)(rb + 128); a.r3 = *(const float4*)(rb + 132);
        } else {
            const bf16_t* rb = p.XB + (size_t)m * D_ + c; const uint4 u = *(const uint4*)rb, v = *(const uint4*)(rb + 128);
            a.r0 = make_float4(__uint_as_float(u.x << 16), __uint_as_float(u.x & 0xffff0000u), __uint_as_float(u.y << 16), __uint_as_float(u.y & 0xffff0000u));
            a.r1 = make_float4(__uint_as_float(u.z << 16), __uint_as_float(u.z & 0xffff0000u), __uint_as_float(u.w << 16), __uint_as_float(u.w & 0xffff0000u));
            a.r2 = make_float4(__uint_as_float(v.x << 16), __uint_as_float(v.x & 0xffff0000u), __uint_as_float(v.y << 16), __uint_as_float(v.y & 0xffff0000u));
            a.r3 = make_float4(__uint_as_float(v.z << 16), __uint_as_float(v.z & 0xffff0000u), __uint_as_float(v.w << 16), __uint_as_float(v.w & 0xffff0000u));
        }
        return a;
    }
    DEV float apply(int m, int pn, int j, const float (&lo)[8], const float (&hi)[8]) const { return apply(m, pn, j, lo, hi, fetch(m, pn, j)); }
    DEV float apply(int m, int pn, int j, const float (&lo)[8], const float (&hi)[8], const Aux& ax) const {
        const int c = pn * 256 + j;
        float a[8], h[8]; float sq = 0.f;
        const float4 r0 = ax.r0, r1 = ax.r1, r2 = ax.r2, r3 = ax.r3;
        a[0] = lo[0] + r0.x; a[1] = lo[1] + r0.y; a[2] = lo[2] + r0.z; a[3] = lo[3] + r0.w; a[4] = lo[4] + r1.x; a[5] = lo[5] + r1.y; a[6] = lo[6] + r1.z; a[7] = lo[7] + r1.w;
        h[0] = hi[0] + r2.x; h[1] = hi[1] + r2.y; h[2] = hi[2] + r2.z; h[3] = hi[3] + r2.w; h[4] = hi[4] + r3.x; h[5] = hi[5] + r3.y; h[6] = hi[6] + r3.z; h[7] = hi[7] + r3.w;
#pragma unroll
        for (int i = 0; i < 8; ++i) sq += a[i] * a[i] + h[i] * h[i];
        st8b(p.XB + (size_t)m * D_ + c, a); st8b(p.XB + (size_t)m * D_ + c + 128, h);
        return sq;
    }
};
struct EpiGU {
    static constexpr bool HAS_SS = false, USE_RS = true, HAS_AUX = false;
    const Prm& p; float* ss;
    DEV const float* ss_src() const { return p.SSa; }
    DEV float apply(int m, int pn, int j, const float (&lo)[8], const float (&hi)[8], float rs) const {
        float a[8];
#pragma unroll
        for (int i = 0; i < 8; ++i) { const float g = lo[i] * rs, u = hi[i] * rs; a[i] = g * sigmoidf_(g) * u; }
        st8b(p.ACT + (size_t)m * DFF + pn * 128 + j, a);
        return 0.f;
    }
};

namespace pg8 {
#define PG8_LAS __attribute__((address_space(3)))
using ::bf16_t;
typedef short bf16x8 __attribute__((ext_vector_type(8)));
typedef float f32x4 __attribute__((ext_vector_type(4)));
typedef unsigned u32x4 __attribute__((ext_vector_type(4)));
constexpr int BM = 256, BK = 64, HALF = 128, HTB = HALF * BK * 2  , STAGE_BYTES = 8 * HTB, NXCD = 8, WGM = 8;

__host__ __device__ __forceinline__ int lds_byte(int r, int c) { const int st = (r >> 4) * 2 + (c >> 5), rr = r & 15, cc = c & 31, ob = rr * 64 + cc * 2; return st * 1024 + (ob ^ (((ob >> 9) & 1) << 5)); }
__host__ __device__ __forceinline__ void stage_rc(int b, int& R, int& C) { const int st = b / 1024, sb = b % 1024, swz = sb ^ (((sb >> 9) & 1) << 5); R = (st >> 1) * 16 + swz / 64; C = (st & 1) * 32 + (swz % 64) / 2; }
__host__ __device__ __forceinline__ int perm32(int rho) { const int n = rho >> 4, i = rho & 15; return 8 * (i >> 2) + 4 * n + (i & 3); }

struct Unit { int pm, pn, kq; };
struct Gemm { const bf16_t* A; const bf16_t* Bt; int M, N, K, Kl; };

struct StaticOrder {
    int nM, nN, nwg, G, c;
    __host__ __device__ void init(int M, int N, int G_, int c_) { nM = M / BM; nN = N / BM; nwg = nM * nN; G = G_; c = c_; }
    __host__ __device__ bool next(int i, Unit& u) const {
        const long L = (long)i * G + c; if (L >= nwg) return false;
        int wgid = (int)L; { const int q = nwg / NXCD, r = nwg % NXCD, xcd = wgid % NXCD, off = wgid / NXCD; wgid = (xcd < r ? xcd * (q + 1) : r * (q + 1) + (xcd - r) * q) + off; }
        const int nig = WGM * nN, gid = wgid / nig, fm = gid * WGM, gsz = (nM - fm) < WGM ? (nM - fm) : WGM;
        u.pm = fm + ((wgid % nig) % gsz); u.pn = (wgid % nig) / gsz; u.kq = 0; return true;
    }
    __device__ __forceinline__ void a_ready(const Unit&) const {}
    __device__ __forceinline__ void done(const Unit&) const {}
};

template <class Epi, class Sched, bool ALIGN_EPI = false, bool SP2 = false>
__device__ __forceinline__ void gemm_phase(PG8_LAS unsigned char* lds, const Gemm g, const Sched& S, const Epi& E) {
    const int tid = opaque_tid(), wid = __builtin_amdgcn_readfirstlane(tid >> 6), lane = tid & 63, wr = wid >> 2, wc = wid & 3, fr = lane & 15, fq = lane >> 4;
    const int K = g.K, nt = g.Kl / BK;
    unsigned voffA[2], voffB[2];
#pragma unroll
    for (int i = 0; i < 2; ++i) { int R, C; stage_rc(tid * 16 + i * 8192, R, C); const int Rb = Epi::PERM ? ((R & ~31) + perm32(R & 31)) : R;
        voffA[i] = (unsigned)(R * K + C) * 2u; voffB[i] = (unsigned)(Rb * K + C) * 2u; }
    const size_t kstep = (size_t)(BK * 2);
    const size_t hstep = (size_t)HALF * K * 2;
    const size_t tstep = 2 * hstep;
    const unsigned ldsw = (unsigned)wid * 1024u;
    const int aoff = lds_byte(wr * 64 + fr, fq * 8), boff = lds_byte(wc * 32 + fr, fq * 8);
#define PG8_SA(b, h) (((b) * 2 + (h)) * HTB)
#define PG8_SB(b, h) ((4 + (b) * 2 + (h)) * HTB)
#define PG8_STAGE(bufoff, gbase, voff) do { _Pragma("unroll") for (int _i = 0; _i < 2; ++_i) \
        __builtin_amdgcn_global_load_lds((const unsigned*)((const char*)(gbase) + (voff)[_i]), (PG8_LAS unsigned*)(lds + (bufoff) + ldsw + _i * 8192), 16, 0, 0); } while (0)
#define PG8_LDA(dst, b, h) do { _Pragma("unroll") for (int m = 0; m < 4; ++m) _Pragma("unroll") for (int k = 0; k < 2; ++k) dst[m][k] = *(const PG8_LAS bf16x8*)(lds + PG8_SA(b, h) + aoff + m * 2048 + k * 1024); } while (0)
#define PG8_LDB(dst, b, h) do { _Pragma("unroll") for (int n = 0; n < 2; ++n) _Pragma("unroll") for (int k = 0; k < 2; ++k) dst[n][k] = *(const PG8_LAS bf16x8*)(lds + PG8_SB(b, h) + boff + n * 2048 + k * 1024); } while (0)
#define PG8_MMA(ai, bj, At, Bt) do { __builtin_amdgcn_s_setprio(1); _Pragma("unroll") for (int m = 0; m < 4; ++m) _Pragma("unroll") for (int n = 0; n < 2; ++n) _Pragma("unroll") for (int k = 0; k < 2; ++k) \
        acc[ai][bj][m][n] = __builtin_amdgcn_mfma_f32_16x16x32_bf16(Bt[n][k], At[m][k], acc[ai][bj][m][n], 0, 0, 0); __builtin_amdgcn_s_setprio(0); } while (0)
#define PG8_WAIT_V(n) asm volatile("s_waitcnt vmcnt(" #n ")" ::: "memory")
#define PG8_WAIT_L(n) asm volatile("s_waitcnt lgkmcnt(" #n ")" ::: "memory")
#define PG8_BAR __builtin_amdgcn_s_barrier()
#define PG8_SCHED __builtin_amdgcn_sched_barrier(0)
    Unit cur, nxt; int ui = 0;
    if (!S.next(0, cur)) return;
    f32x4 acc[2][2][4][2];
#pragma unroll
    for (int a = 0; a < 2; ++a)
#pragma unroll
        for (int b = 0; b < 2; ++b)
#pragma unroll
            for (int m = 0; m < 4; ++m)
#pragma unroll
                for (int n = 0; n < 2; ++n) acc[a][b][m][n] = (f32x4){0.f, 0.f, 0.f, 0.f};
    bf16x8 At[4][2], B0[2][2], B1[2][2];
    const unsigned kqb = (unsigned)g.Kl * 2u;
    const char* cA = (const char*)g.A + (size_t)cur.pm * tstep + (unsigned)cur.kq * kqb; const char* cB = (const char*)g.Bt + (size_t)cur.pn * tstep + (unsigned)cur.kq * kqb;
    S.a_ready(cur);
    if constexpr (SP2) {
        PG8_STAGE(PG8_SB(0, 0), cB, voffB); PG8_STAGE(PG8_SB(0, 1), cB + hstep, voffB); PG8_STAGE(PG8_SA(0, 0), cA, voffA); PG8_STAGE(PG8_SA(0, 1), cA + hstep, voffA);
        if (wr == 1) PG8_BAR;
        PG8_WAIT_V(2); PG8_BAR;
        PG8_STAGE(PG8_SB(1, 0), cB + kstep, voffB); PG8_STAGE(PG8_SA(1, 0), cA + kstep, voffA); PG8_STAGE(PG8_SB(1, 1), cB + hstep + kstep, voffB);
        PG8_WAIT_V(6); PG8_BAR;
    } else {
        PG8_STAGE(PG8_SB(0, 0), cB, voffB); PG8_STAGE(PG8_SA(0, 0), cA, voffA); PG8_STAGE(PG8_SB(0, 1), cB + hstep, voffB); PG8_STAGE(PG8_SA(0, 1), cA + hstep, voffA);
        if (wr == 1) PG8_BAR;
        PG8_WAIT_V(4); PG8_BAR;
        PG8_STAGE(PG8_SB(1, 0), cB + kstep, voffB); PG8_STAGE(PG8_SA(1, 0), cA + kstep, voffA); PG8_STAGE(PG8_SB(1, 1), cB + hstep + kstep, voffB);
        PG8_WAIT_V(6); PG8_BAR;
    }
    for (;;) {
        const bool has_next = S.next(ui + 1, nxt);
        const char* nA = has_next ? (const char*)g.A + (size_t)nxt.pm * tstep + (unsigned)nxt.kq * kqb : cA; const char* nB = has_next ? (const char*)g.Bt + (size_t)nxt.pn * tstep + (unsigned)nxt.kq * kqb : cB;
        for (int t = 0; t < nt; t += 2) {
            const bool last = (t == nt - 2);
            const char* a1 = cA + (size_t)(t + 1) * kstep;
            const char* a2 = last ? nA : cA + (size_t)(t + 2) * kstep; const char* b2 = last ? nB : cB + (size_t)(t + 2) * kstep;
            const char* a3 = a2 + kstep; const char* b3 = b2 + kstep;
            if (last && has_next) S.a_ready(nxt);
            if constexpr (SP2) {
            PG8_LDB(B0, 0, 0); PG8_LDB(B1, 0, 1); PG8_SCHED; PG8_LDA(At, 0, 0); PG8_STAGE(PG8_SA(1, 1), a1 + hstep, voffA);
            PG8_WAIT_V(8); PG8_WAIT_L(0); PG8_BAR; PG8_MMA(0, 0, At, B0); PG8_MMA(0, 1, At, B1); PG8_BAR; PG8_SCHED;
            PG8_LDA(At, 0, 1); PG8_STAGE(PG8_SB(0, 0), b2, voffB); PG8_STAGE(PG8_SB(0, 1), b2 + hstep, voffB); PG8_STAGE(PG8_SA(0, 0), a2, voffA);
            PG8_WAIT_V(8); PG8_WAIT_L(0); PG8_BAR; PG8_MMA(1, 0, At, B0); PG8_MMA(1, 1, At, B1); PG8_BAR; PG8_SCHED;
            PG8_LDB(B0, 1, 0); PG8_LDB(B1, 1, 1); PG8_SCHED; PG8_LDA(At, 1, 0); PG8_STAGE(PG8_SA(0, 1), a2 + hstep, voffA);
            PG8_WAIT_V(8); PG8_WAIT_L(0); PG8_BAR; PG8_MMA(0, 0, At, B0); PG8_MMA(0, 1, At, B1); PG8_BAR; PG8_SCHED;
            PG8_LDA(At, 1, 1); PG8_STAGE(PG8_SB(1, 0), b3, voffB); PG8_STAGE(PG8_SB(1, 1), b3 + hstep, voffB); PG8_STAGE(PG8_SA(1, 0), a3, voffA);
            PG8_WAIT_V(8); PG8_WAIT_L(0); PG8_BAR; PG8_MMA(1, 0, At, B0); PG8_MMA(1, 1, At, B1); PG8_BAR; PG8_SCHED;
            } else {
            PG8_LDB(B0, 0, 0); PG8_SCHED; PG8_LDA(At, 0, 0); PG8_STAGE(PG8_SA(1, 1), a1 + hstep, voffA);
            PG8_WAIT_L(8); PG8_BAR; PG8_WAIT_L(0); PG8_MMA(0, 0, At, B0); PG8_BAR; PG8_SCHED;
            PG8_LDB(B1, 0, 1); PG8_STAGE(PG8_SB(0, 0), b2, voffB);
            PG8_BAR; PG8_WAIT_L(0); PG8_MMA(0, 1, At, B1); PG8_BAR;
            PG8_LDA(At, 0, 1); PG8_STAGE(PG8_SA(0, 0), a2, voffA);
            PG8_BAR; PG8_WAIT_L(0); PG8_MMA(1, 0, At, B0); PG8_BAR; PG8_SCHED;
            PG8_STAGE(PG8_SB(0, 1), b2 + hstep, voffB);
            PG8_WAIT_V(6); PG8_BAR; PG8_MMA(1, 1, At, B1); PG8_BAR;
            PG8_LDB(B0, 1, 0); PG8_SCHED; PG8_LDA(At, 1, 0); PG8_STAGE(PG8_SA(0, 1), a2 + hstep, voffA);
            PG8_WAIT_L(8); PG8_BAR; PG8_WAIT_L(0); PG8_MMA(0, 0, At, B0); PG8_BAR; PG8_SCHED;
            PG8_LDB(B1, 1, 1); PG8_STAGE(PG8_SB(1, 0), b3, voffB);
            PG8_BAR; PG8_WAIT_L(0); PG8_MMA(0, 1, At, B1); PG8_BAR;
            PG8_LDA(At, 1, 1); PG8_STAGE(PG8_SA(1, 0), a3, voffA);
            PG8_BAR; PG8_WAIT_L(0); PG8_MMA(1, 0, At, B0); PG8_BAR; PG8_SCHED;
            PG8_STAGE(PG8_SB(1, 1), b3 + hstep, voffB);
            PG8_WAIT_V(6); PG8_BAR; PG8_MMA(1, 1, At, B1); PG8_BAR;
            }
        }
        if constexpr (ALIGN_EPI) { if (wr == 0) PG8_BAR; }
        if constexpr (!Epi::AFTER_DRAIN) { E(acc, cur, wr, wc, fr, fq); S.done(cur); }
        if (!has_next) break;
#pragma unroll
        for (int a = 0; a < 2; ++a)
#pragma unroll
            for (int b = 0; b < 2; ++b)
#pragma unroll
                for (int m = 0; m < 4; ++m)
#pragma unroll
                    for (int n = 0; n < 2; ++n) acc[a][b][m][n] = (f32x4){0.f, 0.f, 0.f, 0.f};
        cur = nxt; cA = nA; cB = nB; ++ui;
        if constexpr (ALIGN_EPI) { if (wr == 1) PG8_BAR; }
    }
    PG8_WAIT_V(0);
    if constexpr (!ALIGN_EPI) { if (wr == 0) PG8_BAR; }
    PG8_BAR;
    if constexpr (Epi::AFTER_DRAIN) { E.fused(acc, cur, wr, wc, fr, fq, lds, wid, lane); S.done(cur); }
#undef PG8_SA
#undef PG8_SB
#undef PG8_STAGE
#undef PG8_LDA
#undef PG8_LDB
#undef PG8_MMA
#undef PG8_WAIT_V
#undef PG8_WAIT_L
#undef PG8_BAR
#undef PG8_SCHED
}
}

constexpr int RSL_OFF = 131072;
template <class E> struct EpiAdapt {
    static constexpr bool PERM = true, AFTER_DRAIN = false;
    const E& e; const float* rsl; mutable int ui;
    __device__ __forceinline__ void operator()(const pg8::f32x4 (&acc)[2][2][4][2], const pg8::Unit& u, int wr, int wc, int fr, int fq) const {
        const int j = wc * 32 + 8 * fq;
        float rsv[2][4];
        if constexpr (E::USE_RS) {
#pragma unroll
            for (int ai = 0; ai < 2; ++ai)
#pragma unroll
                for (int m = 0; m < 4; ++m) rsv[ai][m] = rsl[ui * 256 + ai * 128 + wr * 64 + m * 16 + fr];
        }
        if constexpr (E::HAS_AUX) {
            int row = u.pm * 256 + wr * 64 + fr; asm volatile("" : "+v"(row));
            typename E::Aux nx = e.fetch(row, u.pn, j);
#pragma unroll
            for (int g = 0; g < 8; ++g) {
                const int ai = g >> 2, m = g & 3;
                const typename E::Aux cu = nx;
                if (g < 7) { int rn = u.pm * 256 + ((g + 1) >> 2) * 128 + wr * 64 + ((g + 1) & 3) * 16 + fr; asm volatile("" : "+v"(rn)); nx = e.fetch(rn, u.pn, j); }
                float lo[8], hi[8];
#pragma unroll
                for (int i = 0; i < 4; ++i) { lo[i] = acc[ai][0][m][0][i]; lo[4 + i] = acc[ai][0][m][1][i]; hi[i] = acc[ai][1][m][0][i]; hi[4 + i] = acc[ai][1][m][1][i]; }
                float sq = e.apply(row, u.pn, j, lo, hi, cu);
                if (E::HAS_SS) { sq += __shfl_xor(sq, 16); sq += __shfl_xor(sq, 32); if (fq == 0) e.ss[(size_t)row * 16 + u.pn * 4 + wc] = sq; }
                row = u.pm * 256 + ((g + 1) >> 2) * 128 + wr * 64 + ((g + 1) & 3) * 16 + fr; asm volatile("" : "+v"(row));
            }
        } else {
#pragma unroll
            for (int ai = 0; ai < 2; ++ai)
#pragma unroll
                for (int m = 0; m < 4; ++m) {
                    int row = u.pm * 256 + ai * 128 + wr * 64 + m * 16 + fr;
                    asm volatile("" : "+v"(row));
                    float lo[8], hi[8];
#pragma unroll
                    for (int i = 0; i < 4; ++i) { lo[i] = acc[ai][0][m][0][i]; lo[4 + i] = acc[ai][0][m][1][i]; hi[i] = acc[ai][1][m][0][i]; hi[4 + i] = acc[ai][1][m][1][i]; }
                    float sq = e.apply(row, u.pn, j, lo, hi, rsv[ai][m]);
                    if (E::HAS_SS) { sq += __shfl_xor(sq, 16); sq += __shfl_xor(sq, 32); if (fq == 0) e.ss[(size_t)row * 16 + u.pn * 4 + wc] = sq; }
                }
        }
        ++ui;
    }
};
template <class E> DEV void gemm_fast(unsigned char* lds, const bf16_t* A, const bf16_t* Bt, int M, int N, int K, const E& e) {
    pg8::Gemm g{A, Bt, M, N, K, K}; pg8::StaticOrder S; S.init(M, N, (int)gridDim.x, (int)blockIdx.x);
    const float* rsl = (const float*)(lds + RSL_OFF);
    if constexpr (E::USE_RS) {
        const int tid = opaque_tid(); pg8::Unit u;
        __syncthreads();
        for (int i = tid >> 8; S.next(i, u); i += 2) ((float*)(lds + RSL_OFF))[i * 256 + (tid & 255)] = row_rs(e.ss_src(), u.pm * 256 + (tid & 255));
        __syncthreads();
    }
    EpiAdapt<E> ad{e, rsl, 0};
    pg8::gemm_phase<EpiAdapt<E>, pg8::StaticOrder, true, true>((PG8_LAS unsigned char*)lds, g, S, ad);
}

struct SplitOrder {
    int npn, nkq, G, c;
    __device__ bool next(int i, pg8::Unit& u) const { const long L = (long)i * G + (G - 1 - c); if (L >= 2L * npn * nkq) return false; const int x = (int)L; u.pm = MP / 256 + (x & 1); u.pn = (x >> 1) % npn; u.kq = (x >> 1) / npn; return true; }
    __device__ __forceinline__ void a_ready(const pg8::Unit&) const {}
    __device__ __forceinline__ void done(const pg8::Unit&) const {}
};
struct EpiPartial {
    static constexpr bool PERM = true, AFTER_DRAIN = false;
    float* slab; int N;
    __device__ __forceinline__ void operator()(const pg8::f32x4 (&acc)[2][2][4][2], const pg8::Unit& u, int wr, int wc, int fr, int fq) const {
        const int j = wc * 32 + 8 * fq;
#pragma unroll
        for (int ai = 0; ai < 2; ++ai)
#pragma unroll
            for (int m = 0; m < 4; ++m) {
                const int rs = (u.pm - MP / 256) * 256 + ai * 128 + wr * 64 + m * 16 + fr;
                float* o = slab + ((size_t)u.kq * MS + rs) * N + u.pn * 256 + j;
                *(pg8::f32x4*)(o) = acc[ai][0][m][0]; *(pg8::f32x4*)(o + 4) = acc[ai][0][m][1]; *(pg8::f32x4*)(o + 128) = acc[ai][1][m][0]; *(pg8::f32x4*)(o + 132) = acc[ai][1][m][1];
            }
    }
};
DEV void gemm_split(unsigned char* lds, const bf16_t* A, const bf16_t* Bt, int N, int K, int Kl, float* slab) {
    pg8::Gemm g{A, Bt, M_, N, K, Kl}; SplitOrder S{N / 256, K / Kl, (int)gridDim.x, (int)blockIdx.x};
    EpiPartial ep{slab, N};
    pg8::gemm_phase<EpiPartial, SplitOrder, false, false>((PG8_LAS unsigned char*)lds, g, S, ep);
}
template <class E> DEV void gemm_reduce(const float* slab, int N, int nkq, const E& e) {
    const int ntn = N / 256, total = MS * ntn * 16;
    for (int gid = blockIdx.x * NTHR + opaque_tid(); gid < total; gid += gridDim.x * NTHR) {
        const int jj = gid & 15, pn = (gid >> 4) % ntn, rs = (gid >> 4) / ntn, j = jj * 8;
        float lo[8], hi[8];
#pragma unroll
        for (int i = 0; i < 8; ++i) { lo[i] = 0.f; hi[i] = 0.f; }
#pragma unroll
        for (int kq = 0; kq < nkq; ++kq) {
            const float* o = slab + ((size_t)kq * MS + rs) * N + pn * 256 + j;
            const float4 a = *(const float4*)(o), b = *(const float4*)(o + 4), c = *(const float4*)(o + 128), d = *(const float4*)(o + 132);
            lo[0] += a.x; lo[1] += a.y; lo[2] += a.z; lo[3] += a.w; lo[4] += b.x; lo[5] += b.y; lo[6] += b.z; lo[7] += b.w;
            hi[0] += c.x; hi[1] += c.y; hi[2] += c.z; hi[3] += c.w; hi[4] += d.x; hi[5] += d.y; hi[6] += d.z; hi[7] += d.w;
        }
        float sq = e.apply(MP + rs, pn, j, lo, hi);
        if (E::HAS_SS) { sq += __shfl_xor(sq, 1); sq += __shfl_xor(sq, 2); if ((jj & 3) == 0) e.ss[(size_t)(MP + rs) * 16 + pn * 4 + (jj >> 2)] = sq; }
    }
}

DEV void gemm_reduce_final(const Prm& p, const float* slab, int nkq_) {
    constexpr int N = D_, ntn = N / 256, total = MS * ntn * 16, nkq = DFF / 256; (void)nkq_;
    for (int gid = blockIdx.x * NTHR + opaque_tid(); gid < total; gid += gridDim.x * NTHR) {
        const int jj = gid & 15, pn = (gid >> 4) % ntn, rs = (gid >> 4) / ntn, j = jj * 8, c = pn * 256 + j;
        float lo[8], hi[8];
#pragma unroll
        for (int i = 0; i < 8; ++i) { lo[i] = 0.f; hi[i] = 0.f; }
#pragma unroll
        for (int kq = 0; kq < nkq; ++kq) {
            const float* o = slab + ((size_t)kq * MS + rs) * N + c;
            const float4 a = *(const float4*)(o), b = *(const float4*)(o + 4), cc = *(const float4*)(o + 128), d = *(const float4*)(o + 132);
            lo[0] += a.x; lo[1] += a.y; lo[2] += a.z; lo[3] += a.w; lo[4] += b.x; lo[5] += b.y; lo[6] += b.z; lo[7] += b.w;
            hi[0] += cc.x; hi[1] += cc.y; hi[2] += cc.z; hi[3] += cc.w; hi[4] += d.x; hi[5] += d.y; hi[6] += d.z; hi[7] += d.w;
        }
        const bf16_t* rb = p.XB + (size_t)(MP + rs) * D_ + c; const uint4 u = *(const uint4*)rb, v = *(const uint4*)(rb + 128);
        const unsigned uu[4] = {u.x, u.y, u.z, u.w}, vv[4] = {v.x, v.y, v.z, v.w};
        float sq = 0.f;
#pragma unroll
        for (int i = 0; i < 4; ++i) { lo[2 * i] += __uint_as_float(uu[i] << 16); lo[2 * i + 1] += __uint_as_float(uu[i] & 0xffff0000u); hi[2 * i] += __uint_as_float(vv[i] << 16); hi[2 * i + 1] += __uint_as_float(vv[i] & 0xffff0000u); }
#pragma unroll
        for (int i = 0; i < 8; ++i) sq += lo[i] * lo[i] + hi[i] * hi[i];
        sq = wave_sum(sq);
        const float r = rsqrtf(sq * (1.f / 1024.f) + 1e-6f);
        const float* g = p.final_norm + c; float* y = p.out + (size_t)(MP + rs) * D_ + c;
        const float4 g0 = *(const float4*)(g), g1 = *(const float4*)(g + 4), g2 = *(const float4*)(g + 128), g3 = *(const float4*)(g + 132);
        *(float4*)(y) = make_float4(lo[0] * r * g0.x, lo[1] * r * g0.y, lo[2] * r * g0.z, lo[3] * r * g0.w); *(float4*)(y + 4) = make_float4(lo[4] * r * g1.x, lo[5] * r * g1.y, lo[6] * r * g1.z, lo[7] * r * g1.w);
        *(float4*)(y + 128) = make_float4(hi[0] * r * g2.x, hi[1] * r * g2.y, hi[2] * r * g2.z, hi[3] * r * g2.w); *(float4*)(y + 132) = make_float4(hi[4] * r * g3.x, hi[5] * r * g3.y, hi[6] * r * g3.z, hi[7] * r * g3.w);
    }
}

DEV void convpool_issue(const Prm& p, int l, int item, float4 (&vc)[8], float4 (&vp)[6]) {
    const int tid = opaque_tid();
    const bool samp = item >= 512; const int NT = samp ? 4 : 32;
    int m0, t0 = 0, req = 0;
    if (!samp) { m0 = item * 32; t0 = m0 % T_; } else { req = item - 512; m0 = MP + req * 4; }
#pragma unroll
    for (int i = 0; i < 8; ++i) { const int idx = tid + NTHR * i, r = idx >> 6, c4 = (idx & 63) * 4, rel = r - 30; float4 v = make_float4(0.f, 0.f, 0.f, 0.f);
        if (r < NT + 30) { if (!samp) { if (t0 + rel >= 0) v = *(const float4*)(p.G + (size_t)(m0 + rel) * 256 + c4); }
            else { if (rel < 0) v = *(const float4*)(p.state_conv + ((size_t)(l * NREQ + req) * 30 + r) * 256 + c4); else v = *(const float4*)(p.G + (size_t)(m0 + rel) * 256 + c4); } }
        vc[i] = v; }
#pragma unroll
    for (int i = 0; i < 6; ++i) { const int idx = tid + NTHR * i, r = idx >> 6, c4 = (idx & 63) * 4, rel = r - 15; float4 v = make_float4(0.f, 0.f, 0.f, 0.f);
        if (r < NT + 15) { if (!samp) { if (t0 + rel >= 0) v = *(const float4*)(p.U + (size_t)(m0 + rel) * 256 + c4); }
            else { if (rel < 0) v = *(const float4*)(p.state_pool + ((size_t)(l * NREQ + req) * 15 + r) * 256 + c4); else v = *(const float4*)(p.U + (size_t)(m0 + rel) * 256 + c4); } }
        vp[i] = v; }
}
DEV void convpool_item(const Prm& p, int l, int item, float* sm, float4 (&vc)[8], float4 (&vp)[6], int next_item) {
    float* cbuf = sm; float* pbuf = sm + 62 * 256; float* yb = sm + (62 + 47) * 256;
    const int tid = opaque_tid(), c = tid & 255, half = tid >> 8, wave = tid >> 6, lane = tid & 63;
    const bool samp = item >= 512; const int NT = samp ? 4 : 32, ntok = NT / 2;
    int m0, t0 = 0, req = 0;
    if (!samp) { m0 = item * 32; t0 = m0 % T_; } else { req = item - 512; m0 = MP + req * 4; }
    __syncthreads();
    {
#pragma unroll
        for (int i = 0; i < 8; ++i) { const int idx = tid + NTHR * i, r = idx >> 6, c4 = (idx & 63) * 4; if (r < NT + 30) *(float4*)(cbuf + r * 256 + c4) = vc[i]; }
#pragma unroll
        for (int i = 0; i < 6; ++i) { const int idx = tid + NTHR * i, r = idx >> 6, c4 = (idx & 63) * 4; if (r < NT + 15) *(float4*)(pbuf + r * 256 + c4) = vp[i]; }
        if (next_item >= 0) convpool_issue(p, l, next_item, vc, vp);
    }
    __syncthreads();
    {
        const float cbias = p.conv_b[l * 256 + c];
        float dw[31];
#pragma unroll
        for (int w = 0; w < 31; ++w) dw[w] = p.conv_dw[(size_t)(l * 31 + w) * 256 + c];
        const float* bp = cbuf + (half * ntok) * 256 + c;
        if (!samp) {
#pragma unroll 1
            for (int k4 = 0; k4 < 4; ++k4) {
                float a0 = cbias, a1 = cbias, a2 = cbias, a3 = cbias;
#pragma unroll
                for (int rr = 0; rr < 34; ++rr) {
                    const float v = bp[(k4 * 4 + rr) * 256];
                    if (rr < 31) a0 += v * dw[rr];
                    if (rr >= 1 && rr < 32) a1 += v * dw[rr - 1];
                    if (rr >= 2 && rr < 33) a2 += v * dw[rr - 2];
                    if (rr >= 3) a3 += v * dw[rr - 3];
                }
                float* yo = yb + (half * ntok + k4 * 4) * 256 + c; yo[0] = a0; yo[256] = a1; yo[512] = a2; yo[768] = a3;
            }
        } else {
            float a0 = cbias, a1 = cbias;
#pragma unroll
            for (int rr = 0; rr < 32; ++rr) { const float v = bp[rr * 256]; if (rr < 31) a0 += v * dw[rr]; if (rr >= 1) a1 += v * dw[rr - 1]; }
            float* yo = yb + (half * ntok) * 256 + c; yo[0] = a0; yo[256] = a1;
        }
    }
    if (samp) {
        for (int idx = tid; idx < 26 * 256; idx += NTHR) p.out[O_CONVS + ((size_t)(l * NREQ + req) * 30) * 256 + idx] = cbuf[4 * 256 + idx];
        for (int idx = tid; idx < 11 * 256; idx += NTHR) p.out[O_POOLS + ((size_t)(l * NREQ + req) * 15) * 256 + idx] = pbuf[4 * 256 + idx];
    }
    __syncthreads();
    for (int tok = wave; tok < NT; tok += 8) {
        const float4 v = *(const float4*)(yb + tok * 256 + lane * 4);
        const float mean = wave_sum((v.x + v.y) + (v.z + v.w)) * (1.f / 256.f);
        const float x0 = v.x - mean, x1 = v.y - mean, x2 = v.z - mean, x3 = v.w - mean;
        const float var = wave_sum((x0 * x0 + x1 * x1) + (x2 * x2 + x3 * x3)) * (1.f / 256.f);
        const float r = rsqrtf(var + 1e-6f);
        const float4 g = *(const float4*)(p.conv_ln_g + l * 256 + lane * 4), bb = *(const float4*)(p.conv_ln_b + l * 256 + lane * 4);
        float y0 = x0 * r * g.x + bb.x, y1 = x1 * r * g.y + bb.y, y2 = x2 * r * g.z + bb.z, y3 = x3 * r * g.w + bb.w;
        y0 *= sigmoidf_(y0); y1 *= sigmoidf_(y1); y2 *= sigmoidf_(y2); y3 *= sigmoidf_(y3);
        uint2 w; w.x = pack2(y0, y1); w.y = pack2(y2, y3);
        *(uint2*)(p.MIX + (size_t)(m0 + tok) * D_ + lane * 4) = w;
    }
    __syncthreads();
    {
        const int w = 2 << (c >> 6);
#pragma unroll 1
        for (int k = 0; k < ntok; ++k) {
            const int tok = half * ntok + k; float v[16];
#pragma unroll
            for (int i = 0; i < 16; ++i) v[i] = pbuf[(tok + 15 - i) * 256 + c];
            float sacc = v[0] + v[1];
#pragma unroll
            for (int i = 2; i < 16; ++i) sacc += i < w ? v[i] : 0.f;
            const int cnt = samp ? w : min(w, t0 + tok + 1);
            yb[tok * 256 + c] = sacc / (float)cnt - v[0];
        }
    }
    __syncthreads();
    {
        const int e = tid & 63, g = (tid >> 6) & 3; const float sc = p.pool_scale[l * 256 + g * 64 + e];
        const float* wp = p.pool_w + (size_t)(l * 4 + g) * 64 * 64 + e;
        float wr[64];
#pragma unroll
        for (int cc = 0; cc < 64; ++cc) wr[cc] = wp[cc * 64];
#pragma unroll 1
        for (int k = 0; k < ntok; ++k) {
            const int tok = half * ntok + k; float acc = 0.f; const float* yr = yb + tok * 256 + g * 64;
#pragma unroll
            for (int c4 = 0; c4 < 16; ++c4) { const float4 y = *(const float4*)(yr + c4 * 4); acc += y.x * wr[c4 * 4] + y.y * wr[c4 * 4 + 1] + y.z * wr[c4 * 4 + 2] + y.w * wr[c4 * 4 + 3]; }
            p.MIX[(size_t)(m0 + tok) * D_ + 256 + g * 64 + e] = f2bf(acc * sc);
        }
    }
}
typedef short bf16x8_t __attribute__((ext_vector_type(8)));
typedef short s16x4_t __attribute__((ext_vector_type(4)));
typedef float f32x16_t __attribute__((ext_vector_type(16)));
DEV unsigned off64(unsigned row, unsigned ch) { return 1024u * (row >> 3) + 512u * (ch >> 2) + 64u * (row & 7) + 16u * ((ch & 3) ^ ((row >> 2) & 3)); }
enum { AM_FAR = 0, AM_NEAR = 1, AM_DIAG = 2, AM_WINFIRST = 3, AM_CMP = 4 };
constexpr int AT_RING = 6, AT_KB = 0, AT_VB = AT_RING * 8192, AT_BT = 2 * AT_RING * 8192, AT_PA = AT_BT + 2048, AT_SELM = AT_PA + 32768, AT_LDS = AT_SELM + 512;
static_assert(AT_LDS <= LDS_BYTES - 16, "attention LDS map");

struct AttnState { f32x16_t O0, O1; float m, l; };

template <bool PRIO = false> DEV void attn_qk(const unsigned char* kb, unsigned ka0, const bf16x8_t (&qf)[4], f32x16_t& S0, f32x16_t& S1) {
#pragma unroll
    for (int i = 0; i < 16; ++i) { S0[i] = 0.f; S1[i] = 0.f; }
    if (PRIO) __builtin_amdgcn_s_setprio(1);
#pragma unroll
    for (int ks = 0; ks < 4; ++ks) {
        const unsigned a = (ka0 ^ ((ks & 1) ? 32u : 0u)) + 512u * (ks >> 1);
        const bf16x8_t a0 = *(const bf16x8_t*)(kb + a), a1 = *(const bf16x8_t*)(kb + a + 4096);
        S0 = __builtin_amdgcn_mfma_f32_32x32x16_bf16(a0, qf[ks], S0, 0, 0, 0);
        S1 = __builtin_amdgcn_mfma_f32_32x32x16_bf16(a1, qf[ks], S1, 0, 0, 0);
    }
    if (PRIO) __builtin_amdgcn_s_setprio(0);
}
template <bool PRIO = false> DEV void attn_pv(unsigned vbase, unsigned va_rel, const f32x16_t& pa, const f32x16_t& pb, f32x16_t& O0, f32x16_t& O1) {
    const unsigned vb_addr0 = vbase + va_rel, vb1 = vbase + (va_rel ^ 32u) + 1024u;
#pragma unroll
    for (int k4 = 0; k4 < 4; ++k4) {
        const f32x16_t& P = (k4 < 2) ? pa : pb; const int s = k4 & 1;
        unsigned w[4];
#pragma unroll
        for (int i = 0; i < 4; ++i) w[i] = cvt_pk_bf16(P[8 * s + 2 * i], P[8 * s + 2 * i + 1]);
        bf16x8_t pf; { typedef unsigned u32x4_t __attribute__((ext_vector_type(4))); u32x4_t t = {w[0], w[1], w[2], w[3]}; pf = __builtin_bit_cast(bf16x8_t, t); }
        s16x4_t v00, v01, v10, v11;
        asm volatile("ds_read_b64_tr_b16 %0, %4 offset:%6\n\tds_read_b64_tr_b16 %1, %5 offset:%6\n\tds_read_b64_tr_b16 %2, %4 offset:%7\n\tds_read_b64_tr_b16 %3, %5 offset:%7\n\ts_waitcnt lgkmcnt(0)"
                     : "=&v"(v00), "=&v"(v01), "=&v"(v10), "=&v"(v11) : "v"(vb_addr0), "v"(vb1), "i"(2048 * k4), "i"(2048 * k4 + 512) : "memory");
        const bf16x8_t a0 = __builtin_shufflevector(v00, v01, 0, 1, 2, 3, 4, 5, 6, 7), a1 = __builtin_shufflevector(v10, v11, 0, 1, 2, 3, 4, 5, 6, 7);
        if (PRIO) __builtin_amdgcn_s_setprio(1);
        O0 = __builtin_amdgcn_mfma_f32_32x32x16_bf16(a0, pf, O0, 0, 0, 0);
        O1 = __builtin_amdgcn_mfma_f32_32x32x16_bf16(a1, pf, O1, 0, 0, 0);
        if (PRIO) __builtin_amdgcn_s_setprio(0);
    }
}
template <int MODE> DEV void attn_bias(f32x16_t& S0, f32x16_t& S1, int dl, float lb, const float* bt_r) {
    constexpr int STEP = MODE == AM_CMP ? 16 : 1;
#pragma unroll
    for (int u = 0; u < 2; ++u)
#pragma unroll
        for (int v = 0; v < 16; ++v) {
            float s = u ? S1[v] : S0[v];
            const int dist = dl - STEP * (32 * u + (v & 3) + 8 * (v >> 2));
            if (MODE == AM_FAR) s += lb;
            else if (MODE == AM_WINFIRST) s = dist < 512 ? s + lb : -1e30f;
            else if (MODE == AM_NEAR) s += bt_r[min(max(dist, 0), 127)] + lb;
            else s = dist >= 0 ? s + bt_r[min(max(dist, 0), 127)] : -1e30f;
            if (u) S1[v] = s; else S0[v] = s;
        }
}
template <bool MASKED> DEV float attn_tilemax(const f32x16_t& S0, const f32x16_t& S1) {
    float t = fmaxf(S0[0], S1[0]);
#pragma unroll
    for (int v = 1; v < 16; ++v) t = fmaxf(t, fmaxf(S0[v], S1[v]));
    return fmaxf(t, __shfl_xor(t, 32));
}
template <bool MASKED> DEV float attn_exp(f32x16_t& S0, f32x16_t& S1, float mref, float scale) {
    float sum = 0.f;
#pragma unroll
    for (int v = 0; v < 16; ++v) {
        float e0 = __builtin_amdgcn_exp2f(S0[v] - mref), e1 = __builtin_amdgcn_exp2f(S1[v] - mref);
        if (MASKED) { e0 = S0[v] > -1e29f ? e0 : 0.f; e1 = S1[v] > -1e29f ? e1 : 0.f; }
        e0 *= scale; e1 *= scale;
        S0[v] = e0; S1[v] = e1; sum += e0 + e1;
    }
    return sum;
}
template <int MODE> DEV void attn_tile(const unsigned char* kb, unsigned ka0, unsigned vbase, unsigned va_rel, const bf16x8_t (&qf)[4], AttnState& st, int dl, float lb, const float* bt_r) {
    constexpr bool MASKED = MODE >= AM_DIAG;
    f32x16_t S0, S1;
    attn_qk(kb, ka0, qf, S0, S1);
    attn_bias<MODE>(S0, S1, dl, lb, bt_r);
    const float tm = attn_tilemax<MASKED>(S0, S1);
    const float mn = fmaxf(st.m, tm), alpha = __builtin_amdgcn_exp2f(st.m - mn);
    st.m = mn;
    const float ps = attn_exp<MASKED>(S0, S1, mn, 1.f);
    st.l = st.l * alpha + ps;
#pragma unroll
    for (int v = 0; v < 16; ++v) { st.O0[v] *= alpha; st.O1[v] *= alpha; }
    attn_pv(vbase, va_rel, S0, S1, st.O0, st.O1);
}

DEV void attn_prompt_unit(const Prm& p, int l, int b, int g, int qb, unsigned char* lds) {
    const int tid = opaque_tid(), w = tid >> 6, lane = tid & 63, c = lane & 31, h = lane >> 5, qi = c >> 2, r = c & 3;
    float* BT = (float*)(lds + AT_BT); float* PA = (float*)(lds + AT_PA) + w * 1024; float* PB = PA + 512;
    unsigned* SELM = (unsigned*)(lds + AT_SELM) + w * 16;
    __syncthreads();
    BT[tid] = p.BIASL2[g * 512 + tid];
#pragma unroll
    for (int i = 0; i < 16; ++i) ((float*)(lds + AT_PA))[tid + 512 * i] = 0.f;
    const int tq = 64 * qb + 8 * w + qi; const size_t mrow = (size_t)b * T_ + tq;
    bf16x8_t qf[4];
#pragma unroll
    for (int ks = 0; ks < 4; ++ks) qf[ks] = *(const bf16x8_t*)(p.Q + mrow * 512 + g * 256 + r * 64 + ks * 16 + 8 * h);
    const float gc = p.GATES[mrow * 24 + g * 4 + r], gs = p.GATES[mrow * 24 + 8 + g * 4 + r], gw = p.GATES[mrow * 24 + 16 + g * 4 + r];
    const float* bt_r = BT + r * 128;
    const unsigned ka0 = 1024u * ((unsigned)c >> 3) + 64u * (c & 7) + 16u * ((unsigned)h ^ (((unsigned)c >> 2) & 3u));
    const unsigned blk = (lane >> 4) & 1, q4 = (lane & 15) >> 2, pp = lane & 3;
    const unsigned va_rel = 64u * (4u * h + q4) + 8u * (pp & 1) + 16u * ((2u * blk + (pp >> 1)) ^ (unsigned)h);
    const unsigned lds_base = (unsigned)(size_t)(LAS unsigned char*)lds;
    const bf16_t* KCb = p.KC + (((size_t)b * 2 + g) * 2 + 0) * 256 * 64; const bf16_t* VCb = KCb + 256 * 64;
    const bf16_t* KSb = p.KVB + ((((size_t)(1 * 2 + 0) * NB_ + b) * 2 + g) * T_) * 64; const bf16_t* VSb = p.KVB + ((((size_t)(1 * 2 + 1) * NB_ + b) * 2 + g) * T_) * 64;
    const bf16_t* KWb = p.KVB + ((((size_t)(2 * 2 + 0) * NB_ + b) * 2 + g) * T_) * 64; const bf16_t* VWb = p.KVB + ((((size_t)(2 * 2 + 1) * NB_ + b) * 2 + g) * T_) * 64;
    const int nC = (4 * qb + 66) >> 6, nS = qb + 1, w0 = qb > 8 ? qb - 8 : 0, nW = qb - w0 + 1, J = 2 * nC + nS + nW;
    const int ws = __builtin_amdgcn_readfirstlane(w);
    const int ldrow = 8 * ws + ((lane >> 2) & 7), ldch = 4 * (lane >> 5) + ((lane & 3) ^ ((2 * ws + ((lane >> 4) & 1)) & 3));
    const size_t ldsrc = (size_t)ldrow * 64 + ldch * 8;
    auto job_src = [&](int ji, const bf16_t*& kp, const bf16_t*& vp) {
        if (ji < nC) { kp = KCb + (size_t)ji * 4096; vp = VCb + (size_t)ji * 4096; }
        else if (ji < 2 * nC) { kp = KCb + (size_t)(ji - nC) * 4096; vp = VCb + (size_t)(ji - nC) * 4096; }
        else if (ji < 2 * nC + nS) { kp = KSb + (size_t)(ji - 2 * nC) * 4096; vp = VSb + (size_t)(ji - 2 * nC) * 4096; }
        else { kp = KWb + (size_t)(w0 + ji - 2 * nC - nS) * 4096; vp = VWb + (size_t)(w0 + ji - 2 * nC - nS) * 4096; }
    };
    auto dma = [&](int ji) {
        const bf16_t* kp; const bf16_t* vp; job_src(ji, kp, vp); const int bufo = (ji % AT_RING) * 8192 + ws * 1024;
        __builtin_amdgcn_global_load_lds((const unsigned*)(kp + ldsrc), (LAS unsigned*)(lds + AT_KB + bufo), 16, 0, 0);
        __builtin_amdgcn_global_load_lds((const unsigned*)(vp + ldsrc), (LAS unsigned*)(lds + AT_VB + bufo), 16, 0, 0);
    };
    dma(0); dma(1); dma(2); dma(3);
    asm volatile("s_waitcnt vmcnt(4) lgkmcnt(0)" ::: "memory");
    __builtin_amdgcn_s_barrier();
    asm volatile("" ::: "memory");
    const float b31 = bt_r[127];
    AttnState st;
#pragma unroll
    for (int v = 0; v < 16; ++v) { st.O0[v] = 0.f; st.O1[v] = 0.f; }
    st.m = -1e30f; st.l = 0.f;
    f32x16_t A0, A1;
#pragma unroll
    for (int v = 0; v < 16; ++v) { A0[v] = 0.f; A1[v] = 0.f; }
    float mC = -1e30f, invC = 0.f; unsigned mlo = 0xffffffffu, mhi = 0xffffffffu;
    for (int jp = 0; jp < J; jp += 2) {
      const int nnew = (jp + 4 < J ? 1 : 0) + (jp + 5 < J ? 1 : 0);
      if (jp + 4 < J) dma(jp + 4);
      if (jp + 5 < J) dma(jp + 5);
#pragma unroll 1
      for (int ji = jp; ji < jp + 2 && ji < J; ++ji) {
        const unsigned char* kb = lds + AT_KB + (ji % AT_RING) * 8192; const unsigned vbase = lds_base + AT_VB + (ji % AT_RING) * 8192;
        if (ji < nC) {
            const int dl = tq - 31 - 1024 * ji - 64 * h;
            f32x16_t S0, S1; attn_qk(kb, ka0, qf, S0, S1); attn_bias<AM_CMP>(S0, S1, dl, 0.f, bt_r);
            const float tm = attn_tilemax<true>(S0, S1); const float mn = fmaxf(st.m, tm), alpha = __builtin_amdgcn_exp2f(st.m - mn); st.m = mn;
            st.l = st.l * alpha + attn_exp<true>(S0, S1, mn, 1.f);
            if (ji == nC - 1) { const float lt = st.l + __shfl_xor(st.l, 32); mC = st.m; invC = lt > 0.f ? 1.f / lt : 0.f; }
        } else if (ji < 2 * nC) {
            const int ct = ji - nC; const int dl = tq - 31 - 1024 * ct - 64 * h;
            f32x16_t S0, S1; attn_qk(kb, ka0, qf, S0, S1); attn_bias<AM_CMP>(S0, S1, dl, 0.f, bt_r);
            (void)attn_exp<true>(S0, S1, mC, invC);
            if (qb >= 16) {
#pragma unroll
                for (int u = 0; u < 2; ++u)
#pragma unroll
                    for (int qd = 0; qd < 4; ++qd) {
                        const f32x16_t& P = u ? S1 : S0;
                        float qs = (P[4 * qd] + P[4 * qd + 1]) + (P[4 * qd + 2] + P[4 * qd + 3]), ls = P[4 * qd + 3];
                        qs += __shfl_xor(qs, 1); qs += __shfl_xor(qs, 2); ls += __shfl_xor(ls, 1); ls += __shfl_xor(ls, 2);
                        const int jq = 16 * ct + 8 * u + 2 * qd + h;
                        if (r == 0) { PA[qi * 64 + jq] = qs; if (jq + 1 < 64) PB[qi * 64 + jq + 1] = ls; }
                    }
            }
            attn_pv(vbase, va_rel, S0, S1, st.O0, st.O1);
        } else if (ji < 2 * nC + nS) {
            const int j = ji - 2 * nC; const int dl = tq - 64 * j - 4 * h;
            const bool sel = j < 32 ? ((mlo >> j) & 1u) : ((mhi >> (j - 32)) & 1u);
            if (j == qb) attn_tile<AM_DIAG>(kb, ka0, vbase, va_rel, qf, st, dl, 0.f, bt_r);
            else if (__ballot(sel) != 0ull) {
                if (j >= qb - 2) attn_tile<AM_NEAR>(kb, ka0, vbase, va_rel, qf, st, dl, sel ? 0.f : -1e30f, bt_r);
                else attn_tile<AM_FAR>(kb, ka0, vbase, va_rel, qf, st, dl, sel ? b31 : -1e30f, bt_r);
            }
        } else {
            const int kbi = w0 + ji - 2 * nC - nS; const int dl = tq - 64 * kbi - 4 * h;
            if (kbi == qb) attn_tile<AM_DIAG>(kb, ka0, vbase, va_rel, qf, st, dl, 0.f, bt_r);
            else if (kbi >= qb - 2) attn_tile<AM_NEAR>(kb, ka0, vbase, va_rel, qf, st, dl, 0.f, bt_r);
            else if (kbi == qb - 8) attn_tile<AM_WINFIRST>(kb, ka0, vbase, va_rel, qf, st, dl, b31, bt_r);
            else attn_tile<AM_FAR>(kb, ka0, vbase, va_rel, qf, st, dl, b31, bt_r);
        }
        if (ji == jp + 1 || ji == J - 1) {
            if (nnew == 2) asm volatile("s_waitcnt vmcnt(4) lgkmcnt(0)" ::: "memory"); else if (nnew == 1) asm volatile("s_waitcnt vmcnt(2) lgkmcnt(0)" ::: "memory"); else asm volatile("s_waitcnt vmcnt(0) lgkmcnt(0)" ::: "memory");
            __builtin_amdgcn_s_barrier();
            asm volatile("" ::: "memory");
        }
        if (ji == 2 * nC - 1) {
#pragma unroll
            for (int v = 0; v < 16; ++v) { A0[v] = gc * st.O0[v]; A1[v] = gc * st.O1[v]; st.O0[v] = 0.f; st.O1[v] = 0.f; }
            st.m = -1e30f; st.l = 0.f;
            __syncthreads();
            if (qb >= 16) {
                for (int q = 0; q < 8; ++q) {
                    const bool cand = lane >= 1 && lane <= qb - 2;
                    const float sc = cand ? PA[q * 64 + lane] + PB[q * 64 + lane] : -1.f;
                    int cnt = 0;
                    for (int i = 1; i <= qb - 2; ++i) { const float si = __builtin_bit_cast(float, __builtin_amdgcn_readlane(__builtin_bit_cast(int, sc), i)); cnt += (si > sc || (si == sc && i < lane)) ? 1 : 0; }
                    const unsigned long long bal = __ballot(cand && cnt < 13) | 1ull | (1ull << qb) | (1ull << (qb - 1));
                    if (lane == 0) { SELM[q * 2] = (unsigned)bal; SELM[q * 2 + 1] = (unsigned)(bal >> 32); }
                }
            }
            __syncthreads();
            if (qb >= 16) { mlo = SELM[qi * 2]; mhi = SELM[qi * 2 + 1]; }
        }
        if (ji == 2 * nC + nS - 1 || ji == J - 1) {
            const float lt = st.l + __shfl_xor(st.l, 32); const float sc = (ji == J - 1 ? gw : gs) * (lt > 0.f ? 1.f / lt : 0.f);
#pragma unroll
            for (int v = 0; v < 16; ++v) { A0[v] += sc * st.O0[v]; A1[v] += sc * st.O1[v]; st.O0[v] = 0.f; st.O1[v] = 0.f; }
            st.m = -1e30f; st.l = 0.f;
        }
      }
    }
    bf16_t* o = p.MIX + mrow * D_ + 512 + g * 256 + r * 64 + 4 * h;
#pragma unroll
    for (int dt = 0; dt < 2; ++dt)
#pragma unroll
        for (int qd = 0; qd < 4; ++qd) {
            const f32x16_t& A = dt ? A1 : A0; uint2 wv; wv.x = cvt_pk_bf16(A[4 * qd], A[4 * qd + 1]); wv.y = cvt_pk_bf16(A[4 * qd + 2], A[4 * qd + 3]);
            *(uint2*)(o + 32 * dt + 8 * qd) = wv;
        }
}

constexpr int CS_G = 17408, CS_BUF = 2 * CS_G, CS_B = 2 * CS_BUF, CS_BB = 16384;
DEV void cmp_sample_item(const Prm& p, int l, int req, int type, unsigned char* lds) {
    const int tid = opaque_tid(), w = tid >> 6, lane = tid & 63, c = lane & 31, h = lane >> 5, g = w >> 2, ib = w & 3;
    const int cidx = tid & 15, rsub = tid >> 4, lg = cidx >> 3, lch = cidx & 7;
    __syncthreads();
    if (tid < 64) { const int bufi = tid >> 5, gg = (tid >> 4) & 1, ch = tid & 7; if ((tid & 15) < 8) *(uint4*)(lds + bufi * CS_BUF + gg * CS_G + off64(128, ch)) = make_uint4(0u, 0u, 0u, 0u); }
    const float* src[4]; unsigned dst[4];
#pragma unroll
    for (int ps = 0; ps < 4; ++ps) { const int i = ps * 32 + rsub; const int page = p.page_table[req * NPG + (i >> 3)];
        src[ps] = p.cache_cmp + (((((size_t)l * NPHYS + page) * 128 + (i & 7) * 16) * 2 + type) * 2) * 64 + cidx * 8; dst[ps] = lg * CS_G + off64(i, lch); }
    const bf16_t* wsrc = p.Wct + (size_t)(l * 2 + type) * 128 * 1024 + (size_t)(tid >> 2) * 1024 + (tid & 3) * 16;
    const unsigned wdst0 = CS_B + off64(tid >> 2, (tid & 3) * 2), wdst1 = CS_B + off64(tid >> 2, (tid & 3) * 2 + 1);
    float4 ra[4], rb[4]; uint4 wq0, wq1;
#pragma unroll
    for (int ps = 0; ps < 4; ++ps) { ra[ps] = *(const float4*)(src[ps]); rb[ps] = *(const float4*)(src[ps] + 4); }
    wq0 = *(const uint4*)(wsrc); wq1 = *(const uint4*)(wsrc + 8);
#pragma unroll
    for (int ps = 0; ps < 4; ++ps) { uint4 wv; wv.x = cvt_pk_bf16(ra[ps].x, ra[ps].y); wv.y = cvt_pk_bf16(ra[ps].z, ra[ps].w); wv.z = cvt_pk_bf16(rb[ps].x, rb[ps].y); wv.w = cvt_pk_bf16(rb[ps].z, rb[ps].w); *(uint4*)(lds + dst[ps]) = wv; }
    *(uint4*)(lds + wdst0) = wq0; *(uint4*)(lds + wdst1) = wq1;
    __syncthreads();
    f32x16_t acc0, acc1;
#pragma unroll
    for (int v = 0; v < 16; ++v) { acc0[v] = 0.f; acc1[v] = 0.f; }
    const unsigned alo = g * CS_G + off64(32 * ib + c, h), ahi = g * CS_G + off64(32 * ib + c + 1, h);
    const unsigned bo = CS_B + off64(c, h);
#define CS_ISSUE(RA, RB, W0, W1, st) do { _Pragma("unroll") for (int ps = 0; ps < 4; ++ps) { RA[ps] = *(const float4*)(src[ps] + (size_t)(st) * 256); RB[ps] = *(const float4*)(src[ps] + (size_t)(st) * 256 + 4); } \
        W0 = *(const uint4*)(wsrc + (st) * 64); W1 = *(const uint4*)(wsrc + (st) * 64 + 8); } while (0)
#define CS_COMMIT(RA, RB, W0, W1, st) do { unsigned char* nb = lds + ((st) & 1) * CS_BUF; _Pragma("unroll") for (int ps = 0; ps < 4; ++ps) { uint4 wv; wv.x = cvt_pk_bf16(RA[ps].x, RA[ps].y); wv.y = cvt_pk_bf16(RA[ps].z, RA[ps].w); \
        wv.z = cvt_pk_bf16(RB[ps].x, RB[ps].y); wv.w = cvt_pk_bf16(RB[ps].z, RB[ps].w); *(uint4*)(nb + dst[ps]) = wv; } \
        *(uint4*)(lds + ((st) & 1) * CS_BB + wdst0) = W0; *(uint4*)(lds + ((st) & 1) * CS_BB + wdst1) = W1; } while (0)
#define CS_COMPUTE(st) do { const unsigned char* ab = lds + ((st) & 1) * CS_BUF; const unsigned char* bb = lds + ((st) & 1) * CS_BB; _Pragma("unroll") for (int ks = 0; ks < 4; ++ks) { \
        const unsigned sw = (ks & 1) ? 32u : 0u, ad = 512u * (ks >> 1); \
        const bf16x8_t fa = *(const bf16x8_t*)(ab + (alo ^ sw) + ad), fb = *(const bf16x8_t*)(ab + (ahi ^ sw) + ad); \
        const unsigned char* bk = bb + (bo ^ sw) + ad; \
        const bf16x8_t b00 = *(const bf16x8_t*)(bk), b01 = *(const bf16x8_t*)(bk + 4096), b10 = *(const bf16x8_t*)(bk + 8192), b11 = *(const bf16x8_t*)(bk + 12288); \
        acc0 = __builtin_amdgcn_mfma_f32_32x32x16_bf16(fa, b00, acc0, 0, 0, 0); acc1 = __builtin_amdgcn_mfma_f32_32x32x16_bf16(fa, b01, acc1, 0, 0, 0); \
        acc0 = __builtin_amdgcn_mfma_f32_32x32x16_bf16(fb, b10, acc0, 0, 0, 0); acc1 = __builtin_amdgcn_mfma_f32_32x32x16_bf16(fb, b11, acc1, 0, 0, 0); } } while (0)
    float4 rc[4], rd[4]; uint4 wq2, wq3;
    CS_ISSUE(ra, rb, wq0, wq1, 1);
#pragma unroll 1
    for (int ll = 0; ll < 16; ll += 2) {
        if (ll + 2 < 16) CS_ISSUE(rc, rd, wq2, wq3, ll + 2);
        CS_COMPUTE(ll);
        CS_COMMIT(ra, rb, wq0, wq1, ll + 1);
        __syncthreads();
        if (ll + 3 < 16) CS_ISSUE(ra, rb, wq0, wq1, ll + 3);
        CS_COMPUTE(ll + 1);
        if (ll + 2 < 16) CS_COMMIT(rc, rd, wq2, wq3, ll + 2);
        __syncthreads();
    }
#undef CS_ISSUE
#undef CS_COMMIT
#undef CS_COMPUTE
    bf16_t* o = p.KCS + (((((size_t)l * NREQ + req) * 2 + g) * 2 + type) * 128) * 64;
    const float cb0 = cb_val(p.cb, (l * 2 + type) * 64 + c), cb1 = cb_val(p.cb, (l * 2 + type) * 64 + 32 + c);
#pragma unroll
    for (int v = 0; v < 16; ++v) {
        const int i = 32 * ib + (v & 3) + 8 * (v >> 2) + 4 * h;
        o[(size_t)i * 64 + c] = i == 127 ? (bf16_t)0 : f2bf(acc0[v] + cb0); o[(size_t)i * 64 + 32 + c] = i == 127 ? (bf16_t)0 : f2bf(acc1[v] + cb1);
    }
}
DEV void cmp_sample_fast(const Prm& p, int l, unsigned char* lds) {
    for (int it = blockIdx.x; it < NREQ * 2; it += gridDim.x) cmp_sample_item(p, l, it >> 1, it & 1, lds);
}

constexpr int AS_BT = 131072, AS_PA = AS_BT + 2048, AS_SELM = AS_PA + 4096, AS_LDS = AS_SELM + 64;
template <int NH = 2, class RowFn, class DstFn> DEV void as_load_f32(unsigned char* kt, unsigned char* vt, int lane, RowFn rowp, DstFn dstp) {
    const int rsub = lane >> 4, li = lane & 15;
    constexpr int NI = 16 / NH;
#pragma unroll 1
    for (int hf = 0; hf < NH; ++hf) {
        float4 kx[NI], vx[NI];
#pragma unroll
        for (int it = 0; it < NI; ++it) { const float* rp = rowp(32 * hf + 4 * it + rsub);
            if (rp) { kx[it] = *(const float4*)(rp + li * 4); vx[it] = *(const float4*)(rp + 128 + li * 4); } else { kx[it] = make_float4(0.f, 0.f, 0.f, 0.f); vx[it] = kx[it]; } }
#pragma unroll
        for (int it = 0; it < NI; ++it) { const unsigned o = off64(32 * hf + 4 * it + rsub, li >> 1) + 8 * (li & 1);
            uint2 a, b; a.x = cvt_pk_bf16(kx[it].x, kx[it].y); a.y = cvt_pk_bf16(kx[it].z, kx[it].w); b.x = cvt_pk_bf16(vx[it].x, vx[it].y); b.y = cvt_pk_bf16(vx[it].z, vx[it].w);
            *(uint2*)(kt + o) = a; *(uint2*)(vt + o) = b;
            float* dp = dstp(32 * hf + 4 * it + rsub); if (dp) { *(float4*)(dp + li * 4) = kx[it]; *(float4*)(dp + 128 + li * 4) = vx[it]; } }
    }
}
DEV void as_load_bf16(unsigned char* t, const bf16_t* src, int lane) {
    uint4 v[8];
#pragma unroll
    for (int it = 0; it < 8; ++it) v[it] = *(const uint4*)(src + (size_t)(8 * it + (lane >> 3)) * 64 + (lane & 7) * 8);
#pragma unroll
    for (int it = 0; it < 8; ++it) *(uint4*)(t + off64(8 * it + (lane >> 3), lane & 7)) = v[it];
}
template <int MODE, bool FM> DEV void attn_tile_m(const unsigned char* kb, unsigned ka0, unsigned vbase, unsigned va_rel, const bf16x8_t (&qf)[4], AttnState& st, int dl, float lb, const float* bt_r) {
    constexpr bool MASKED = FM || MODE >= AM_DIAG;
    f32x16_t S0, S1;
    attn_qk(kb, ka0, qf, S0, S1);
    attn_bias<MODE>(S0, S1, dl, lb, bt_r);
    const float tm = attn_tilemax<MASKED>(S0, S1);
    const float mn = fmaxf(st.m, tm), alpha = __builtin_amdgcn_exp2f(st.m - mn);
    st.m = mn;
    const float ps = attn_exp<MASKED>(S0, S1, mn, 1.f);
    st.l = st.l * alpha + ps;
#pragma unroll
    for (int v = 0; v < 16; ++v) { st.O0[v] *= alpha; st.O1[v] *= alpha; }
    attn_pv(vbase, va_rel, S0, S1, st.O0, st.O1);
}
#define AS_WAVE_SYNC() do { asm volatile("s_waitcnt lgkmcnt(0)" ::: "memory"); __builtin_amdgcn_wave_barrier(); } while (0)
DEV void attn_sample_item(const Prm& p, int l, int req, int g, unsigned char* lds) {
    const int tid = opaque_tid(), w = __builtin_amdgcn_readfirstlane(tid >> 6), lane = tid & 63, c = lane & 31, h = lane >> 5, qi = (c >> 2) & 3, r = c & 3; const bool real = c < 16;
    float* BT = (float*)(lds + AS_BT); float* PA = (float*)(lds + AS_PA); float* PB = PA + 512; unsigned* SELM = (unsigned*)(lds + AS_SELM);
    unsigned char* kt = lds + w * 16384; unsigned char* vt = kt + 8192;
    __syncthreads();
    BT[tid] = p.BIASL2[g * 512 + tid]; PA[tid] = 0.f; PA[512 + tid] = 0.f;
    const int tq = PAST_ + qi; const size_t mrow = (size_t)MP + req * 4 + qi;
    bf16x8_t qf[4];
#pragma unroll
    for (int ks = 0; ks < 4; ++ks) { qf[ks] = *(const bf16x8_t*)(p.Q + mrow * 512 + g * 256 + r * 64 + ks * 16 + 8 * h); if (!real) qf[ks] = (bf16x8_t){0, 0, 0, 0, 0, 0, 0, 0}; }
    const float gc = p.GATES[mrow * 24 + g * 4 + r], gs = p.GATES[mrow * 24 + 8 + g * 4 + r], gw = p.GATES[mrow * 24 + 16 + g * 4 + r];
    const float* bt_r = BT + r * 128;
    const unsigned ka0 = 1024u * ((unsigned)c >> 3) + 64u * (c & 7) + 16u * ((unsigned)h ^ (((unsigned)c >> 2) & 3u));
    const unsigned blk = (lane >> 4) & 1, q4 = (lane & 15) >> 2, pp = lane & 3;
    const unsigned va_rel = 64u * (4u * h + q4) + 8u * (pp & 1) + 16u * ((2u * blk + (pp >> 1)) ^ (unsigned)h);
    const unsigned vbase = (unsigned)(size_t)(LAS unsigned char*)vt;
    __syncthreads();
    const float b31 = bt_r[127];
    AttnState sw, ss;
#pragma unroll
    for (int v = 0; v < 16; ++v) { sw.O0[v] = 0.f; sw.O1[v] = 0.f; ss.O0[v] = 0.f; ss.O1[v] = 0.f; }
    sw.m = -1e30f; sw.l = 0.f; ss.m = -1e30f; ss.l = 0.f;
    const size_t lr = (size_t)l * NREQ + req;
    const bf16_t* kc = p.KCS + ((lr * 2 + g) * 2 + 0) * 128 * 64; const bf16_t* vc = kc + 128 * 64;
    if (w == 0) {
        uint4 k0[8], k1[8], v0[8], v1[8];
        const int lr8 = lane >> 3, lc8 = (lane & 7) * 8;
#pragma unroll
        for (int it = 0; it < 8; ++it) { const size_t o = (size_t)(8 * it + lr8) * 64 + lc8; k0[it] = *(const uint4*)(kc + o); k1[it] = *(const uint4*)(kc + 4096 + o); }
#pragma unroll
        for (int it = 0; it < 8; ++it) { const unsigned o = off64(8 * it + lr8, lane & 7); *(uint4*)(kt + o) = k0[it]; *(uint4*)(vt + o) = k1[it]; }
        AS_WAVE_SYNC();
        f32x16_t A0, A1, B0, B1;
        attn_qk(kt, ka0, qf, A0, A1); attn_qk(vt, ka0, qf, B0, B1);
        attn_bias<AM_CMP>(A0, A1, tq - 31 - 64 * h, 0.f, bt_r); attn_bias<AM_CMP>(B0, B1, tq - 31 - 1024 - 64 * h, 0.f, bt_r);
        const float mC = fmaxf(attn_tilemax<true>(A0, A1), attn_tilemax<true>(B0, B1));
        float lC = attn_exp<true>(A0, A1, mC, 1.f); lC += attn_exp<true>(B0, B1, mC, 1.f);
        const float lt = lC + __shfl_xor(lC, 32), invC = lt > 0.f ? 1.f / lt : 0.f;
#pragma unroll
        for (int v = 0; v < 16; ++v) { A0[v] *= invC; A1[v] *= invC; B0[v] *= invC; B1[v] *= invC; }
        AS_WAVE_SYNC();
#pragma unroll
        for (int it = 0; it < 8; ++it) { const size_t o = (size_t)(8 * it + lr8) * 64 + lc8; v0[it] = *(const uint4*)(vc + o); v1[it] = *(const uint4*)(vc + 4096 + o); }
#pragma unroll
        for (int it = 0; it < 8; ++it) { const unsigned o = off64(8 * it + lr8, lane & 7); *(uint4*)(kt + o) = v0[it]; *(uint4*)(vt + o) = v1[it]; }
#pragma unroll
        for (int ct = 0; ct < 2; ++ct)
#pragma unroll
            for (int u = 0; u < 2; ++u)
#pragma unroll
                for (int qd = 0; qd < 4; ++qd) {
                    const f32x16_t& P = ct ? (u ? B1 : B0) : (u ? A1 : A0);
                    float qs = (P[4 * qd] + P[4 * qd + 1]) + (P[4 * qd + 2] + P[4 * qd + 3]), ls = P[4 * qd + 3];
                    qs += __shfl_xor(qs, 1); qs += __shfl_xor(qs, 2); ls += __shfl_xor(ls, 1); ls += __shfl_xor(ls, 2);
                    const int jq = 16 * ct + 8 * u + 2 * qd + h;
                    if (r == 0 && real) { PA[qi * 64 + jq] = qs; PB[qi * 64 + jq + 1] = ls; }
                }
        AS_WAVE_SYNC();
        attn_pv((unsigned)(size_t)(LAS unsigned char*)kt, va_rel, A0, A1, sw.O0, sw.O1);
        attn_pv(vbase, va_rel, B0, B1, sw.O0, sw.O1);
        AS_WAVE_SYNC();
    } else {
        for (int t = 0; t < 2; ++t) {
            const int wt = w - 1 + 7 * t; if (wt >= 9) break;
            as_load_f32<1>(kt, vt, lane, [&](int k) -> const float* { const int idx = 64 * wt + k;
                if (idx < 512) return p.cache_win + (lr * 512 + idx) * 256 + g * 64;
                if (idx < 516) return p.out + O_WINS + (lr * 512 + 508 + (idx - 512)) * 256 + g * 64;
                return nullptr; },
                [&](int k) -> float* { const int idx = 64 * wt + k; return (idx >= 4 && idx < 512) ? p.out + O_WINS + (lr * 512 + (idx - 4)) * 256 + g * 64 : nullptr; });
            AS_WAVE_SYNC();
            const int dl = 512 + qi - 64 * wt - 4 * h;
            if (wt == 0) attn_tile_m<AM_WINFIRST, false>(kt, ka0, vbase, va_rel, qf, sw, dl, b31, bt_r);
            else if (wt == 8) attn_tile_m<AM_DIAG, false>(kt, ka0, vbase, va_rel, qf, sw, dl, 0.f, bt_r);
            else if (wt >= 6) attn_tile_m<AM_NEAR, false>(kt, ka0, vbase, va_rel, qf, sw, dl, 0.f, bt_r);
            else attn_tile_m<AM_FAR, false>(kt, ka0, vbase, va_rel, qf, sw, dl, b31, bt_r);
            AS_WAVE_SYNC();
        }
    }
    if (w == 0) {
        for (int q = 0; q < 4; ++q) {
            const bool cand = lane >= 1 && lane <= 30;
            const float sc = cand ? PA[q * 64 + lane] + PB[q * 64 + lane] : -1.f;
            int cnt = 0;
            for (int i = 1; i <= 30; ++i) { const float si = __builtin_bit_cast(float, __builtin_amdgcn_readlane(__builtin_bit_cast(int, sc), i)); cnt += (si > sc || (si == sc && i < lane)) ? 1 : 0; }
            const unsigned long long bal = __ballot(cand && cnt < 13) | 1ull | (1ull << 31) | (1ull << 32);
            if (lane == 0) { SELM[q * 2] = (unsigned)bal; SELM[q * 2 + 1] = (unsigned)(bal >> 32); }
        }
    }
    __syncthreads();
    const unsigned mlo = SELM[qi * 2], mhi = SELM[qi * 2 + 1];
    unsigned long long um = 0ull;
#pragma unroll
    for (int q = 0; q < 4; ++q) um |= (unsigned long long)SELM[q * 2] | ((unsigned long long)SELM[q * 2 + 1] << 32);
    um = ((unsigned long long)__builtin_amdgcn_readfirstlane((unsigned)(um >> 32)) << 32) | (unsigned)__builtin_amdgcn_readfirstlane((unsigned)um);
    while (um) {
        int j = -1;
        for (int k = 0; k < 8 && um; ++k) { const int jj = __ffsll((long long)um) - 1; um &= um - 1ull; if (k == w) j = jj; }
        if (j >= 0) {
            const int page = j < 32 ? p.page_table[req * NPG + (j >> 1)] : 0;
            const float* sbase = j < 32 ? p.cache_slc + ((((size_t)l * NPHYS + page) * 128 + (j & 1) * 64) * 4 + g) * 64 : p.out + O_SLCS + (lr * 4) * 256 + g * 64;
            const int nrow = j < 32 ? 64 : 4;
            as_load_f32(kt, vt, lane, [&](int k) -> const float* { return k < nrow ? sbase + (size_t)k * 256 : nullptr; }, [](int) -> float* { return nullptr; });
        }
        AS_WAVE_SYNC();
        if (j >= 0) {
            const bool sel = j < 32 ? ((mlo >> j) & 1u) : ((mhi >> (j - 32)) & 1u);
            const int dl = tq - 64 * j - 4 * h;
            if (j == 32) attn_tile_m<AM_DIAG, true>(kt, ka0, vbase, va_rel, qf, ss, dl, 0.f, bt_r);
            else if (j >= 30) attn_tile_m<AM_NEAR, true>(kt, ka0, vbase, va_rel, qf, ss, dl, sel ? 0.f : -1e30f, bt_r);
            else attn_tile_m<AM_FAR, true>(kt, ka0, vbase, va_rel, qf, ss, dl, sel ? b31 : -1e30f, bt_r);
        }
        AS_WAVE_SYNC();
    }
    float* MO = (float*)(lds + w * 16384);
    float* ML = (float*)(lds + w * 16384 + 8192);
    {
        const float lts = ss.l + __shfl_xor(ss.l, 32), ltw = sw.l + __shfl_xor(sw.l, 32);
        if (real) {
#pragma unroll
            for (int dt = 0; dt < 2; ++dt)
#pragma unroll
                for (int qd = 0; qd < 4; ++qd) {
                    const f32x16_t& A = dt ? ss.O1 : ss.O0; const f32x16_t& B = dt ? sw.O1 : sw.O0; const int d = 32 * dt + 8 * qd + 4 * h;
                    *(float4*)(MO + c * 64 + d) = make_float4(A[4 * qd], A[4 * qd + 1], A[4 * qd + 2], A[4 * qd + 3]);
                    *(float4*)(MO + 1024 + c * 64 + d) = make_float4(B[4 * qd], B[4 * qd + 1], B[4 * qd + 2], B[4 * qd + 3]);
                }
            if (h == 0) { ML[c * 2] = ss.m; ML[c * 2 + 1] = lts; ML[32 + c * 2] = sw.m; ML[32 + c * 2 + 1] = ltw; }
        }
    }
    __syncthreads();
    for (int o = tid; o < 1024; o += NTHR) {
        const int cc = o >> 6, d = o & 63, q = cc >> 2, rr = cc & 3; const size_t mr = (size_t)MP + req * 4 + q;
        float res = p.GATES[mr * 24 + g * 4 + rr] * ((const float*)(lds + 0 * 16384))[1024 + cc * 64 + d];
#pragma unroll
        for (int br = 0; br < 2; ++br) {
            float M = -1e30f;
            for (int ww = (br == 1 ? 1 : 0); ww < 8; ++ww) M = fmaxf(M, ((const float*)(lds + ww * 16384 + 8192))[br * 32 + cc * 2]);
            float num = 0.f, den = 0.f;
            for (int ww = (br == 1 ? 1 : 0); ww < 8; ++ww) { const float* ml = (const float*)(lds + ww * 16384 + 8192) + br * 32 + cc * 2; const float f = __builtin_amdgcn_exp2f(ml[0] - M);
                num += f * ((const float*)(lds + ww * 16384))[br * 1024 + cc * 64 + d]; den += f * ml[1]; }
            res += p.GATES[mr * 24 + (br == 0 ? 8 : 16) + g * 4 + rr] * (den > 0.f ? num / den : 0.f);
        }
        p.MIX[mr * D_ + 512 + g * 256 + rr * 64 + d] = f2bf(res);
    }
}

DEV void cmp_prompt_fast(const Prm& p, int l, float* sm) {
    const int tid = opaque_tid(), w = __builtin_amdgcn_readfirstlane(tid >> 6), lane = tid & 63, c = lane & 31, h = lane >> 5;
    for (int wi = (int)blockIdx.x - ((int)gridDim.x >= 256 ? 128 : 0); wi < 128; wi += gridDim.x) {
        if (wi < 0) continue;
        const int ib = wi & 7, type = (wi >> 3) & 1, g = (wi >> 4) & 1, b = wi >> 5;
        const bf16_t* kv = p.KVB + ((((size_t)(0 * 2 + type) * NB_ + b) * 2 + g) * T_) * 64 + 8 * h;
        const bf16_t* wb = p.Wct + (size_t)(l * 2 + type) * 128 * 1024 + (size_t)c * 1024 + 8 * h;
        f32x16_t acc0, acc1;
#pragma unroll
        for (int v = 0; v < 16; ++v) { acc0[v] = 0.f; acc1[v] = 0.f; }
        const int i0 = 32 * ib + c;
#pragma unroll
        for (int l2 = 0; l2 < 2; ++l2) {
            const int ll = 2 * w + l2; const int tlo = 16 * i0 + ll, thi = min(tlo + 16, T_ - 1);
            bf16x8_t fa[4], fb[4], b00[4], b01[4], b10[4], b11[4];
#pragma unroll
            for (int ks = 0; ks < 4; ++ks) {
                fa[ks] = *(const bf16x8_t*)(kv + (size_t)tlo * 64 + ks * 16); fb[ks] = *(const bf16x8_t*)(kv + (size_t)thi * 64 + ks * 16);
                const bf16_t* wk = wb + ll * 64 + ks * 16;
                b00[ks] = *(const bf16x8_t*)(wk); b01[ks] = *(const bf16x8_t*)(wk + 32 * 1024); b10[ks] = *(const bf16x8_t*)(wk + 64 * 1024); b11[ks] = *(const bf16x8_t*)(wk + 96 * 1024);
            }
#pragma unroll
            for (int ks = 0; ks < 4; ++ks) {
                acc0 = __builtin_amdgcn_mfma_f32_32x32x16_bf16(fa[ks], b00[ks], acc0, 0, 0, 0);
                acc1 = __builtin_amdgcn_mfma_f32_32x32x16_bf16(fa[ks], b01[ks], acc1, 0, 0, 0);
                acc0 = __builtin_amdgcn_mfma_f32_32x32x16_bf16(fb[ks], b10[ks], acc0, 0, 0, 0);
                acc1 = __builtin_amdgcn_mfma_f32_32x32x16_bf16(fb[ks], b11[ks], acc1, 0, 0, 0);
            }
        }
        __syncthreads();
        float* part = sm + w * 2048;
#pragma unroll
        for (int v = 0; v < 16; ++v) { const int i = (v & 3) + 8 * (v >> 2) + 4 * h; part[i * 64 + c] = acc0[v]; part[i * 64 + 32 + c] = acc1[v]; }
        __syncthreads();
        bf16_t* o = p.KC + ((((size_t)b * 2 + g) * 2 + type) * 256 + 32 * ib) * 64;
#pragma unroll
        for (int q = 0; q < 4; ++q) { const int idx = tid + NTHR * q, i = idx >> 6, e = idx & 63; float a = cb_val(p.cb, (l * 2 + type) * 64 + e);
#pragma unroll
            for (int ww = 0; ww < 8; ++ww) a += sm[ww * 2048 + idx];
            o[idx] = (32 * ib + i) == 255 ? (bf16_t)0 : f2bf(a); }
    }
}
DEV void phase_mix1(const Prm& p, int l, float* sm) {
    cmp_prompt_fast(p, l, sm);
    float4 vc[8], vp[6];
    if ((int)blockIdx.x < 512 + NREQ) convpool_issue(p, l, (int)blockIdx.x, vc, vp);
    for (int item = blockIdx.x; item < 512 + NREQ; item += gridDim.x) { const int nx = item + (int)gridDim.x; convpool_item(p, l, item, sm, vc, vp, nx < 512 + NREQ ? nx : -1); }
}
DEV void phase_attn(const Prm& p, int l, float* sm) {
    const int spos = (int)(blockIdx.x % 3u);
    for (int k = blockIdx.x; k < 256; k += gridDim.x) {
        const int bg = k >> 5, pi = k & 31;
#pragma unroll 1
        for (int s = 0; s < 3; ++s) {
            const int what = s == spos ? 2 : (s < spos ? s : s - 1);
            if (what == 2) attn_sample_item(p, l, k >> 1, k & 1, (unsigned char*)sm);
            else attn_prompt_unit(p, l, bg >> 1, bg & 1, what == 0 ? 63 - pi : pi, (unsigned char*)sm);
        }
    }
}
DEV void phase_final(const Prm& p) {
    const int tid = opaque_tid(), wv = tid >> 6, lane = tid & 63;
    float4 g[4];
#pragma unroll
    for (int i = 0; i < 4; ++i) g[i] = *(const float4*)(p.final_norm + i * 256 + lane * 4);
    for (int m0 = (blockIdx.x * 8 + wv) * 2; m0 < MP; m0 += gridDim.x * 16) {
        uint2 v[2][4]; float rs[2];
#pragma unroll
        for (int rr = 0; rr < 2; ++rr) { rs[rr] = row_rs(p.SSb, m0 + rr);
#pragma unroll
            for (int i = 0; i < 4; ++i) v[rr][i] = *(const uint2*)(p.XB + (size_t)(m0 + rr) * D_ + i * 256 + lane * 4); }
#pragma unroll
        for (int rr = 0; rr < 2; ++rr)
#pragma unroll
            for (int i = 0; i < 4; ++i) { const uint2 a = v[rr][i]; const float r = rs[rr];
                const float x0 = __uint_as_float(a.x << 16), x1 = __uint_as_float(a.x & 0xffff0000u), x2 = __uint_as_float(a.y << 16), x3 = __uint_as_float(a.y & 0xffff0000u);
                *(float4*)(p.out + (size_t)(m0 + rr) * D_ + i * 256 + lane * 4) = make_float4(x0 * r * g[i].x, x1 * r * g[i].y, x2 * r * g[i].z, x3 * r * g[i].w); }
    }
}

enum { PH_PREP = 0, PH_IN, PH_MIX1, PH_ATTN, PH_OUT, PH_GU, PH_DOWN, PH_FINAL, PH_DOWNR };
template <int PH> DEV void run_phase(const Prm& p, int l, unsigned char* lds) {
    float* sm = (float*)lds;
    if constexpr (PH == PH_PREP) phase_prep(p, sm);
    if constexpr (PH == PH_IN) { EpiIn e{p, l, nullptr};
        const bool cf = l == 0 && (blockIdx.x & 1);
        if (cf) cmp_sample_fast(p, 0, lds);
        gemm_fast(lds, p.XB, p.Wt_in + (size_t)l * NIN * D_, M_, NIN, D_, e);
        if (l == 0 && !cf) cmp_sample_fast(p, 0, lds);
        if (l == 0) { const int nfull = (M_ / 256) * (NIN / 256) % (int)gridDim.x; if ((int)blockIdx.x >= nfull) prep_weights(p, sm, 576 / 4, 2944 / 4, (int)blockIdx.x - nfull, (int)gridDim.x - nfull); } }
    if constexpr (PH == PH_MIX1) phase_mix1(p, l, sm);
    if constexpr (PH == PH_ATTN) phase_attn(p, l, sm);
    if constexpr (PH == PH_OUT) { EpiRes e{p, 1, p.SSa, true}; gemm_fast(lds, p.MIX, p.Wt_out + (size_t)l * D_ * D_, M_, D_, D_, e);
        if (l == 0 && blockIdx.x >= 8) prep_weights(p, sm, 2944 / 4, 2 * 2944 / 4, (int)blockIdx.x - 8, (int)gridDim.x - 8); }
    if constexpr (PH == PH_GU) { EpiGU e{p, nullptr}; gemm_fast(lds, p.XB, p.Wt_gu + (size_t)l * NGU * D_, M_, NGU, D_, e); }
    if constexpr (PH == PH_DOWN) { EpiRes e{p, 2, p.SSb, l + 1 < NL_}; const bf16_t* W = p.Wt_down + (size_t)l * D_ * DFF;
        const bool cf = l == 0 && (blockIdx.x & 1);
        if (cf) cmp_sample_fast(p, 1, lds);
        gemm_fast(lds, p.ACT, W, MP, D_, DFF, e);
        gemm_split(lds, p.ACT, W, D_, DFF, 256, p.SLAB);
        if (l == 0 && !cf) cmp_sample_fast(p, 1, lds); }
    if constexpr (PH == PH_FINAL) phase_final(p);
    if constexpr (PH == PH_DOWNR) { if (l + 1 < NL_) { EpiRes e{p, 2, p.SSb, true}; gemm_reduce(p.SLAB, D_, DFF / 256, e); } else gemm_reduce_final(p, p.SLAB, DFF / 256); }
}
template <int PH> __global__ void __launch_bounds__(NTHR, 2) k_phase(Prm p, int l) {
    extern __shared__ __attribute__((aligned(16))) unsigned char lds[];
    run_phase<PH>(p, l, lds);
}
__global__ void __launch_bounds__(NTHR, 2) k_mega(Prm p) {
    extern __shared__ __attribute__((aligned(16))) unsigned char lds[];
    if (threadIdx.x == 0) *(uint4*)(lds + LDS_BYTES - 16) = make_uint4(0u, 0u, 0u, 0u);
    __syncthreads();
    const XcdBarrier bar = xcd_barrier_post(p.bar, (volatile LAS unsigned*)(lds + LDS_BYTES - 16));
    run_phase<PH_PREP>(p, 0, lds); xcd_barrier(bar);
#define LAYER(l) do { run_phase<PH_IN>(p, l, lds); xcd_barrier(bar); run_phase<PH_MIX1>(p, l, lds); xcd_barrier(bar); run_phase<PH_ATTN>(p, l, lds); xcd_barrier(bar); \
        run_phase<PH_OUT>(p, l, lds); xcd_barrier(bar); run_phase<PH_GU>(p, l, lds); xcd_barrier(bar); run_phase<PH_DOWN>(p, l, lds); xcd_barrier(bar); run_phase<PH_DOWNR>(p, l, lds); } while (0)
    LAYER(0); xcd_barrier(bar); LAYER(1);
#undef LAYER
    run_phase<PH_FINAL>(p, 0, lds);
}

constexpr bool ONE_LAUNCH = true;
static size_t carve(size_t& off, size_t bytes) { const size_t o = off; off += (bytes + 255) & ~(size_t)255; return o; }
template <int PH> static void launch_phase(const Prm& p, int l, int grid, hipStream_t stream) {
    static bool attr = false;
    if (!attr) { (void)hipFuncSetAttribute((const void*)k_phase<PH>, hipFuncAttributeMaxDynamicSharedMemorySize, LDS_BYTES); attr = true; }
    hipLaunchKernelGGL(k_phase<PH>, dim3(grid), dim3(NTHR), LDS_BYTES, stream, p, l);
}
extern "C" void kernel_launch(void* const* d_in, const int* in_sizes, int n_in, void* d_out, int out_size, void* d_ws, size_t ws_size, hipStream_t stream) {
    Prm p{};
    p.x_prompt = (const float*)d_in[0]; p.x_sample = (const float*)d_in[1]; p.cache_cmp = (const float*)d_in[2]; p.cache_slc = (const float*)d_in[3]; p.cache_win = (const float*)d_in[4];
    p.state_conv = (const float*)d_in[5]; p.state_pool = (const float*)d_in[6]; p.page_table = (const int*)d_in[7]; p.rel_bias = (const float*)d_in[8]; p.norm1 = (const float*)d_in[9];
    p.w_in = (const float*)d_in[10]; p.conv_dw = (const float*)d_in[11]; p.conv_b = (const float*)d_in[12]; p.conv_ln_g = (const float*)d_in[13]; p.conv_ln_b = (const float*)d_in[14];
    p.pool_w = (const float*)d_in[15]; p.pool_scale = (const float*)d_in[16]; p.pe_k = (const float*)d_in[17]; p.wk = (const float*)d_in[18]; p.pe_v = (const float*)d_in[19]; p.wv = (const float*)d_in[20];
    p.w_out = (const float*)d_in[21]; p.norm2 = (const float*)d_in[22]; p.w_gu = (const float*)d_in[23]; p.w_down = (const float*)d_in[24]; p.final_norm = (const float*)d_in[25];
    p.out = (float*)d_out;
    char* ws = (char*)d_ws; size_t off = 0;
    p.bar = (unsigned*)(ws + carve(off, 16384));
    p.Wt_in = (bf16_t*)(ws + carve(off, (size_t)NL_ * NIN * D_ * 2)); p.Wt_out = (bf16_t*)(ws + carve(off, (size_t)NL_ * D_ * D_ * 2));
    p.Wt_gu = (bf16_t*)(ws + carve(off, (size_t)NL_ * NGU * D_ * 2)); p.Wt_down = (bf16_t*)(ws + carve(off, (size_t)NL_ * D_ * DFF * 2));
    p.Wct = (bf16_t*)(ws + carve(off, (size_t)2 * 2 * 128 * 1024 * 2)); p.cb = (float*)(ws + carve(off, 4 * 256 * 4));
    p.XB = (bf16_t*)(ws + carve(off, (size_t)M_ * D_ * 2)); p.SSa = (float*)(ws + carve(off, (size_t)M_ * 16 * 4)); p.SSb = (float*)(ws + carve(off, (size_t)M_ * 16 * 4));
    p.G = (float*)(ws + carve(off, (size_t)M_ * 256 * 4)); p.U = (float*)(ws + carve(off, (size_t)M_ * 256 * 4));
    p.Q = (bf16_t*)(ws + carve(off, (size_t)M_ * 512 * 2)); p.KVB = (bf16_t*)(ws + carve(off, (size_t)3 * 2 * NB_ * 2 * T_ * 64 * 2));
    p.GATES = (float*)(ws + carve(off, (size_t)M_ * 24 * 4));
    p.KC = (bf16_t*)(ws + carve(off, (size_t)NB_ * 2 * 2 * 256 * 64 * 2)); p.KCS = (bf16_t*)(ws + carve(off, (size_t)NL_ * NREQ * 2 * 2 * 128 * 64 * 2));
    p.MIX = (bf16_t*)(ws + carve(off, (size_t)M_ * D_ * 2)); p.X1 = (float*)(ws + carve(off, (size_t)M_ * D_ * 4)); p.X2 = (float*)(ws + carve(off, (size_t)M_ * D_ * 4));
    p.ACT = (bf16_t*)(ws + carve(off, (size_t)M_ * DFF * 2)); p.BIASL2 = (float*)(ws + carve(off, 1024 * 4)); p.SLAB = (float*)(ws + carve(off, (size_t)11 * MS * D_ * 4));
    if (off > ws_size || out_size != (int)O_END) { fprintf(stderr, "kernel_launch: bad sizes (ws %zu need %zu, out %d expect %zu)\n", ws_size, off, out_size, (size_t)O_END); return; }
    static int grid = 0;
    if (!grid) {
        int dev = 0, cus = 0, per_cu = 0;
        (void)hipGetDevice(&dev); (void)hipDeviceGetAttribute(&cus, hipDeviceAttributeMultiprocessorCount, dev);
        (void)hipFuncSetAttribute((const void*)k_mega, hipFuncAttributeMaxDynamicSharedMemorySize, LDS_BYTES);
        (void)hipOccupancyMaxActiveBlocksPerMultiprocessor(&per_cu, (const void*)k_mega, NTHR, LDS_BYTES);
        if (per_cu < 1) fprintf(stderr, "kernel_launch: occupancy query reports %d workgroups per CU\n", per_cu);
        grid = cus > 0 ? cus : 256;
    }
    (void)hipMemsetAsync(p.bar, 0, XCD_BAR_WORDS * sizeof(unsigned), stream);
    if (ONE_LAUNCH) {
        hipLaunchKernelGGL(k_mega, dim3(grid), dim3(NTHR), LDS_BYTES, stream, p);
    } else {
        launch_phase<PH_PREP>(p, 0, grid, stream);
        for (int l = 0; l < NL_; ++l) {
            launch_phase<PH_IN>(p, l, grid, stream); launch_phase<PH_MIX1>(p, l, grid, stream); launch_phase<PH_ATTN>(p, l, grid, stream);
            launch_phase<PH_OUT>(p, l, grid, stream); launch_phase<PH_GU>(p, l, grid, stream); launch_phase<PH_DOWN>(p, l, grid, stream); launch_phase<PH_DOWNR>(p, l, grid, stream);
        }
        launch_phase<PH_FINAL>(p, 0, grid, stream);
    }
}
```

```cpp
#include <hip/hip_runtime.h>
#include <stdint.h>
#include <stdio.h>

typedef unsigned short bf16_t;
#define DEV __device__ __forceinline__

constexpr int D_ = 1024, NB_ = 4, T_ = 4096, NL_ = 2, NREQ = 128, NS_ = 4, PAST_ = 2048, NPG = 16, NPHYS = 2560;
constexpr int MP = NB_ * T_, MS = NREQ * NS_, M_ = MP + MS;
constexpr int NIN = 2304, DFF = 2816, NGU = 5632, INW = 2072;
constexpr float QSCALE = 0.18033688011112042f;
constexpr float LOG2E = 1.4426950408889634f;

constexpr size_t O_YP = 0, O_YS = O_YP + (size_t)MP * D_, O_CMPP = O_YS + (size_t)MS * D_, O_SLCP = O_CMPP + (size_t)NL_ * NB_ * T_ * 256,
                 O_WINP = O_SLCP + (size_t)NL_ * NB_ * T_ * 256, O_CONVP = O_WINP + (size_t)NL_ * NB_ * 512 * 256, O_POOLP = O_CONVP + (size_t)NL_ * NB_ * 30 * 256,
                 O_CMPS = O_POOLP + (size_t)NL_ * NB_ * 15 * 256, O_SLCS = O_CMPS + (size_t)NL_ * NREQ * 4 * 256, O_WINS = O_SLCS + (size_t)NL_ * NREQ * 4 * 256,
                 O_CONVS = O_WINS + (size_t)NL_ * NREQ * 512 * 256, O_POOLS = O_CONVS + (size_t)NL_ * NREQ * 30 * 256, O_END = O_POOLS + (size_t)NL_ * NREQ * 15 * 256;

__device__ const unsigned char kBucket[128] = {0, 1, 2, 3, 4, 5, 6, 7, 8, 9, 10, 11, 12, 13, 14, 15, 16, 16, 16, 17, 17, 18, 18, 18, 19, 19, 19, 20, 20, 20, 20, 21, 21, 21, 21, 22, 22, 22, 22, 22, 23, 23, 23, 23, 23, 23, 24, 24, 24, 24, 24, 24, 25, 25, 25, 25, 25, 25, 25, 26, 26, 26, 26, 26, 26, 26, 26, 27, 27, 27, 27, 27, 27, 27, 27, 27, 27, 28, 28, 28, 28, 28, 28, 28, 28, 28, 28, 29, 29, 29, 29, 29, 29, 29, 29, 29, 29, 29, 29, 30, 30, 30, 30, 30, 30, 30, 30, 30, 30, 30, 30, 30, 30, 31, 31, 31, 31, 31, 31, 31, 31, 31, 31, 31, 31, 31, 31, 31};

struct Prm {
    const float *x_prompt, *x_sample, *cache_cmp, *cache_slc, *cache_win, *state_conv, *state_pool;
    const int* page_table;
    const float *rel_bias, *norm1, *w_in, *conv_dw, *conv_b, *conv_ln_g, *conv_ln_b, *pool_w, *pool_scale, *pe_k, *wk, *pe_v, *wv, *w_out, *norm2, *w_gu, *w_down, *final_norm;
    float* out;
    unsigned* bar;
    bf16_t *Wt_in, *Wt_out, *Wt_gu, *Wt_down, *Wct;
    float* cb;
    bf16_t* XB;
    float *SSa, *SSb, *G, *U;
    bf16_t *Q, *KVB;
    float* GATES;
    bf16_t *KC, *KCS, *MIX;
    float *X1, *X2;
    bf16_t* ACT;
    float* BIASL2;
    float* SLAB;
};

DEV int opaque_tid() { int t = threadIdx.x; asm volatile("" : "+v"(t)); return t; }
DEV float bf2f(bf16_t v) { return __uint_as_float((unsigned)v << 16); }
DEV bf16_t f2bf(float f) { unsigned u = __float_as_uint(f); u += 0x7fffu + ((u >> 16) & 1u); return (bf16_t)(u >> 16); }
DEV unsigned cvt_pk_bf16(float lo, float hi) { unsigned r; asm("v_cvt_pk_bf16_f32 %0, %1, %2\n\ts_nop 1" : "=v"(r) : "v"(lo), "v"(hi)); return r; }
DEV unsigned pack2(float a, float b) { return cvt_pk_bf16(a, b); }
DEV float wave_sum(float v) { for (int o = 32; o > 0; o >>= 1) v += __shfl_xor(v, o); return v; }
DEV float wave_max(float v) { for (int o = 32; o > 0; o >>= 1) v = fmaxf(v, __shfl_xor(v, o)); return v; }
DEV float sigmoidf_(float x) { return __builtin_amdgcn_rcpf(1.f + __builtin_amdgcn_exp2f(-1.4426950408889634f * x)); }

constexpr int NTHR = 512;
constexpr int LDS_BYTES = 147456;

#define XB_TMO      128
#define XB_XCNT(j)  (256  + 64 * (j))
#define XB_XSUB(j)  (1280 + 64 * (j))
#define XB_XGEN(j)  (2304 + 64 * (j))
#define XB_TOP      3328
#define XB_TOPGEN   3392
#define XCD_BAR_WORDS 3456
#define XB_SPIN_CAP (1u << 24)
#define LAS __attribute__((address_space(3)))
__device__ __forceinline__ unsigned xb_ld(unsigned* p)              { return __hip_atomic_load(p, __ATOMIC_RELAXED, __HIP_MEMORY_SCOPE_AGENT); }
__device__ __forceinline__ unsigned xb_add(unsigned* p, unsigned v) { return __hip_atomic_fetch_add(p, v, __ATOMIC_RELAXED, __HIP_MEMORY_SCOPE_AGENT); }
__device__ __forceinline__ unsigned xb_xcc_id() { return (unsigned)__builtin_amdgcn_s_getreg((3 << 11) | 20) & 0xFu; }
#define XB_SPIN(cond, bar) do { unsigned _sp = 0; while (cond) { __builtin_amdgcn_s_sleep(1); \
    if ((++_sp & 255u) == 0u) { if (xb_ld(&(bar)[XB_TMO])) break; if (_sp > XB_SPIN_CAP) { atomicAdd(&(bar)[XB_TMO], 1u); break; } } } } while (0)
struct XcdBarrier { unsigned* bar; unsigned x; volatile LAS unsigned* st; };
__device__ __forceinline__ XcdBarrier xcd_barrier_post(unsigned* bar, volatile LAS unsigned* st) {
    XcdBarrier b; b.bar = bar; b.x = xb_xcc_id(); b.st = st;
    if (threadIdx.x == 0) (void)xb_add(&bar[XB_XCNT(b.x)], 1u);
    return b;
}
__device__ __forceinline__ void xcd_barrier_complete(unsigned* bar, unsigned x, unsigned& nloc, unsigned& nx) {
    const unsigned G = gridDim.x * gridDim.y * gridDim.z;
    unsigned sum, cnt, mine, sp = 0u;
    for (;;) {
        sum = 0u; cnt = 0u; mine = 0u;
#pragma unroll
        for (unsigned j = 0; j < 16; ++j) { const unsigned c = xb_ld(&bar[XB_XCNT(j)]); sum += c; cnt += (c > 0u) ? 1u : 0u; mine = (j == x) ? c : mine; }
        if (sum == G) break;
        __builtin_amdgcn_s_sleep(1);
        if ((++sp & 255u) == 0u) { if (xb_ld(&bar[XB_TMO])) break; if (sp > XB_SPIN_CAP) { atomicAdd(&bar[XB_TMO], 1u); break; } }
    }
    nloc = mine > 0u ? mine : 1u; nx = cnt > 0u ? cnt : 1u;
}
__device__ __forceinline__ void xcd_barrier(const XcdBarrier& b) {
    asm volatile("s_waitcnt vmcnt(0)" ::: "memory");
    __syncthreads();
    if (threadIdx.x == 0) {
        unsigned* bar = b.bar;
        __builtin_amdgcn_s_waitcnt(0);
        unsigned nloc = b.st[0], nx = b.st[1];
        if (nloc == 0u) { xcd_barrier_complete(bar, b.x, nloc, nx); b.st[0] = nloc; b.st[1] = nx; }
        const unsigned old = xb_add(&bar[XB_XSUB(b.x)], 1u);
        const unsigned gen = old / nloc;
        if (old + 1u == (gen + 1u) * nloc) {
            __builtin_amdgcn_fence(__ATOMIC_RELEASE, "agent");
            asm volatile("s_waitcnt vmcnt(0)" ::: "memory");
            const unsigned og = xb_add(&bar[XB_TOP], 1u);
            const unsigned tg = og / nx;
            if (og + 1u == (tg + 1u) * nx) xb_add(&bar[XB_TOPGEN], 1u);
            else XB_SPIN(xb_ld(&bar[XB_TOPGEN]) == tg, bar);
            __builtin_amdgcn_fence(__ATOMIC_ACQUIRE, "agent");
            xb_add(&bar[XB_XGEN(b.x)], 1u);
            asm volatile("s_waitcnt vmcnt(0)" ::: "memory");
        } else {
            XB_SPIN(xb_ld(&bar[XB_XGEN(b.x)]) == gen, bar);
            __builtin_amdgcn_fence(__ATOMIC_ACQUIRE, "agent");
            asm volatile("s_waitcnt vmcnt(0)" ::: "memory");
        }
    }
    __syncthreads();
}

DEV int srccol(int mode, int n) {
    if (mode == 0) { if (n < 512) { const int t = n >> 8, j = n & 255; return j < 128 ? 128 * t + j : 256 + 128 * t + (j - 128); } return n < INW ? n : -1; }
    if (mode == 2) { const int t = n >> 8, j = n & 255; return j < 128 ? 128 * t + j : DFF + 128 * t + (j - 128); }
    return n;
}
#define WDESC(tg) \
    const int l_ = (tg) / TPL, r_ = (tg) % TPL, which = r_ < 576 ? 0 : (r_ < 832 ? 1 : (r_ < 2240 ? 2 : 3)), tl = r_ - (which == 0 ? 0 : (which == 1 ? 576 : (which == 2 ? 832 : 2240))); \
    const float* src = which == 0 ? p.w_in + (size_t)l_ * D_ * INW : (which == 1 ? p.w_out + (size_t)l_ * D_ * D_ : (which == 2 ? p.w_gu + (size_t)l_ * D_ * NGU : p.w_down + (size_t)l_ * DFF * D_)); \
    const float* gain = which == 0 ? p.norm1 + l_ * D_ : (which == 2 ? p.norm2 + l_ * D_ : nullptr); \
    bf16_t* dst = which == 0 ? p.Wt_in + (size_t)l_ * NIN * D_ : (which == 1 ? p.Wt_out + (size_t)l_ * D_ * D_ : (which == 2 ? p.Wt_gu + (size_t)l_ * NGU * D_ : p.Wt_down + (size_t)l_ * D_ * DFF)); \
    const int K = which == 3 ? DFF : D_, Ns = which == 0 ? INW : (which == 2 ? NGU : D_), ntn = which == 0 ? NIN / 64 : (which == 2 ? NGU / 64 : D_ / 64), mode = which == 0 ? 0 : (which == 2 ? 2 : 1); \
    const int n0 = (tl % ntn) * 64, k0 = (tl / ntn) * 64;
DEV void prep_weights(const Prm& p, float* sm, int vb_first, int vb_end, int bidx, int nblk) {
    const int tid = opaque_tid();
    constexpr int TPL = (NIN / 64) * 16 + 16 * 16 + (NGU / 64) * 16 + 16 * (DFF / 64);
    static_assert(TPL == 2944, "tile counts");
    for (int vb = vb_first + bidx; vb < vb_end; vb += nblk) {
        float4 v[8];
#pragma unroll
        for (int q = 0; q < 4; ++q) {
            WDESC(vb * 4 + q)
#pragma unroll
            for (int i = 0; i < 2; ++i) { const int idx = tid + 512 * i, k = idx >> 4, n4 = (idx & 15) * 4; const int sc = srccol(mode, n0 + n4);
                float4 x = make_float4(0.f, 0.f, 0.f, 0.f);
                if (sc >= 0) { x = *(const float4*)(src + (size_t)(k0 + k) * Ns + sc); if (gain) { const float gk = gain[k0 + k]; x.x *= gk; x.y *= gk; x.z *= gk; x.w *= gk; } }
                v[q * 2 + i] = x; }
            (void)dst; (void)K;
        }
        __syncthreads();
#pragma unroll
        for (int q = 0; q < 4; ++q)
#pragma unroll
            for (int i = 0; i < 2; ++i) { const int idx = tid + 512 * i, k = idx >> 4, n4 = (idx & 15) * 4; float* t = sm + q * (64 * 65) + k * 65 + n4; t[0] = v[q * 2 + i].x; t[1] = v[q * 2 + i].y; t[2] = v[q * 2 + i].z; t[3] = v[q * 2 + i].w; }
        __syncthreads();
#pragma unroll
        for (int q = 0; q < 4; ++q) {
            WDESC(vb * 4 + q)
            const int k8 = tid & 7, n = tid >> 3; const float* t = sm + q * (64 * 65) + (8 * k8) * 65 + n;
            uint4 w; w.x = pack2(t[0], t[65]); w.y = pack2(t[130], t[195]); w.z = pack2(t[260], t[325]); w.w = pack2(t[390], t[455]);
            *(uint4*)(dst + (size_t)(n0 + n) * K + k0 + 8 * k8) = w;
            (void)src; (void)gain; (void)Ns; (void)mode;
        }
    }
}
#undef WDESC
DEV float cb_val(const float* cb, int i) { return ((cb[i] + cb[256 + i]) + cb[512 + i]) + cb[768 + i]; }
DEV void phase_prep(const Prm& p, float* sm) {
    const int tid = opaque_tid(); const size_t gt = (size_t)blockIdx.x * NTHR + tid, gn = (size_t)gridDim.x * NTHR;
    for (size_t base = gt; base < (size_t)2 * 2 * 128 * 1024; base += gn * 4) {
        float v[4];
#pragma unroll
        for (int i = 0; i < 4; ++i) { const size_t idx = base + gn * i; v[i] = 0.f;
            if (idx < (size_t)2 * 2 * 128 * 1024) { const int k = idx & 1023, n = (idx >> 10) & 127, type = (idx >> 17) & 1, l = (int)(idx >> 18);
                const float* src = (type ? p.wv : p.wk) + (size_t)l * 32 * 64 * 64; const int half = n >> 6, e = n & 63; v[i] = src[(size_t)(half * 1024 + k) * 64 + e]; } }
#pragma unroll
        for (int i = 0; i < 4; ++i) { const size_t idx = base + gn * i; if (idx < (size_t)2 * 2 * 128 * 1024) p.Wct[idx] = f2bf(v[i]); }
    }
    if ((int)blockIdx.x >= (int)gridDim.x - 16) {
        const int wq = (int)blockIdx.x - ((int)gridDim.x - 16), lt = wq >> 2, qk = wq & 3, l = lt >> 1, type = lt & 1, e = tid & 63, kq = tid >> 6;
        const float* w = (type ? p.wv : p.wk) + (size_t)l * 32 * 64 * 64; const float* pe = (type ? p.pe_v : p.pe_k) + (size_t)l * 32 * 64;
        float acc = 0.f;
#pragma unroll 1
        for (int k0 = qk * 512 + kq * 64; k0 < qk * 512 + kq * 64 + 64; k0 += 64) {
            float wv[64];
#pragma unroll
            for (int i = 0; i < 64; ++i) wv[i] = w[(size_t)(k0 + i) * 64 + e];
#pragma unroll
            for (int i = 0; i < 64; ++i) acc += pe[k0 + i] * wv[i];
        }
        sm[tid] = acc; __syncthreads();
        if (tid < 64) { float a = 0.f; for (int q = 0; q < 8; ++q) a += sm[q * 64 + tid]; p.cb[qk * 256 + lt * 64 + tid] = a; }
        __syncthreads(); }
    if (gt < 1024) { const int dist = (int)gt & 127, gr = (int)gt >> 7; p.BIASL2[gt] = p.rel_bias[kBucket[dist] * 8 + gr] * LOG2E; }
    {
        const int wv = tid >> 6, lane = tid & 63;
        for (int m0 = (blockIdx.x * 8 + wv) * 2; m0 < M_; m0 += gridDim.x * 16) {
            float4 v[2][4];
#pragma unroll
            for (int rr = 0; rr < 2; ++rr) { const int m = m0 + rr; const float* x = m < MP ? p.x_prompt + (size_t)m * D_ : p.x_sample + (size_t)(m - MP) * D_;
#pragma unroll
                for (int i = 0; i < 4; ++i) v[rr][i] = *(const float4*)(x + i * 256 + lane * 4); }
#pragma unroll
            for (int rr = 0; rr < 2; ++rr) { const int m = m0 + rr; float sq = 0.f;
#pragma unroll
                for (int i = 0; i < 4; ++i) { const float4 a = v[rr][i]; sq += (a.x * a.x + a.y * a.y) + (a.z * a.z + a.w * a.w); uint2 w; w.x = pack2(a.x, a.y); w.y = pack2(a.z, a.w); *(uint2*)(p.XB + (size_t)m * D_ + i * 256 + lane * 4) = w; }
                sq = wave_sum(sq);
                if (lane < 16) p.SSb[(size_t)m * 16 + lane] = lane == 0 ? sq : 0.f; }
        }
    }
    prep_weights(p, sm, 0, 576 / 4, (int)blockIdx.x, (int)gridDim.x);
}
DEV float row_rs(const float* SS, int m) {
    const float4* q = (const float4*)(SS + (size_t)m * 16); const float4 a = q[0], b = q[1], c = q[2], d = q[3];
    float s = 0.f; s += a.x; s += a.y; s += a.z; s += a.w; s += b.x; s += b.y; s += b.z; s += b.w; s += c.x; s += c.y; s += c.z; s += c.w; s += d.x; s += d.y; s += d.z; s += d.w;
    return rsqrtf(s * (1.f / 1024.f) + 1e-6f); }
DEV void st8f(float* dst, const float (&v)[8]) { *(float4*)dst = make_float4(v[0], v[1], v[2], v[3]); *(float4*)(dst + 4) = make_float4(v[4], v[5], v[6], v[7]); }
DEV void st8b(bf16_t* dst, const float (&v)[8]) { uint4 w; w.x = pack2(v[0], v[1]); w.y = pack2(v[2], v[3]); w.z = pack2(v[4], v[5]); w.w = pack2(v[6], v[7]); *(uint4*)dst = w; }

struct EpiIn {
    static constexpr bool HAS_SS = false, USE_RS = true, HAS_AUX = false;
    const Prm& p; int l; float* ss;
    DEV const float* ss_src() const { return p.SSb; }
    DEV float apply(int m, int pn, int j, const float (&lo_)[8], const float (&hi_)[8], float rs) const {
        float lo[8], hi[8];
#pragma unroll
        for (int i = 0; i < 8; ++i) { lo[i] = lo_[i] * rs; hi[i] = hi_[i] * rs; }
        const bool samp = m >= MP; const int b = m / T_, t = m % T_, req = (m - MP) >> 2, s = (m - MP) & 3;
        if (pn < 2) {
            float g[8];
#pragma unroll
            for (int i = 0; i < 8; ++i) g[i] = lo[i] * sigmoidf_(hi[i]);
            const int c = 128 * pn + j;
            st8f(p.G + (size_t)m * 256 + c, g);
            if (!samp) { if (t >= T_ - 30) st8f(p.out + O_CONVP + ((size_t)(l * NB_ + b) * 30 + (t - (T_ - 30))) * 256 + c, g); }
            else st8f(p.out + O_CONVS + ((size_t)(l * NREQ + req) * 30 + 26 + s) * 256 + c, g);
        } else if (pn == 2) {
            st8f(p.U + (size_t)m * 256 + j, lo); st8f(p.U + (size_t)m * 256 + 128 + j, hi);
            if (!samp) { if (t >= T_ - 15) { float* o = p.out + O_POOLP + ((size_t)(l * NB_ + b) * 15 + (t - (T_ - 15))) * 256; st8f(o + j, lo); st8f(o + 128 + j, hi); } }
            else { float* o = p.out + O_POOLS + ((size_t)(l * NREQ + req) * 15 + 11 + s) * 256; st8f(o + j, lo); st8f(o + 128 + j, hi); }
        } else if (pn < 5) {
            const int g = pn - 3; float a[8], c[8];
#pragma unroll
            for (int i = 0; i < 8; ++i) { a[i] = lo[i] * QSCALE; c[i] = hi[i] * QSCALE; }
            st8b(p.Q + (size_t)m * 512 + g * 256 + j, a); st8b(p.Q + (size_t)m * 512 + g * 256 + 128 + j, c);
        } else if (pn < 8) {
            const int br = pn - 5, g = j >> 6, d = j & 63;
            long long oo;
            if (!samp) oo = br == 0 ? (long long)(O_CMPP + ((size_t)(l * NB_ + b) * T_ + t) * 256) : (br == 1 ? (long long)(O_SLCP + ((size_t)(l * NB_ + b) * T_ + t) * 256)
                          : (t >= T_ - 512 ? (long long)(O_WINP + ((size_t)(l * NB_ + b) * 512 + (t - (T_ - 512))) * 256) : -1ll));
            else oo = br == 0 ? (long long)(O_CMPS + ((size_t)(l * NREQ + req) * 4 + s) * 256) : (br == 1 ? (long long)(O_SLCS + ((size_t)(l * NREQ + req) * 4 + s) * 256)
                          : (long long)(O_WINS + ((size_t)(l * NREQ + req) * 512 + 508 + s) * 256));
            if (oo >= 0) { st8f(p.out + oo + j, lo); st8f(p.out + oo + 128 + j, hi); }
            if (!samp) {
                bf16_t* kb = p.KVB + ((((size_t)(br * 2) * NB_ + b) * 2 + g) * T_ + t) * 64 + d;
                st8b(kb, lo); st8b(kb + (size_t)NB_ * 2 * T_ * 64, hi);
            }
        } else {
            if (j < 24) {
#pragma unroll
                for (int i = 0; i < 8; ++i) p.GATES[(size_t)m * 24 + j + i] = sigmoidf_(lo[i]);
            }
        }
        return 0.f;
    }
};
struct EpiRes {
    static constexpr bool HAS_SS = true, USE_RS = false, HAS_AUX = true;
    const Prm& p; int mode;
    float* ss; bool keep_f32;
    struct Aux { float4 r0, r1, r2, r3; };
    DEV Aux fetch(int m, int pn, int j) const {
        const int c = pn * 256 + j; Aux a;
        if (mode == 0) {
            const float* rb = (m < MP ? p.x_prompt + (size_t)m * D_ : p.x_sample + (size_t)(m - MP) * D_) + c;
            a.r0 = *(const float4*)(rb); a.r1 = *(const float4*)(rb + 4); a.r2 = *(const float4*)(rb + 128); a.r3 = *(const float4*)(rb + 132);
        } else {
            const bf16_t* rb = p.XB + (size_t)m * D_ + c; const uint4 u = *(const uint4*)rb, v = *(const uint4*)(rb + 128);
            a.r0 = make_float4(__uint_as_float(u.x << 16), __uint_as_float(u.x & 0xffff0000u), __uint_as_float(u.y << 16), __uint_as_float(u.y & 0xffff0000u));
            a.r1 = make_float4(__uint_as_float(u.z << 16), __uint_as_float(u.z & 0xffff0000u), __uint_as_float(u.w << 16), __uint_as_float(u.w & 0xffff0000u));
            a.r2 = make_float4(__uint_as_float(v.x << 16), __uint_as_float(v.x & 0xffff0000u), __uint_as_float(v.y << 16), __uint_as_float(v.y & 0xffff0000u));
            a.r3 = make_float4(__uint_as_float(v.z << 16), __uint_as_float(v.z & 0xffff0000u), __uint_as_float(v.w << 16), __uint_as_float(v.w & 0xffff0000u));
        }
        return a;
    }
    DEV float apply(int m, int pn, int j, const float (&lo)[8], const float (&hi)[8]) const { return apply(m, pn, j, lo, hi, fetch(m, pn, j)); }
    DEV float apply(int m, int pn, int j, const float (&lo)[8], const float (&hi)[8], const Aux& ax) const {
        const int c = pn * 256 + j;
        float a[8], h[8]; float sq = 0.f;
        const float4 r0 = ax.r0, r1 = ax.r1, r2 = ax.r2, r3 = ax.r3;
        a[0] = lo[0] + r0.x; a[1] = lo[1] + r0.y; a[2] = lo[2] + r0.z; a[3] = lo[3] + r0.w; a[4] = lo[4] + r1.x; a[5] = lo[5] + r1.y; a[6] = lo[6] + r1.z; a[7] = lo[7] + r1.w;
        h[0] = hi[0] + r2.x; h[1] = hi[1] + r2.y; h[2] = hi[2] + r2.z; h[3] = hi[3] + r2.w; h[4] = hi[4] + r3.x; h[5] = hi[5] + r3.y; h[6] = hi[6] + r3.z; h[7] = hi[7] + r3.w;
#pragma unroll
        for (int i = 0; i < 8; ++i) sq += a[i] * a[i] + h[i] * h[i];
        st8b(p.XB + (size_t)m * D_ + c, a); st8b(p.XB + (size_t)m * D_ + c + 128, h);
        return sq;
    }
};
struct EpiGU {
    static constexpr bool HAS_SS = false, USE_RS = true, HAS_AUX = false;
    const Prm& p; float* ss;
    DEV const float* ss_src() const { return p.SSa; }
    DEV float apply(int m, int pn, int j, const float (&lo)[8], const float (&hi)[8], float rs) const {
        float a[8];
#pragma unroll
        for (int i = 0; i < 8; ++i) { const float g = lo[i] * rs, u = hi[i] * rs; a[i] = g * sigmoidf_(g) * u; }
        st8b(p.ACT + (size_t)m * DFF + pn * 128 + j, a);
        return 0.f;
    }
};

namespace pg8 {
#define PG8_LAS __attribute__((address_space(3)))
using ::bf16_t;
typedef short bf16x8 __attribute__((ext_vector_type(8)));
typedef float f32x4 __attribute__((ext_vector_type(4)));
typedef unsigned u32x4 __attribute__((ext_vector_type(4)));
constexpr int BM = 256, BK = 64, HALF = 128, HTB = HALF * BK * 2  , STAGE_BYTES = 8 * HTB, NXCD = 8, WGM = 8;

__host__ __device__ __forceinline__ int lds_byte(int r, int c) { const int st = (r >> 4) * 2 + (c >> 5), rr = r & 15, cc = c & 31, ob = rr * 64 + cc * 2; return st * 1024 + (ob ^ (((ob >> 9) & 1) << 5)); }
__host__ __device__ __forceinline__ void stage_rc(int b, int& R, int& C) { const int st = b / 1024, sb = b % 1024, swz = sb ^ (((sb >> 9) & 1) << 5); R = (st >> 1) * 16 + swz / 64; C = (st & 1) * 32 + (swz % 64) / 2; }
__host__ __device__ __forceinline__ int perm32(int rho) { const int n = rho >> 4, i = rho & 15; return 8 * (i >> 2) + 4 * n + (i & 3); }

struct Unit { int pm, pn, kq; };
struct Gemm { const bf16_t* A; const bf16_t* Bt; int M, N, K, Kl; };

struct StaticOrder {
    int nM, nN, nwg, G, c;
    __host__ __device__ void init(int M, int N, int G_, int c_) { nM = M / BM; nN = N / BM; nwg = nM * nN; G = G_; c = c_; }
    __host__ __device__ bool next(int i, Unit& u) const {
        const long L = (long)i * G + c; if (L >= nwg) return false;
        int wgid = (int)L; { const int q = nwg / NXCD, r = nwg % NXCD, xcd = wgid % NXCD, off = wgid / NXCD; wgid = (xcd < r ? xcd * (q + 1) : r * (q + 1) + (xcd - r) * q) + off; }
        const int nig = WGM * nN, gid = wgid / nig, fm = gid * WGM, gsz = (nM - fm) < WGM ? (nM - fm) : WGM;
        u.pm = fm + ((wgid % nig) % gsz); u.pn = (wgid % nig) / gsz; u.kq = 0; return true;
    }
    __device__ __forceinline__ void a_ready(const Unit&) const {}
    __device__ __forceinline__ void done(const Unit&) const {}
};

template <class Epi, class Sched, bool ALIGN_EPI = false, bool SP2 = false>
__device__ __forceinline__ void gemm_phase(PG8_LAS unsigned char* lds, const Gemm g, const Sched& S, const Epi& E) {
    const int tid = opaque_tid(), wid = __builtin_amdgcn_readfirstlane(tid >> 6), lane = tid & 63, wr = wid >> 2, wc = wid & 3, fr = lane & 15, fq = lane >> 4;
    const int K = g.K, nt = g.Kl / BK;
    unsigned voffA[2], voffB[2];
#pragma unroll
    for (int i = 0; i < 2; ++i) { int R, C; stage_rc(tid * 16 + i * 8192, R, C); const int Rb = Epi::PERM ? ((R & ~31) + perm32(R & 31)) : R;
        voffA[i] = (unsigned)(R * K + C) * 2u; voffB[i] = (unsigned)(Rb * K + C) * 2u; }
    const size_t kstep = (size_t)(BK * 2);
    const size_t hstep = (size_t)HALF * K * 2;
    const size_t tstep = 2 * hstep;
    const unsigned ldsw = (unsigned)wid * 1024u;
    const int aoff = lds_byte(wr * 64 + fr, fq * 8), boff = lds_byte(wc * 32 + fr, fq * 8);
#define PG8_SA(b, h) (((b) * 2 + (h)) * HTB)
#define PG8_SB(b, h) ((4 + (b) * 2 + (h)) * HTB)
#define PG8_STAGE(bufoff, gbase, voff) do { _Pragma("unroll") for (int _i = 0; _i < 2; ++_i) \
        __builtin_amdgcn_global_load_lds((const unsigned*)((const char*)(gbase) + (voff)[_i]), (PG8_LAS unsigned*)(lds + (bufoff) + ldsw + _i * 8192), 16, 0, 0); } while (0)
#define PG8_LDA(dst, b, h) do { _Pragma("unroll") for (int m = 0; m < 4; ++m) _Pragma("unroll") for (int k = 0; k < 2; ++k) dst[m][k] = *(const PG8_LAS bf16x8*)(lds + PG8_SA(b, h) + aoff + m * 2048 + k * 1024); } while (0)
#define PG8_LDB(dst, b, h) do { _Pragma("unroll") for (int n = 0; n < 2; ++n) _Pragma("unroll") for (int k = 0; k < 2; ++k) dst[n][k] = *(const PG8_LAS bf16x8*)(lds + PG8_SB(b, h) + boff + n * 2048 + k * 1024); } while (0)
#define PG8_MMA(ai, bj, At, Bt) do { __builtin_amdgcn_s_setprio(1); _Pragma("unroll") for (int m = 0; m < 4; ++m) _Pragma("unroll") for (int n = 0; n < 2; ++n) _Pragma("unroll") for (int k = 0; k < 2; ++k) \
        acc[ai][bj][m][n] = __builtin_amdgcn_mfma_f32_16x16x32_bf16(Bt[n][k], At[m][k], acc[ai][bj][m][n], 0, 0, 0); __builtin_amdgcn_s_setprio(0); } while (0)
#define PG8_WAIT_V(n) asm volatile("s_waitcnt vmcnt(" #n ")" ::: "memory")
#define PG8_WAIT_L(n) asm volatile("s_waitcnt lgkmcnt(" #n ")" ::: "memory")
#define PG8_BAR __builtin_amdgcn_s_barrier()
#define PG8_SCHED __builtin_amdgcn_sched_barrier(0)
    Unit cur, nxt; int ui = 0;
    if (!S.next(0, cur)) return;
    f32x4 acc[2][2][4][2];
#pragma unroll
    for (int a = 0; a < 2; ++a)
#pragma unroll
        for (int b = 0; b < 2; ++b)
#pragma unroll
            for (int m = 0; m < 4; ++m)
#pragma unroll
                for (int n = 0; n < 2; ++n) acc[a][b][m][n] = (f32x4){0.f, 0.f, 0.f, 0.f};
    bf16x8 At[4][2], B0[2][2], B1[2][2];
    const unsigned kqb = (unsigned)g.Kl * 2u;
    const char* cA = (const char*)g.A + (size_t)cur.pm * tstep + (unsigned)cur.kq * kqb; const char* cB = (const char*)g.Bt + (size_t)cur.pn * tstep + (unsigned)cur.kq * kqb;
    S.a_ready(cur);
    if constexpr (SP2) {
        PG8_STAGE(PG8_SB(0, 0), cB, voffB); PG8_STAGE(PG8_SB(0, 1), cB + hstep, voffB); PG8_STAGE(PG8_SA(0, 0), cA, voffA); PG8_STAGE(PG8_SA(0, 1), cA + hstep, voffA);
        if (wr == 1) PG8_BAR;
        PG8_WAIT_V(2); PG8_BAR;
        PG8_STAGE(PG8_SB(1, 0), cB + kstep, voffB); PG8_STAGE(PG8_SA(1, 0), cA + kstep, voffA); PG8_STAGE(PG8_SB(1, 1), cB + hstep + kstep, voffB);
        PG8_WAIT_V(6); PG8_BAR;
    } else {
        PG8_STAGE(PG8_SB(0, 0), cB, voffB); PG8_STAGE(PG8_SA(0, 0), cA, voffA); PG8_STAGE(PG8_SB(0, 1), cB + hstep, voffB); PG8_STAGE(PG8_SA(0, 1), cA + hstep, voffA);
        if (wr == 1) PG8_BAR;
        PG8_WAIT_V(4); PG8_BAR;
        PG8_STAGE(PG8_SB(1, 0), cB + kstep, voffB); PG8_STAGE(PG8_SA(1, 0), cA + kstep, voffA); PG8_STAGE(PG8_SB(1, 1), cB + hstep + kstep, voffB);
        PG8_WAIT_V(6); PG8_BAR;
    }
    for (;;) {
        const bool has_next = S.next(ui + 1, nxt);
        const char* nA = has_next ? (const char*)g.A + (size_t)nxt.pm * tstep + (unsigned)nxt.kq * kqb : cA; const char* nB = has_next ? (const char*)g.Bt + (size_t)nxt.pn * tstep + (unsigned)nxt.kq * kqb : cB;
        for (int t = 0; t < nt; t += 2) {
            const bool last = (t == nt - 2);
            const char* a1 = cA + (size_t)(t + 1) * kstep;
            const char* a2 = last ? nA : cA + (size_t)(t + 2) * kstep; const char* b2 = last ? nB : cB + (size_t)(t + 2) * kstep;
            const char* a3 = a2 + kstep; const char* b3 = b2 + kstep;
            if (last && has_next) S.a_ready(nxt);
            if constexpr (SP2) {
            PG8_LDB(B0, 0, 0); PG8_LDB(B1, 0, 1); PG8_SCHED; PG8_LDA(At, 0, 0); PG8_STAGE(PG8_SA(1, 1), a1 + hstep, voffA);
            PG8_WAIT_V(8); PG8_WAIT_L(0); PG8_BAR; PG8_MMA(0, 0, At, B0); PG8_MMA(0, 1, At, B1); PG8_BAR; PG8_SCHED;
            PG8_LDA(At, 0, 1); PG8_STAGE(PG8_SB(0, 0), b2, voffB); PG8_STAGE(PG8_SB(0, 1), b2 + hstep, voffB); PG8_STAGE(PG8_SA(0, 0), a2, voffA);
            PG8_WAIT_V(8); PG8_WAIT_L(0); PG8_BAR; PG8_MMA(1, 0, At, B0); PG8_MMA(1, 1, At, B1); PG8_BAR; PG8_SCHED;
            PG8_LDB(B0, 1, 0); PG8_LDB(B1, 1, 1); PG8_SCHED; PG8_LDA(At, 1, 0); PG8_STAGE(PG8_SA(0, 1), a2 + hstep, voffA);
            PG8_WAIT_V(8); PG8_WAIT_L(0); PG8_BAR; PG8_MMA(0, 0, At, B0); PG8_MMA(0, 1, At, B1); PG8_BAR; PG8_SCHED;
            PG8_LDA(At, 1, 1); PG8_STAGE(PG8_SB(1, 0), b3, voffB); PG8_STAGE(PG8_SB(1, 1), b3 + hstep, voffB); PG8_STAGE(PG8_SA(1, 0), a3, voffA);
            PG8_WAIT_V(8); PG8_WAIT_L(0); PG8_BAR; PG8_MMA(1, 0, At, B0); PG8_MMA(1, 1, At, B1); PG8_BAR; PG8_SCHED;
            } else {
            PG8_LDB(B0, 0, 0); PG8_SCHED; PG8_LDA(At, 0, 0); PG8_STAGE(PG8_SA(1, 1), a1 + hstep, voffA);
            PG8_WAIT_L(8); PG8_BAR; PG8_WAIT_L(0); PG8_MMA(0, 0, At, B0); PG8_BAR; PG8_SCHED;
            PG8_LDB(B1, 0, 1); PG8_STAGE(PG8_SB(0, 0), b2, voffB);
            PG8_BAR; PG8_WAIT_L(0); PG8_MMA(0, 1, At, B1); PG8_BAR;
            PG8_LDA(At, 0, 1); PG8_STAGE(PG8_SA(0, 0), a2, voffA);
            PG8_BAR; PG8_WAIT_L(0); PG8_MMA(1, 0, At, B0); PG8_BAR; PG8_SCHED;
            PG8_STAGE(PG8_SB(0, 1), b2 + hstep, voffB);
            PG8_WAIT_V(6); PG8_BAR; PG8_MMA(1, 1, At, B1); PG8_BAR;
            PG8_LDB(B0, 1, 0); PG8_SCHED; PG8_LDA(At, 1, 0); PG8_STAGE(PG8_SA(0, 1), a2 + hstep, voffA);
            PG8_WAIT_L(8); PG8_BAR; PG8_WAIT_L(0); PG8_MMA(0, 0, At, B0); PG8_BAR; PG8_SCHED;
            PG8_LDB(B1, 1, 1); PG8_STAGE(PG8_SB(1, 0), b3, voffB);
            PG8_BAR; PG8_WAIT_L(0); PG8_MMA(0, 1, At, B1); PG8_BAR;
            PG8_LDA(At, 1, 1); PG8_STAGE(PG8_SA(1, 0), a3, voffA);
            PG8_BAR; PG8_WAIT_L(0); PG8_MMA(1, 0, At, B0); PG8_BAR; PG8_SCHED;
            PG8_STAGE(PG8_SB(1, 1), b3 + hstep, voffB);
            PG8_WAIT_V(6); PG8_BAR; PG8_MMA(1, 1, At, B1); PG8_BAR;
            }
        }
        if constexpr (ALIGN_EPI) { if (wr == 0) PG8_BAR; }
        if constexpr (!Epi::AFTER_DRAIN) { E(acc, cur, wr, wc, fr, fq); S.done(cur); }
        if (!has_next) break;
#pragma unroll
        for (int a = 0; a < 2; ++a)
#pragma unroll
            for (int b = 0; b < 2; ++b)
#pragma unroll
                for (int m = 0; m < 4; ++m)
#pragma unroll
                    for (int n = 0; n < 2; ++n) acc[a][b][m][n] = (f32x4){0.f, 0.f, 0.f, 0.f};
        cur = nxt; cA = nA; cB = nB; ++ui;
        if constexpr (ALIGN_EPI) { if (wr == 1) PG8_BAR; }
    }
    PG8_WAIT_V(0);
    if constexpr (!ALIGN_EPI) { if (wr == 0) PG8_BAR; }
    PG8_BAR;
    if constexpr (Epi::AFTER_DRAIN) { E.fused(acc, cur, wr, wc, fr, fq, lds, wid, lane); S.done(cur); }
#undef PG8_SA
#undef PG8_SB
#undef PG8_STAGE
#undef PG8_LDA
#undef PG8_LDB
#undef PG8_MMA
#undef PG8_WAIT_V
#undef PG8_WAIT_L
#undef PG8_BAR
#undef PG8_SCHED
}
}

constexpr int RSL_OFF = 131072;
template <class E> struct EpiAdapt {
    static constexpr bool PERM = true, AFTER_DRAIN = false;
    const E& e; const float* rsl; mutable int ui;
    __device__ __forceinline__ void operator()(const pg8::f32x4 (&acc)[2][2][4][2], const pg8::Unit& u, int wr, int wc, int fr, int fq) const {
        const int j = wc * 32 + 8 * fq;
        float rsv[2][4];
        if constexpr (E::USE_RS) {
#pragma unroll
            for (int ai = 0; ai < 2; ++ai)
#pragma unroll
                for (int m = 0; m < 4; ++m) rsv[ai][m] = rsl[ui * 256 + ai * 128 + wr * 64 + m * 16 + fr];
        }
        if constexpr (E::HAS_AUX) {
            int row = u.pm * 256 + wr * 64 + fr; asm volatile("" : "+v"(row));
            typename E::Aux nx = e.fetch(row, u.pn, j);
#pragma unroll
            for (int g = 0; g < 8; ++g) {
                const int ai = g >> 2, m = g & 3;
                const typename E::Aux cu = nx;
                if (g < 7) { int rn = u.pm * 256 + ((g + 1) >> 2) * 128 + wr * 64 + ((g + 1) & 3) * 16 + fr; asm volatile("" : "+v"(rn)); nx = e.fetch(rn, u.pn, j); }
                float lo[8], hi[8];
#pragma unroll
                for (int i = 0; i < 4; ++i) { lo[i] = acc[ai][0][m][0][i]; lo[4 + i] = acc[ai][0][m][1][i]; hi[i] = acc[ai][1][m][0][i]; hi[4 + i] = acc[ai][1][m][1][i]; }
                float sq = e.apply(row, u.pn, j, lo, hi, cu);
                if (E::HAS_SS) { sq += __shfl_xor(sq, 16); sq += __shfl_xor(sq, 32); if (fq == 0) e.ss[(size_t)row * 16 + u.pn * 4 + wc] = sq; }
                row = u.pm * 256 + ((g + 1) >> 2) * 128 + wr * 64 + ((g + 1) & 3) * 16 + fr; asm volatile("" : "+v"(row));
            }
        } else {
#pragma unroll
            for (int ai = 0; ai < 2; ++ai)
#pragma unroll
                for (int m = 0; m < 4; ++m) {
                    int row = u.pm * 256 + ai * 128 + wr * 64 + m * 16 + fr;
                    asm volatile("" : "+v"(row));
                    float lo[8], hi[8];
#pragma unroll
                    for (int i = 0; i < 4; ++i) { lo[i] = acc[ai][0][m][0][i]; lo[4 + i] = acc[ai][0][m][1][i]; hi[i] = acc[ai][1][m][0][i]; hi[4 + i] = acc[ai][1][m][1][i]; }
                    float sq = e.apply(row, u.pn, j, lo, hi, rsv[ai][m]);
                    if (E::HAS_SS) { sq += __shfl_xor(sq, 16); sq += __shfl_xor(sq, 32); if (fq == 0) e.ss[(size_t)row * 16 + u.pn * 4 + wc] = sq; }
                }
        }
        ++ui;
    }
};
template <class E> DEV void gemm_fast(unsigned char* lds, const bf16_t* A, const bf16_t* Bt, int M, int N, int K, const E& e) {
    pg8::Gemm g{A, Bt, M, N, K, K}; pg8::StaticOrder S; S.init(M, N, (int)gridDim.x, (int)blockIdx.x);
    const float* rsl = (const float*)(lds + RSL_OFF);
    if constexpr (E::USE_RS) {
        const int tid = opaque_tid(); pg8::Unit u;
        __syncthreads();
        for (int i = tid >> 8; S.next(i, u); i += 2) ((float*)(lds + RSL_OFF))[i * 256 + (tid & 255)] = row_rs(e.ss_src(), u.pm * 256 + (tid & 255));
        __syncthreads();
    }
    EpiAdapt<E> ad{e, rsl, 0};
    pg8::gemm_phase<EpiAdapt<E>, pg8::StaticOrder, true, true>((PG8_LAS unsigned char*)lds, g, S, ad);
}

struct SplitOrder {
    int npn, nkq, G, c;
    __device__ bool next(int i, pg8::Unit& u) const { const long L = (long)i * G + (G - 1 - c); if (L >= 2L * npn * nkq) return false; const int x = (int)L; u.pm = MP / 256 + (x & 1); u.pn = (x >> 1) % npn; u.kq = (x >> 1) / npn; return true; }
    __device__ __forceinline__ void a_ready(const pg8::Unit&) const {}
    __device__ __forceinline__ void done(const pg8::Unit&) const {}
};
struct EpiPartial {
    static constexpr bool PERM = true, AFTER_DRAIN = false;
    float* slab; int N;
    __device__ __forceinline__ void operator()(const pg8::f32x4 (&acc)[2][2][4][2], const pg8::Unit& u, int wr, int wc, int fr, int fq) const {
        const int j = wc * 32 + 8 * fq;
#pragma unroll
        for (int ai = 0; ai < 2; ++ai)
#pragma unroll
            for (int m = 0; m < 4; ++m) {
                const int rs = (u.pm - MP / 256) * 256 + ai * 128 + wr * 64 + m * 16 + fr;
                float* o = slab + ((size_t)u.kq * MS + rs) * N + u.pn * 256 + j;
                *(pg8::f32x4*)(o) = acc[ai][0][m][0]; *(pg8::f32x4*)(o + 4) = acc[ai][0][m][1]; *(pg8::f32x4*)(o + 128) = acc[ai][1][m][0]; *(pg8::f32x4*)(o + 132) = acc[ai][1][m][1];
            }
    }
};
DEV void gemm_split(unsigned char* lds, const bf16_t* A, const bf16_t* Bt, int N, int K, int Kl, float* slab) {
    pg8::Gemm g{A, Bt, M_, N, K, Kl}; SplitOrder S{N / 256, K / Kl, (int)gridDim.x, (int)blockIdx.x};
    EpiPartial ep{slab, N};
    pg8::gemm_phase<EpiPartial, SplitOrder, false, false>((PG8_LAS unsigned char*)lds, g, S, ep);
}
template <class E> DEV void gemm_reduce(const float* slab, int N, int nkq, const E& e) {
    const int ntn = N / 256, total = MS * ntn * 16;
    for (int gid = blockIdx.x * NTHR + opaque_tid(); gid < total; gid += gridDim.x * NTHR) {
        const int jj = gid & 15, pn = (gid >> 4) % ntn, rs = (gid >> 4) / ntn, j = jj * 8;
        float lo[8], hi[8];
#pragma unroll
        for (int i = 0; i < 8; ++i) { lo[i] = 0.f; hi[i] = 0.f; }
#pragma unroll
        for (int kq = 0; kq < nkq; ++kq) {
            const float* o = slab + ((size_t)kq * MS + rs) * N + pn * 256 + j;
            const float4 a = *(const float4*)(o), b = *(const float4*)(o + 4), c = *(const float4*)(o + 128), d = *(const float4*)(o + 132);
            lo[0] += a.x; lo[1] += a.y; lo[2] += a.z; lo[3] += a.w; lo[4] += b.x; lo[5] += b.y; lo[6] += b.z; lo[7] += b.w;
            hi[0] += c.x; hi[1] += c.y; hi[2] += c.z; hi[3] += c.w; hi[4] += d.x; hi[5] += d.y; hi[6] += d.z; hi[7] += d.w;
        }
        float sq = e.apply(MP + rs, pn, j, lo, hi);
        if (E::HAS_SS) { sq += __shfl_xor(sq, 1); sq += __shfl_xor(sq, 2); if ((jj & 3) == 0) e.ss[(size_t)(MP + rs) * 16 + pn * 4 + (jj >> 2)] = sq; }
    }
}

DEV void gemm_reduce_final(const Prm& p, const float* slab, int nkq_) {
    constexpr int N = D_, ntn = N / 256, total = MS * ntn * 16, nkq = DFF / 256; (void)nkq_;
    for (int gid = blockIdx.x * NTHR + opaque_tid(); gid < total; gid += gridDim.x * NTHR) {
        const int jj = gid & 15, pn = (gid >> 4) % ntn, rs = (gid >> 4) / ntn, j = jj * 8, c = pn * 256 + j;
        float lo[8], hi[8];
#pragma unroll
        for (int i = 0; i < 8; ++i) { lo[i] = 0.f; hi[i] = 0.f; }
#pragma unroll
        for (int kq = 0; kq < nkq; ++kq) {
            const float* o = slab + ((size_t)kq * MS + rs) * N + c;
            const float4 a = *(const float4*)(o), b = *(const float4*)(o + 4), cc = *(const float4*)(o + 128), d = *(const float4*)(o + 132);
            lo[0] += a.x; lo[1] += a.y; lo[2] += a.z; lo[3] += a.w; lo[4] += b.x; lo[5] += b.y; lo[6] += b.z; lo[7] += b.w;
            hi[0] += cc.x; hi[1] += cc.y; hi[2] += cc.z; hi[3] += cc.w; hi[4] += d.x; hi[5] += d.y; hi[6] += d.z; hi[7] += d.w;
        }
        const bf16_t* rb = p.XB + (size_t)(MP + rs) * D_ + c; const uint4 u = *(const uint4*)rb, v = *(const uint4*)(rb + 128);
        const unsigned uu[4] = {u.x, u.y, u.z, u.w}, vv[4] = {v.x, v.y, v.z, v.w};
        float sq = 0.f;
#pragma unroll
        for (int i = 0; i < 4; ++i) { lo[2 * i] += __uint_as_float(uu[i] << 16); lo[2 * i + 1] += __uint_as_float(uu[i] & 0xffff0000u); hi[2 * i] += __uint_as_float(vv[i] << 16); hi[2 * i + 1] += __uint_as_float(vv[i] & 0xffff0000u); }
#pragma unroll
        for (int i = 0; i < 8; ++i) sq += lo[i] * lo[i] + hi[i] * hi[i];
        sq = wave_sum(sq);
        const float r = rsqrtf(sq * (1.f / 1024.f) + 1e-6f);
        const float* g = p.final_norm + c; float* y = p.out + (size_t)(MP + rs) * D_ + c;
        const float4 g0 = *(const float4*)(g), g1 = *(const float4*)(g + 4), g2 = *(const float4*)(g + 128), g3 = *(const float4*)(g + 132);
        *(float4*)(y) = make_float4(lo[0] * r * g0.x, lo[1] * r * g0.y, lo[2] * r * g0.z, lo[3] * r * g0.w); *(float4*)(y + 4) = make_float4(lo[4] * r * g1.x, lo[5] * r * g1.y, lo[6] * r * g1.z, lo[7] * r * g1.w);
        *(float4*)(y + 128) = make_float4(hi[0] * r * g2.x, hi[1] * r * g2.y, hi[2] * r * g2.z, hi[3] * r * g2.w); *(float4*)(y + 132) = make_float4(hi[4] * r * g3.x, hi[5] * r * g3.y, hi[6] * r * g3.z, hi[7] * r * g3.w);
    }
}

DEV void convpool_item(const Prm& p, int l, int item, float* sm) {
    float* cbuf = sm; float* pbuf = sm + 62 * 256; float* yb = sm + (62 + 47) * 256;
    const int tid = opaque_tid(), c = tid & 255, half = tid >> 8, wave = tid >> 6, lane = tid & 63;
    const bool samp = item >= 512; const int NT = samp ? 4 : 32, ntok = NT / 2;
    int m0, t0 = 0, req = 0;
    if (!samp) { m0 = item * 32; t0 = m0 % T_; } else { req = item - 512; m0 = MP + req * 4; }
    __syncthreads();
    {
        float4 vc[8], vp[6];
#pragma unroll
        for (int i = 0; i < 8; ++i) { const int idx = tid + NTHR * i, r = idx >> 6, c4 = (idx & 63) * 4, rel = r - 30; float4 v = make_float4(0.f, 0.f, 0.f, 0.f);
            if (r < NT + 30) { if (!samp) { if (t0 + rel >= 0) v = *(const float4*)(p.G + (size_t)(m0 + rel) * 256 + c4); }
                else { if (rel < 0) v = *(const float4*)(p.state_conv + ((size_t)(l * NREQ + req) * 30 + r) * 256 + c4); else v = *(const float4*)(p.G + (size_t)(m0 + rel) * 256 + c4); } }
            vc[i] = v; }
#pragma unroll
        for (int i = 0; i < 6; ++i) { const int idx = tid + NTHR * i, r = idx >> 6, c4 = (idx & 63) * 4, rel = r - 15; float4 v = make_float4(0.f, 0.f, 0.f, 0.f);
            if (r < NT + 15) { if (!samp) { if (t0 + rel >= 0) v = *(const float4*)(p.U + (size_t)(m0 + rel) * 256 + c4); }
                else { if (rel < 0) v = *(const float4*)(p.state_pool + ((size_t)(l * NREQ + req) * 15 + r) * 256 + c4); else v = *(const float4*)(p.U + (size_t)(m0 + rel) * 256 + c4); } }
            vp[i] = v; }
#pragma unroll
        for (int i = 0; i < 8; ++i) { const int idx = tid + NTHR * i, r = idx >> 6, c4 = (idx & 63) * 4; if (r < NT + 30) *(float4*)(cbuf + r * 256 + c4) = vc[i]; }
#pragma unroll
        for (int i = 0; i < 6; ++i) { const int idx = tid + NTHR * i, r = idx >> 6, c4 = (idx & 63) * 4; if (r < NT + 15) *(float4*)(pbuf + r * 256 + c4) = vp[i]; }
    }
    __syncthreads();
    {
        const float cbias = p.conv_b[l * 256 + c];
        float dw[31];
#pragma unroll
        for (int w = 0; w < 31; ++w) dw[w] = p.conv_dw[(size_t)(l * 31 + w) * 256 + c];
        const float* bp = cbuf + (half * ntok) * 256 + c;
        if (!samp) {
#pragma unroll 1
            for (int k4 = 0; k4 < 4; ++k4) {
                float a0 = cbias, a1 = cbias, a2 = cbias, a3 = cbias;
#pragma unroll
                for (int rr = 0; rr < 34; ++rr) {
                    const float v = bp[(k4 * 4 + rr) * 256];
                    if (rr < 31) a0 += v * dw[rr];
                    if (rr >= 1 && rr < 32) a1 += v * dw[rr - 1];
                    if (rr >= 2 && rr < 33) a2 += v * dw[rr - 2];
                    if (rr >= 3) a3 += v * dw[rr - 3];
                }
                float* yo = yb + (half * ntok + k4 * 4) * 256 + c; yo[0] = a0; yo[256] = a1; yo[512] = a2; yo[768] = a3;
            }
        } else {
            float a0 = cbias, a1 = cbias;
#pragma unroll
            for (int rr = 0; rr < 32; ++rr) { const float v = bp[rr * 256]; if (rr < 31) a0 += v * dw[rr]; if (rr >= 1) a1 += v * dw[rr - 1]; }
            float* yo = yb + (half * ntok) * 256 + c; yo[0] = a0; yo[256] = a1;
        }
    }
    if (samp) {
        for (int idx = tid; idx < 26 * 256; idx += NTHR) p.out[O_CONVS + ((size_t)(l * NREQ + req) * 30) * 256 + idx] = cbuf[4 * 256 + idx];
        for (int idx = tid; idx < 11 * 256; idx += NTHR) p.out[O_POOLS + ((size_t)(l * NREQ + req) * 15) * 256 + idx] = pbuf[4 * 256 + idx];
    }
    __syncthreads();
    for (int tok = wave; tok < NT; tok += 8) {
        const float4 v = *(const float4*)(yb + tok * 256 + lane * 4);
        const float mean = wave_sum((v.x + v.y) + (v.z + v.w)) * (1.f / 256.f);
        const float x0 = v.x - mean, x1 = v.y - mean, x2 = v.z - mean, x3 = v.w - mean;
        const float var = wave_sum((x0 * x0 + x1 * x1) + (x2 * x2 + x3 * x3)) * (1.f / 256.f);
        const float r = rsqrtf(var + 1e-6f);
        const float4 g = *(const float4*)(p.conv_ln_g + l * 256 + lane * 4), bb = *(const float4*)(p.conv_ln_b + l * 256 + lane * 4);
        float y0 = x0 * r * g.x + bb.x, y1 = x1 * r * g.y + bb.y, y2 = x2 * r * g.z + bb.z, y3 = x3 * r * g.w + bb.w;
        y0 *= sigmoidf_(y0); y1 *= sigmoidf_(y1); y2 *= sigmoidf_(y2); y3 *= sigmoidf_(y3);
        uint2 w; w.x = pack2(y0, y1); w.y = pack2(y2, y3);
        *(uint2*)(p.MIX + (size_t)(m0 + tok) * D_ + lane * 4) = w;
    }
    __syncthreads();
    {
        const int w = 2 << (c >> 6);
#pragma unroll 1
        for (int k = 0; k < ntok; ++k) {
            const int tok = half * ntok + k; float v[16];
#pragma unroll
            for (int i = 0; i < 16; ++i) v[i] = pbuf[(tok + 15 - i) * 256 + c];
            float sacc = v[0] + v[1];
#pragma unroll
            for (int i = 2; i < 16; ++i) sacc += i < w ? v[i] : 0.f;
            const int cnt = samp ? w : min(w, t0 + tok + 1);
            yb[tok * 256 + c] = sacc / (float)cnt - v[0];
        }
    }
    __syncthreads();
    {
        const int e = tid & 63, g = (tid >> 6) & 3; const float sc = p.pool_scale[l * 256 + g * 64 + e];
        const float* wp = p.pool_w + (size_t)(l * 4 + g) * 64 * 64 + e;
        float wr[64];
#pragma unroll
        for (int cc = 0; cc < 64; ++cc) wr[cc] = wp[cc * 64];
#pragma unroll 1
        for (int k = 0; k < ntok; ++k) {
            const int tok = half * ntok + k; float acc = 0.f; const float* yr = yb + tok * 256 + g * 64;
#pragma unroll
            for (int c4 = 0; c4 < 16; ++c4) { const float4 y = *(const float4*)(yr + c4 * 4); acc += y.x * wr[c4 * 4] + y.y * wr[c4 * 4 + 1] + y.z * wr[c4 * 4 + 2] + y.w * wr[c4 * 4 + 3]; }
            p.MIX[(size_t)(m0 + tok) * D_ + 256 + g * 64 + e] = f2bf(acc * sc);
        }
    }
}
typedef short bf16x8_t __attribute__((ext_vector_type(8)));
typedef short s16x4_t __attribute__((ext_vector_type(4)));
typedef float f32x16_t __attribute__((ext_vector_type(16)));
DEV unsigned off64(unsigned row, unsigned ch) { return 1024u * (row >> 3) + 512u * (ch >> 2) + 64u * (row & 7) + 16u * ((ch & 3) ^ ((row >> 2) & 3)); }
enum { AM_FAR = 0, AM_NEAR = 1, AM_DIAG = 2, AM_WINFIRST = 3, AM_CMP = 4 };
constexpr int AT_RING = 6, AT_KB = 0, AT_VB = AT_RING * 8192, AT_BT = 2 * AT_RING * 8192, AT_PA = AT_BT + 2048, AT_SELM = AT_PA + 32768, AT_LDS = AT_SELM + 512;
static_assert(AT_LDS <= LDS_BYTES - 16, "attention LDS map");

struct AttnState { f32x16_t O0, O1; float m, l; };

template <bool PRIO = false> DEV void attn_qk(const unsigned char* kb, unsigned ka0, const bf16x8_t (&qf)[4], f32x16_t& S0, f32x16_t& S1) {
#pragma unroll
    for (int i = 0; i < 16; ++i) { S0[i] = 0.f; S1[i] = 0.f; }
    if (PRIO) __builtin_amdgcn_s_setprio(1);
#pragma unroll
    for (int ks = 0; ks < 4; ++ks) {
        const unsigned a = (ka0 ^ ((ks & 1) ? 32u : 0u)) + 512u * (ks >> 1);
        const bf16x8_t a0 = *(const bf16x8_t*)(kb + a), a1 = *(const bf16x8_t*)(kb + a + 4096);
        S0 = __builtin_amdgcn_mfma_f32_32x32x16_bf16(a0, qf[ks], S0, 0, 0, 0);
        S1 = __builtin_amdgcn_mfma_f32_32x32x16_bf16(a1, qf[ks], S1, 0, 0, 0);
    }
    if (PRIO) __builtin_amdgcn_s_setprio(0);
}
template <bool PRIO = false> DEV void attn_pv(unsigned vbase, unsigned va_rel, const f32x16_t& pa, const f32x16_t& pb, f32x16_t& O0, f32x16_t& O1) {
    const unsigned vb_addr0 = vbase + va_rel, vb1 = vbase + (va_rel ^ 32u) + 1024u;
#pragma unroll
    for (int k4 = 0; k4 < 4; ++k4) {
        const f32x16_t& P = (k4 < 2) ? pa : pb; const int s = k4 & 1;
        unsigned w[4];
#pragma unroll
        for (int i = 0; i < 4; ++i) w[i] = cvt_pk_bf16(P[8 * s + 2 * i], P[8 * s + 2 * i + 1]);
        bf16x8_t pf; { typedef unsigned u32x4_t __attribute__((ext_vector_type(4))); u32x4_t t = {w[0], w[1], w[2], w[3]}; pf = __builtin_bit_cast(bf16x8_t, t); }
        s16x4_t v00, v01, v10, v11;
        asm volatile("ds_read_b64_tr_b16 %0, %4 offset:%6\n\tds_read_b64_tr_b16 %1, %5 offset:%6\n\tds_read_b64_tr_b16 %2, %4 offset:%7\n\tds_read_b64_tr_b16 %3, %5 offset:%7\n\ts_waitcnt lgkmcnt(0)"
                     : "=&v"(v00), "=&v"(v01), "=&v"(v10), "=&v"(v11) : "v"(vb_addr0), "v"(vb1), "i"(2048 * k4), "i"(2048 * k4 + 512) : "memory");
        const bf16x8_t a0 = __builtin_shufflevector(v00, v01, 0, 1, 2, 3, 4, 5, 6, 7), a1 = __builtin_shufflevector(v10, v11, 0, 1, 2, 3, 4, 5, 6, 7);
        if (PRIO) __builtin_amdgcn_s_setprio(1);
        O0 = __builtin_amdgcn_mfma_f32_32x32x16_bf16(a0, pf, O0, 0, 0, 0);
        O1 = __builtin_amdgcn_mfma_f32_32x32x16_bf16(a1, pf, O1, 0, 0, 0);
        if (PRIO) __builtin_amdgcn_s_setprio(0);
    }
}
template <int MODE> DEV void attn_bias(f32x16_t& S0, f32x16_t& S1, int dl, float lb, const float* bt_r) {
    constexpr int STEP = MODE == AM_CMP ? 16 : 1;
#pragma unroll
    for (int u = 0; u < 2; ++u)
#pragma unroll
        for (int v = 0; v < 16; ++v) {
            float s = u ? S1[v] : S0[v];
            const int dist = dl - STEP * (32 * u + (v & 3) + 8 * (v >> 2));
            if (MODE == AM_FAR) s += lb;
            else if (MODE == AM_WINFIRST) s = dist < 512 ? s + lb : -1e30f;
            else if (MODE == AM_NEAR) s += bt_r[min(max(dist, 0), 127)] + lb;
            else s = dist >= 0 ? s + bt_r[min(max(dist, 0), 127)] : -1e30f;
            if (u) S1[v] = s; else S0[v] = s;
        }
}
template <bool MASKED> DEV float attn_tilemax(const f32x16_t& S0, const f32x16_t& S1) {
    float t = fmaxf(S0[0], S1[0]);
#pragma unroll
    for (int v = 1; v < 16; ++v) t = fmaxf(t, fmaxf(S0[v], S1[v]));
    return fmaxf(t, __shfl_xor(t, 32));
}
template <bool MASKED> DEV float attn_exp(f32x16_t& S0, f32x16_t& S1, float mref, float scale) {
    float sum = 0.f;
#pragma unroll
    for (int v = 0; v < 16; ++v) {
        float e0 = __builtin_amdgcn_exp2f(S0[v] - mref), e1 = __builtin_amdgcn_exp2f(S1[v] - mref);
        if (MASKED) { e0 = S0[v] > -1e29f ? e0 : 0.f; e1 = S1[v] > -1e29f ? e1 : 0.f; }
        e0 *= scale; e1 *= scale;
        S0[v] = e0; S1[v] = e1; sum += e0 + e1;
    }
    return sum;
}
template <int MODE> DEV void attn_tile(const unsigned char* kb, unsigned ka0, unsigned vbase, unsigned va_rel, const bf16x8_t (&qf)[4], AttnState& st, int dl, float lb, const float* bt_r) {
    constexpr bool MASKED = MODE >= AM_DIAG;
    f32x16_t S0, S1;
    attn_qk(kb, ka0, qf, S0, S1);
    attn_bias<MODE>(S0, S1, dl, lb, bt_r);
    const float tm = attn_tilemax<MASKED>(S0, S1);
    const float mn = fmaxf(st.m, tm), alpha = __builtin_amdgcn_exp2f(st.m - mn);
    st.m = mn;
    const float ps = attn_exp<MASKED>(S0, S1, mn, 1.f);
    st.l = st.l * alpha + ps;
#pragma unroll
    for (int v = 0; v < 16; ++v) { st.O0[v] *= alpha; st.O1[v] *= alpha; }
    attn_pv(vbase, va_rel, S0, S1, st.O0, st.O1);
}

DEV void attn_prompt_unit(const Prm& p, int l, int b, int g, int qb, unsigned char* lds) {
    const int tid = opaque_tid(), w = tid >> 6, lane = tid & 63, c = lane & 31, h = lane >> 5, qi = c >> 2, r = c & 3;
    float* BT = (float*)(lds + AT_BT); float* PA = (float*)(lds + AT_PA) + w * 1024; float* PB = PA + 512;
    unsigned* SELM = (unsigned*)(lds + AT_SELM) + w * 16;
    __syncthreads();
    BT[tid] = p.BIASL2[g * 512 + tid];
#pragma unroll
    for (int i = 0; i < 16; ++i) ((float*)(lds + AT_PA))[tid + 512 * i] = 0.f;
    const int tq = 64 * qb + 8 * w + qi; const size_t mrow = (size_t)b * T_ + tq;
    bf16x8_t qf[4];
#pragma unroll
    for (int ks = 0; ks < 4; ++ks) qf[ks] = *(const bf16x8_t*)(p.Q + mrow * 512 + g * 256 + r * 64 + ks * 16 + 8 * h);
    const float gc = p.GATES[mrow * 24 + g * 4 + r], gs = p.GATES[mrow * 24 + 8 + g * 4 + r], gw = p.GATES[mrow * 24 + 16 + g * 4 + r];
    const float* bt_r = BT + r * 128;
    const unsigned ka0 = 1024u * ((unsigned)c >> 3) + 64u * (c & 7) + 16u * ((unsigned)h ^ (((unsigned)c >> 2) & 3u));
    const unsigned blk = (lane >> 4) & 1, q4 = (lane & 15) >> 2, pp = lane & 3;
    const unsigned va_rel = 64u * (4u * h + q4) + 8u * (pp & 1) + 16u * ((2u * blk + (pp >> 1)) ^ (unsigned)h);
    const unsigned lds_base = (unsigned)(size_t)(LAS unsigned char*)lds;
    const bf16_t* KCb = p.KC + (((size_t)b * 2 + g) * 2 + 0) * 256 * 64; const bf16_t* VCb = KCb + 256 * 64;
    const bf16_t* KSb = p.KVB + ((((size_t)(1 * 2 + 0) * NB_ + b) * 2 + g) * T_) * 64; const bf16_t* VSb = p.KVB + ((((size_t)(1 * 2 + 1) * NB_ + b) * 2 + g) * T_) * 64;
    const bf16_t* KWb = p.KVB + ((((size_t)(2 * 2 + 0) * NB_ + b) * 2 + g) * T_) * 64; const bf16_t* VWb = p.KVB + ((((size_t)(2 * 2 + 1) * NB_ + b) * 2 + g) * T_) * 64;
    const int nC = (4 * qb + 66) >> 6, nS = qb + 1, w0 = qb > 8 ? qb - 8 : 0, nW = qb - w0 + 1, J = 2 * nC + nS + nW;
    const int ws = __builtin_amdgcn_readfirstlane(w);
    const int ldrow = 8 * ws + ((lane >> 2) & 7), ldch = 4 * (lane >> 5) + ((lane & 3) ^ ((2 * ws + ((lane >> 4) & 1)) & 3));
    const size_t ldsrc = (size_t)ldrow * 64 + ldch * 8;
    auto job_src = [&](int ji, const bf16_t*& kp, const bf16_t*& vp) {
        if (ji < nC) { kp = KCb + (size_t)ji * 4096; vp = VCb + (size_t)ji * 4096; }
        else if (ji < 2 * nC) { kp = KCb + (size_t)(ji - nC) * 4096; vp = VCb + (size_t)(ji - nC) * 4096; }
        else if (ji < 2 * nC + nS) { kp = KSb + (size_t)(ji - 2 * nC) * 4096; vp = VSb + (size_t)(ji - 2 * nC) * 4096; }
        else { kp = KWb + (size_t)(w0 + ji - 2 * nC - nS) * 4096; vp = VWb + (size_t)(w0 + ji - 2 * nC - nS) * 4096; }
    };
    auto dma = [&](int ji) {
        const bf16_t* kp; const bf16_t* vp; job_src(ji, kp, vp); const int bufo = (ji % AT_RING) * 8192 + ws * 1024;
        __builtin_amdgcn_global_load_lds((const unsigned*)(kp + ldsrc), (LAS unsigned*)(lds + AT_KB + bufo), 16, 0, 0);
        __builtin_amdgcn_global_load_lds((const unsigned*)(vp + ldsrc), (LAS unsigned*)(lds + AT_VB + bufo), 16, 0, 0);
    };
    dma(0); dma(1); dma(2); dma(3);
    asm volatile("s_waitcnt vmcnt(4) lgkmcnt(0)" ::: "memory");
    __builtin_amdgcn_s_barrier();
    asm volatile("" ::: "memory");
    const float b31 = bt_r[127];
    AttnState st;
#pragma unroll
    for (int v = 0; v < 16; ++v) { st.O0[v] = 0.f; st.O1[v] = 0.f; }
    st.m = -1e30f; st.l = 0.f;
    f32x16_t A0, A1;
#pragma unroll
    for (int v = 0; v < 16; ++v) { A0[v] = 0.f; A1[v] = 0.f; }
    float mC = -1e30f, invC = 0.f; unsigned mlo = 0xffffffffu, mhi = 0xffffffffu;
    for (int jp = 0; jp < J; jp += 2) {
      const int nnew = (jp + 4 < J ? 1 : 0) + (jp + 5 < J ? 1 : 0);
      if (jp + 4 < J) dma(jp + 4);
      if (jp + 5 < J) dma(jp + 5);
#pragma unroll 1
      for (int ji = jp; ji < jp + 2 && ji < J; ++ji) {
        const unsigned char* kb = lds + AT_KB + (ji % AT_RING) * 8192; const unsigned vbase = lds_base + AT_VB + (ji % AT_RING) * 8192;
        if (ji < nC) {
            const int dl = tq - 31 - 1024 * ji - 64 * h;
            f32x16_t S0, S1; attn_qk(kb, ka0, qf, S0, S1); attn_bias<AM_CMP>(S0, S1, dl, 0.f, bt_r);
            const float tm = attn_tilemax<true>(S0, S1); const float mn = fmaxf(st.m, tm), alpha = __builtin_amdgcn_exp2f(st.m - mn); st.m = mn;
            st.l = st.l * alpha + attn_exp<true>(S0, S1, mn, 1.f);
            if (ji == nC - 1) { const float lt = st.l + __shfl_xor(st.l, 32); mC = st.m; invC = lt > 0.f ? 1.f / lt : 0.f; }
        } else if (ji < 2 * nC) {
            const int ct = ji - nC; const int dl = tq - 31 - 1024 * ct - 64 * h;
            f32x16_t S0, S1; attn_qk(kb, ka0, qf, S0, S1); attn_bias<AM_CMP>(S0, S1, dl, 0.f, bt_r);
            (void)attn_exp<true>(S0, S1, mC, invC);
            if (qb >= 16) {
#pragma unroll
                for (int u = 0; u < 2; ++u)
#pragma unroll
                    for (int qd = 0; qd < 4; ++qd) {
                        const f32x16_t& P = u ? S1 : S0;
                        float qs = (P[4 * qd] + P[4 * qd + 1]) + (P[4 * qd + 2] + P[4 * qd + 3]), ls = P[4 * qd + 3];
                        qs += __shfl_xor(qs, 1); qs += __shfl_xor(qs, 2); ls += __shfl_xor(ls, 1); ls += __shfl_xor(ls, 2);
                        const int jq = 16 * ct + 8 * u + 2 * qd + h;
                        if (r == 0) { PA[qi * 64 + jq] = qs; if (jq + 1 < 64) PB[qi * 64 + jq + 1] = ls; }
                    }
            }
            attn_pv(vbase, va_rel, S0, S1, st.O0, st.O1);
        } else if (ji < 2 * nC + nS) {
            const int j = ji - 2 * nC; const int dl = tq - 64 * j - 4 * h;
            const bool sel = j < 32 ? ((mlo >> j) & 1u) : ((mhi >> (j - 32)) & 1u);
            if (j == qb) attn_tile<AM_DIAG>(kb, ka0, vbase, va_rel, qf, st, dl, 0.f, bt_r);
            else if (__ballot(sel) != 0ull) {
                if (j >= qb - 2) attn_tile<AM_NEAR>(kb, ka0, vbase, va_rel, qf, st, dl, sel ? 0.f : -1e30f, bt_r);
                else attn_tile<AM_FAR>(kb, ka0, vbase, va_rel, qf, st, dl, sel ? b31 : -1e30f, bt_r);
            }
        } else {
            const int kbi = w0 + ji - 2 * nC - nS; const int dl = tq - 64 * kbi - 4 * h;
            if (kbi == qb) attn_tile<AM_DIAG>(kb, ka0, vbase, va_rel, qf, st, dl, 0.f, bt_r);
            else if (kbi >= qb - 2) attn_tile<AM_NEAR>(kb, ka0, vbase, va_rel, qf, st, dl, 0.f, bt_r);
            else if (kbi == qb - 8) attn_tile<AM_WINFIRST>(kb, ka0, vbase, va_rel, qf, st, dl, b31, bt_r);
            else attn_tile<AM_FAR>(kb, ka0, vbase, va_rel, qf, st, dl, b31, bt_r);
        }
        if (ji == jp + 1 || ji == J - 1) {
            if (nnew == 2) asm volatile("s_waitcnt vmcnt(4) lgkmcnt(0)" ::: "memory"); else if (nnew == 1) asm volatile("s_waitcnt vmcnt(2) lgkmcnt(0)" ::: "memory"); else asm volatile("s_waitcnt vmcnt(0) lgkmcnt(0)" ::: "memory");
            __builtin_amdgcn_s_barrier();
            asm volatile("" ::: "memory");
        }
        if (ji == 2 * nC - 1) {
#pragma unroll
            for (int v = 0; v < 16; ++v) { A0[v] = gc * st.O0[v]; A1[v] = gc * st.O1[v]; st.O0[v] = 0.f; st.O1[v] = 0.f; }
            st.m = -1e30f; st.l = 0.f;
            __syncthreads();
            if (qb >= 16) {
                for (int q = 0; q < 8; ++q) {
                    const bool cand = lane >= 1 && lane <= qb - 2;
                    const float sc = cand ? PA[q * 64 + lane] + PB[q * 64 + lane] : -1.f;
                    int cnt = 0;
                    for (int i = 1; i <= qb - 2; ++i) { const float si = __builtin_bit_cast(float, __builtin_amdgcn_readlane(__builtin_bit_cast(int, sc), i)); cnt += (si > sc || (si == sc && i < lane)) ? 1 : 0; }
                    const unsigned long long bal = __ballot(cand && cnt < 13) | 1ull | (1ull << qb) | (1ull << (qb - 1));
                    if (lane == 0) { SELM[q * 2] = (unsigned)bal; SELM[q * 2 + 1] = (unsigned)(bal >> 32); }
                }
            }
            __syncthreads();
            if (qb >= 16) { mlo = SELM[qi * 2]; mhi = SELM[qi * 2 + 1]; }
        }
        if (ji == 2 * nC + nS - 1 || ji == J - 1) {
            const float lt = st.l + __shfl_xor(st.l, 32); const float sc = (ji == J - 1 ? gw : gs) * (lt > 0.f ? 1.f / lt : 0.f);
#pragma unroll
            for (int v = 0; v < 16; ++v) { A0[v] += sc * st.O0[v]; A1[v] += sc * st.O1[v]; st.O0[v] = 0.f; st.O1[v] = 0.f; }
            st.m = -1e30f; st.l = 0.f;
        }
      }
    }
    bf16_t* o = p.MIX + mrow * D_ + 512 + g * 256 + r * 64 + 4 * h;
#pragma unroll
    for (int dt = 0; dt < 2; ++dt)
#pragma unroll
        for (int qd = 0; qd < 4; ++qd) {
            const f32x16_t& A = dt ? A1 : A0; uint2 wv; wv.x = cvt_pk_bf16(A[4 * qd], A[4 * qd + 1]); wv.y = cvt_pk_bf16(A[4 * qd + 2], A[4 * qd + 3]);
            *(uint2*)(o + 32 * dt + 8 * qd) = wv;
        }
}

constexpr int CS_G = 17408, CS_BUF = 2 * CS_G, CS_B = 2 * CS_BUF, CS_BB = 16384;
DEV void cmp_sample_item(const Prm& p, int l, int req, int type, unsigned char* lds) {
    const int tid = opaque_tid(), w = tid >> 6, lane = tid & 63, c = lane & 31, h = lane >> 5, g = w >> 2, ib = w & 3;
    const int cidx = tid & 15, rsub = tid >> 4, lg = cidx >> 3, lch = cidx & 7;
    __syncthreads();
    if (tid < 64) { const int bufi = tid >> 5, gg = (tid >> 4) & 1, ch = tid & 7; if ((tid & 15) < 8) *(uint4*)(lds + bufi * CS_BUF + gg * CS_G + off64(128, ch)) = make_uint4(0u, 0u, 0u, 0u); }
    const float* src[4]; unsigned dst[4];
#pragma unroll
    for (int ps = 0; ps < 4; ++ps) { const int i = ps * 32 + rsub; const int page = p.page_table[req * NPG + (i >> 3)];
        src[ps] = p.cache_cmp + (((((size_t)l * NPHYS + page) * 128 + (i & 7) * 16) * 2 + type) * 2) * 64 + cidx * 8; dst[ps] = lg * CS_G + off64(i, lch); }
    const bf16_t* wsrc = p.Wct + (size_t)(l * 2 + type) * 128 * 1024 + (size_t)(tid >> 2) * 1024 + (tid & 3) * 16;
    const unsigned wdst0 = CS_B + off64(tid >> 2, (tid & 3) * 2), wdst1 = CS_B + off64(tid >> 2, (tid & 3) * 2 + 1);
    float4 ra[4], rb[4], rc[4], rd[4]; uint4 wq0, wq1, wq2, wq3;
#pragma unroll
    for (int ps = 0; ps < 4; ++ps) { rc[ps] = *(const float4*)(src[ps]); rd[ps] = *(const float4*)(src[ps] + 4); }
    wq2 = *(const uint4*)(wsrc); wq3 = *(const uint4*)(wsrc + 8);
#pragma unroll
    for (int ps = 0; ps < 4; ++ps) { ra[ps] = *(const float4*)(src[ps] + 256); rb[ps] = *(const float4*)(src[ps] + 256 + 4); }
    wq0 = *(const uint4*)(wsrc + 64); wq1 = *(const uint4*)(wsrc + 64 + 8);
#pragma unroll
    for (int ps = 0; ps < 4; ++ps) { uint4 wv; wv.x = cvt_pk_bf16(rc[ps].x, rc[ps].y); wv.y = cvt_pk_bf16(rc[ps].z, rc[ps].w); wv.z = cvt_pk_bf16(rd[ps].x, rd[ps].y); wv.w = cvt_pk_bf16(rd[ps].z, rd[ps].w); *(uint4*)(lds + dst[ps]) = wv; }
    *(uint4*)(lds + wdst0) = wq2; *(uint4*)(lds + wdst1) = wq3;
    __syncthreads();
    f32x16_t acc0, acc1;
#pragma unroll
    for (int v = 0; v < 16; ++v) { acc0[v] = 0.f; acc1[v] = 0.f; }
    const unsigned alo = g * CS_G + off64(32 * ib + c, h), ahi = g * CS_G + off64(32 * ib + c + 1, h);
    const unsigned bo = CS_B + off64(c, h);
#define CS_ISSUE(RA, RB, W0, W1, st) do { _Pragma("unroll") for (int ps = 0; ps < 4; ++ps) { RA[ps] = *(const float4*)(src[ps] + (size_t)(st) * 256); RB[ps] = *(const float4*)(src[ps] + (size_t)(st) * 256 + 4); } \
        W0 = *(const uint4*)(wsrc + (st) * 64); W1 = *(const uint4*)(wsrc + (st) * 64 + 8); } while (0)
#define CS_COMMIT(RA, RB, W0, W1, st) do { unsigned char* nb = lds + ((st) & 1) * CS_BUF; _Pragma("unroll") for (int ps = 0; ps < 4; ++ps) { uint4 wv; wv.x = cvt_pk_bf16(RA[ps].x, RA[ps].y); wv.y = cvt_pk_bf16(RA[ps].z, RA[ps].w); \
        wv.z = cvt_pk_bf16(RB[ps].x, RB[ps].y); wv.w = cvt_pk_bf16(RB[ps].z, RB[ps].w); *(uint4*)(nb + dst[ps]) = wv; } \
        *(uint4*)(lds + ((st) & 1) * CS_BB + wdst0) = W0; *(uint4*)(lds + ((st) & 1) * CS_BB + wdst1) = W1; } while (0)
#define CS_COMPUTE(st) do { const unsigned char* ab = lds + ((st) & 1) * CS_BUF; const unsigned char* bb = lds + ((st) & 1) * CS_BB; _Pragma("unroll") for (int ks = 0; ks < 4; ++ks) { \
        const unsigned sw = (ks & 1) ? 32u : 0u, ad = 512u * (ks >> 1); \
        const bf16x8_t fa = *(const bf16x8_t*)(ab + (alo ^ sw) + ad), fb = *(const bf16x8_t*)(ab + (ahi ^ sw) + ad); \
        const unsigned char* bk = bb + (bo ^ sw) + ad; \
        const bf16x8_t b00 = *(const bf16x8_t*)(bk), b01 = *(const bf16x8_t*)(bk + 4096), b10 = *(const bf16x8_t*)(bk + 8192), b11 = *(const bf16x8_t*)(bk + 12288); \
        acc0 = __builtin_amdgcn_mfma_f32_32x32x16_bf16(fa, b00, acc0, 0, 0, 0); acc1 = __builtin_amdgcn_mfma_f32_32x32x16_bf16(fa, b01, acc1, 0, 0, 0); \
        acc0 = __builtin_amdgcn_mfma_f32_32x32x16_bf16(fb, b10, acc0, 0, 0, 0); acc1 = __builtin_amdgcn_mfma_f32_32x32x16_bf16(fb, b11, acc1, 0, 0, 0); } } while (0)
#pragma unroll 1
    for (int ll = 0; ll < 16; ll += 2) {
        if (ll + 2 < 16) CS_ISSUE(rc, rd, wq2, wq3, ll + 2);
        CS_COMPUTE(ll);
        CS_COMMIT(ra, rb, wq0, wq1, ll + 1);
        __syncthreads();
        if (ll + 3 < 16) CS_ISSUE(ra, rb, wq0, wq1, ll + 3);
        CS_COMPUTE(ll + 1);
        if (ll + 2 < 16) CS_COMMIT(rc, rd, wq2, wq3, ll + 2);
        __syncthreads();
    }
#undef CS_ISSUE
#undef CS_COMMIT
#undef CS_COMPUTE
    bf16_t* o = p.KCS + (((((size_t)l * NREQ + req) * 2 + g) * 2 + type) * 128) * 64;
    const float cb0 = cb_val(p.cb, (l * 2 + type) * 64 + c), cb1 = cb_val(p.cb, (l * 2 + type) * 64 + 32 + c);
#pragma unroll
    for (int v = 0; v < 16; ++v) {
        const int i = 32 * ib + (v & 3) + 8 * (v >> 2) + 4 * h;
        o[(size_t)i * 64 + c] = i == 127 ? (bf16_t)0 : f2bf(acc0[v] + cb0); o[(size_t)i * 64 + 32 + c] = i == 127 ? (bf16_t)0 : f2bf(acc1[v] + cb1);
    }
}
DEV void cmp_sample_fast(const Prm& p, int l, unsigned char* lds) {
    for (int it = blockIdx.x; it < NREQ * 2; it += gridDim.x) cmp_sample_item(p, l, it >> 1, it & 1, lds);
}

constexpr int AS_BT = 131072, AS_PA = AS_BT + 2048, AS_SELM = AS_PA + 4096, AS_LDS = AS_SELM + 64;
template <int NH = 2, class RowFn, class DstFn> DEV void as_load_f32(unsigned char* kt, unsigned char* vt, int lane, RowFn rowp, DstFn dstp) {
    const int rsub = lane >> 4, li = lane & 15;
    constexpr int NI = 16 / NH;
#pragma unroll 1
    for (int hf = 0; hf < NH; ++hf) {
        float4 kx[NI], vx[NI];
#pragma unroll
        for (int it = 0; it < NI; ++it) { const float* rp = rowp(32 * hf + 4 * it + rsub);
            if (rp) { kx[it] = *(const float4*)(rp + li * 4); vx[it] = *(const float4*)(rp + 128 + li * 4); } else { kx[it] = make_float4(0.f, 0.f, 0.f, 0.f); vx[it] = kx[it]; } }
#pragma unroll
        for (int it = 0; it < NI; ++it) { const unsigned o = off64(32 * hf + 4 * it + rsub, li >> 1) + 8 * (li & 1);
            uint2 a, b; a.x = cvt_pk_bf16(kx[it].x, kx[it].y); a.y = cvt_pk_bf16(kx[it].z, kx[it].w); b.x = cvt_pk_bf16(vx[it].x, vx[it].y); b.y = cvt_pk_bf16(vx[it].z, vx[it].w);
            *(uint2*)(kt + o) = a; *(uint2*)(vt + o) = b;
            float* dp = dstp(32 * hf + 4 * it + rsub); if (dp) { *(float4*)(dp + li * 4) = kx[it]; *(float4*)(dp + 128 + li * 4) = vx[it]; } }
    }
}
DEV void as_load_bf16(unsigned char* t, const bf16_t* src, int lane) {
    uint4 v[8];
#pragma unroll
    for (int it = 0; it < 8; ++it) v[it] = *(const uint4*)(src + (size_t)(8 * it + (lane >> 3)) * 64 + (lane & 7) * 8);
#pragma unroll
    for (int it = 0; it < 8; ++it) *(uint4*)(t + off64(8 * it + (lane >> 3), lane & 7)) = v[it];
}
template <int MODE, bool FM> DEV void attn_tile_m(const unsigned char* kb, unsigned ka0, unsigned vbase, unsigned va_rel, const bf16x8_t (&qf)[4], AttnState& st, int dl, float lb, const float* bt_r) {
    constexpr bool MASKED = FM || MODE >= AM_DIAG;
    f32x16_t S0, S1;
    attn_qk(kb, ka0, qf, S0, S1);
    attn_bias<MODE>(S0, S1, dl, lb, bt_r);
    const float tm = attn_tilemax<MASKED>(S0, S1);
    const float mn = fmaxf(st.m, tm), alpha = __builtin_amdgcn_exp2f(st.m - mn);
    st.m = mn;
    const float ps = attn_exp<MASKED>(S0, S1, mn, 1.f);
    st.l = st.l * alpha + ps;
#pragma unroll
    for (int v = 0; v < 16; ++v) { st.O0[v] *= alpha; st.O1[v] *= alpha; }
    attn_pv(vbase, va_rel, S0, S1, st.O0, st.O1);
}
#define AS_WAVE_SYNC() do { asm volatile("s_waitcnt lgkmcnt(0)" ::: "memory"); __builtin_amdgcn_wave_barrier(); } while (0)
DEV void attn_sample_item(const Prm& p, int l, int req, int g, unsigned char* lds) {
    const int tid = opaque_tid(), w = __builtin_amdgcn_readfirstlane(tid >> 6), lane = tid & 63, c = lane & 31, h = lane >> 5, qi = (c >> 2) & 3, r = c & 3; const bool real = c < 16;
    float* BT = (float*)(lds + AS_BT); float* PA = (float*)(lds + AS_PA); float* PB = PA + 512; unsigned* SELM = (unsigned*)(lds + AS_SELM);
    unsigned char* kt = lds + w * 16384; unsigned char* vt = kt + 8192;
    __syncthreads();
    BT[tid] = p.BIASL2[g * 512 + tid]; PA[tid] = 0.f; PA[512 + tid] = 0.f;
    const int tq = PAST_ + qi; const size_t mrow = (size_t)MP + req * 4 + qi;
    bf16x8_t qf[4];
#pragma unroll
    for (int ks = 0; ks < 4; ++ks) { qf[ks] = *(const bf16x8_t*)(p.Q + mrow * 512 + g * 256 + r * 64 + ks * 16 + 8 * h); if (!real) qf[ks] = (bf16x8_t){0, 0, 0, 0, 0, 0, 0, 0}; }
    const float gc = p.GATES[mrow * 24 + g * 4 + r], gs = p.GATES[mrow * 24 + 8 + g * 4 + r], gw = p.GATES[mrow * 24 + 16 + g * 4 + r];
    const float* bt_r = BT + r * 128;
    const unsigned ka0 = 1024u * ((unsigned)c >> 3) + 64u * (c & 7) + 16u * ((unsigned)h ^ (((unsigned)c >> 2) & 3u));
    const unsigned blk = (lane >> 4) & 1, q4 = (lane & 15) >> 2, pp = lane & 3;
    const unsigned va_rel = 64u * (4u * h + q4) + 8u * (pp & 1) + 16u * ((2u * blk + (pp >> 1)) ^ (unsigned)h);
    const unsigned vbase = (unsigned)(size_t)(LAS unsigned char*)vt;
    __syncthreads();
    const float b31 = bt_r[127];
    AttnState sw, ss;
#pragma unroll
    for (int v = 0; v < 16; ++v) { sw.O0[v] = 0.f; sw.O1[v] = 0.f; ss.O0[v] = 0.f; ss.O1[v] = 0.f; }
    sw.m = -1e30f; sw.l = 0.f; ss.m = -1e30f; ss.l = 0.f;
    const size_t lr = (size_t)l * NREQ + req;
    const bf16_t* kc = p.KCS + ((lr * 2 + g) * 2 + 0) * 128 * 64; const bf16_t* vc = kc + 128 * 64;
    if (w == 0) {
        uint4 k0[8], k1[8], v0[8], v1[8];
        const int lr8 = lane >> 3, lc8 = (lane & 7) * 8;
#pragma unroll
        for (int it = 0; it < 8; ++it) { const size_t o = (size_t)(8 * it + lr8) * 64 + lc8; k0[it] = *(const uint4*)(kc + o); k1[it] = *(const uint4*)(kc + 4096 + o); }
#pragma unroll
        for (int it = 0; it < 8; ++it) { const unsigned o = off64(8 * it + lr8, lane & 7); *(uint4*)(kt + o) = k0[it]; *(uint4*)(vt + o) = k1[it]; }
        AS_WAVE_SYNC();
        f32x16_t A0, A1, B0, B1;
        attn_qk(kt, ka0, qf, A0, A1); attn_qk(vt, ka0, qf, B0, B1);
        attn_bias<AM_CMP>(A0, A1, tq - 31 - 64 * h, 0.f, bt_r); attn_bias<AM_CMP>(B0, B1, tq - 31 - 1024 - 64 * h, 0.f, bt_r);
        const float mC = fmaxf(attn_tilemax<true>(A0, A1), attn_tilemax<true>(B0, B1));
        float lC = attn_exp<true>(A0, A1, mC, 1.f); lC += attn_exp<true>(B0, B1, mC, 1.f);
        const float lt = lC + __shfl_xor(lC, 32), invC = lt > 0.f ? 1.f / lt : 0.f;
#pragma unroll
        for (int v = 0; v < 16; ++v) { A0[v] *= invC; A1[v] *= invC; B0[v] *= invC; B1[v] *= invC; }
        AS_WAVE_SYNC();
#pragma unroll
        for (int it = 0; it < 8; ++it) { const size_t o = (size_t)(8 * it + lr8) * 64 + lc8; v0[it] = *(const uint4*)(vc + o); v1[it] = *(const uint4*)(vc + 4096 + o); }
#pragma unroll
        for (int it = 0; it < 8; ++it) { const unsigned o = off64(8 * it + lr8, lane & 7); *(uint4*)(kt + o) = v0[it]; *(uint4*)(vt + o) = v1[it]; }
#pragma unroll
        for (int ct = 0; ct < 2; ++ct)
#pragma unroll
            for (int u = 0; u < 2; ++u)
#pragma unroll
                for (int qd = 0; qd < 4; ++qd) {
                    const f32x16_t& P = ct ? (u ? B1 : B0) : (u ? A1 : A0);
                    float qs = (P[4 * qd] + P[4 * qd + 1]) + (P[4 * qd + 2] + P[4 * qd + 3]), ls = P[4 * qd + 3];
                    qs += __shfl_xor(qs, 1); qs += __shfl_xor(qs, 2); ls += __shfl_xor(ls, 1); ls += __shfl_xor(ls, 2);
                    const int jq = 16 * ct + 8 * u + 2 * qd + h;
                    if (r == 0 && real) { PA[qi * 64 + jq] = qs; PB[qi * 64 + jq + 1] = ls; }
                }
        AS_WAVE_SYNC();
        attn_pv((unsigned)(size_t)(LAS unsigned char*)kt, va_rel, A0, A1, sw.O0, sw.O1);
        attn_pv(vbase, va_rel, B0, B1, sw.O0, sw.O1);
        AS_WAVE_SYNC();
    } else {
        for (int t = 0; t < 2; ++t) {
            const int wt = w - 1 + 7 * t; if (wt >= 9) break;
            as_load_f32<1>(kt, vt, lane, [&](int k) -> const float* { const int idx = 64 * wt + k;
                if (idx < 512) return p.cache_win + (lr * 512 + idx) * 256 + g * 64;
                if (idx < 516) return p.out + O_WINS + (lr * 512 + 508 + (idx - 512)) * 256 + g * 64;
                return nullptr; },
                [&](int k) -> float* { const int idx = 64 * wt + k; return (idx >= 4 && idx < 512) ? p.out + O_WINS + (lr * 512 + (idx - 4)) * 256 + g * 64 : nullptr; });
            AS_WAVE_SYNC();
            const int dl = 512 + qi - 64 * wt - 4 * h;
            if (wt == 0) attn_tile_m<AM_WINFIRST, false>(kt, ka0, vbase, va_rel, qf, sw, dl, b31, bt_r);
            else if (wt == 8) attn_tile_m<AM_DIAG, false>(kt, ka0, vbase, va_rel, qf, sw, dl, 0.f, bt_r);
            else if (wt >= 6) attn_tile_m<AM_NEAR, false>(kt, ka0, vbase, va_rel, qf, sw, dl, 0.f, bt_r);
            else attn_tile_m<AM_FAR, false>(kt, ka0, vbase, va_rel, qf, sw, dl, b31, bt_r);
            AS_WAVE_SYNC();
        }
    }
    if (w == 0) {
        for (int q = 0; q < 4; ++q) {
            const bool cand = lane >= 1 && lane <= 30;
            const float sc = cand ? PA[q * 64 + lane] + PB[q * 64 + lane] : -1.f;
            int cnt = 0;
            for (int i = 1; i <= 30; ++i) { const float si = __builtin_bit_cast(float, __builtin_amdgcn_readlane(__builtin_bit_cast(int, sc), i)); cnt += (si > sc || (si == sc && i < lane)) ? 1 : 0; }
            const unsigned long long bal = __ballot(cand && cnt < 13) | 1ull | (1ull << 31) | (1ull << 32);
            if (lane == 0) { SELM[q * 2] = (unsigned)bal; SELM[q * 2 + 1] = (unsigned)(bal >> 32); }
        }
    }
    __syncthreads();
    const unsigned mlo = SELM[qi * 2], mhi = SELM[qi * 2 + 1];
    unsigned long long um = 0ull;
#pragma unroll
    for (int q = 0; q < 4; ++q) um |= (unsigned long long)SELM[q * 2] | ((unsigned long long)SELM[q * 2 + 1] << 32);
    um = ((unsigned long long)__builtin_amdgcn_readfirstlane((unsigned)(um >> 32)) << 32) | (unsigned)__builtin_amdgcn_readfirstlane((unsigned)um);
    while (um) {
        int j = -1;
        for (int k = 0; k < 8 && um; ++k) { const int jj = __ffsll((long long)um) - 1; um &= um - 1ull; if (k == w) j = jj; }
        if (j >= 0) {
            const int page = j < 32 ? p.page_table[req * NPG + (j >> 1)] : 0;
            const float* sbase = j < 32 ? p.cache_slc + ((((size_t)l * NPHYS + page) * 128 + (j & 1) * 64) * 4 + g) * 64 : p.out + O_SLCS + (lr * 4) * 256 + g * 64;
            const int nrow = j < 32 ? 64 : 4;
            as_load_f32(kt, vt, lane, [&](int k) -> const float* { return k < nrow ? sbase + (size_t)k * 256 : nullptr; }, [](int) -> float* { return nullptr; });
        }
        AS_WAVE_SYNC();
        if (j >= 0) {
            const bool sel = j < 32 ? ((mlo >> j) & 1u) : ((mhi >> (j - 32)) & 1u);
            const int dl = tq - 64 * j - 4 * h;
            if (j == 32) attn_tile_m<AM_DIAG, true>(kt, ka0, vbase, va_rel, qf, ss, dl, 0.f, bt_r);
            else if (j >= 30) attn_tile_m<AM_NEAR, true>(kt, ka0, vbase, va_rel, qf, ss, dl, sel ? 0.f : -1e30f, bt_r);
            else attn_tile_m<AM_FAR, true>(kt, ka0, vbase, va_rel, qf, ss, dl, sel ? b31 : -1e30f, bt_r);
        }
        AS_WAVE_SYNC();
    }
    float* MO = (float*)(lds + w * 16384);
    float* ML = (float*)(lds + w * 16384 + 8192);
    {
        const float lts = ss.l + __shfl_xor(ss.l, 32), ltw = sw.l + __shfl_xor(sw.l, 32);
        if (real) {
#pragma unroll
            for (int dt = 0; dt < 2; ++dt)
#pragma unroll
                for (int qd = 0; qd < 4; ++qd) {
                    const f32x16_t& A = dt ? ss.O1 : ss.O0; const f32x16_t& B = dt ? sw.O1 : sw.O0; const int d = 32 * dt + 8 * qd + 4 * h;
                    *(float4*)(MO + c * 64 + d) = make_float4(A[4 * qd], A[4 * qd + 1], A[4 * qd + 2], A[4 * qd + 3]);
                    *(float4*)(MO + 1024 + c * 64 + d) = make_float4(B[4 * qd], B[4 * qd + 1], B[4 * qd + 2], B[4 * qd + 3]);
                }
            if (h == 0) { ML[c * 2] = ss.m; ML[c * 2 + 1] = lts; ML[32 + c * 2] = sw.m; ML[32 + c * 2 + 1] = ltw; }
        }
    }
    __syncthreads();
    for (int o = tid; o < 1024; o += NTHR) {
        const int cc = o >> 6, d = o & 63, q = cc >> 2, rr = cc & 3; const size_t mr = (size_t)MP + req * 4 + q;
        float res = p.GATES[mr * 24 + g * 4 + rr] * ((const float*)(lds + 0 * 16384))[1024 + cc * 64 + d];
#pragma unroll
        for (int br = 0; br < 2; ++br) {
            float M = -1e30f;
            for (int ww = (br == 1 ? 1 : 0); ww < 8; ++ww) M = fmaxf(M, ((const float*)(lds + ww * 16384 + 8192))[br * 32 + cc * 2]);
            float num = 0.f, den = 0.f;
            for (int ww = (br == 1 ? 1 : 0); ww < 8; ++ww) { const float* ml = (const float*)(lds + ww * 16384 + 8192) + br * 32 + cc * 2; const float f = __builtin_amdgcn_exp2f(ml[0] - M);
                num += f * ((const float*)(lds + ww * 16384))[br * 1024 + cc * 64 + d]; den += f * ml[1]; }
            res += p.GATES[mr * 24 + (br == 0 ? 8 : 16) + g * 4 + rr] * (den > 0.f ? num / den : 0.f);
        }
        p.MIX[mr * D_ + 512 + g * 256 + rr * 64 + d] = f2bf(res);
    }
}

DEV void cmp_prompt_fast(const Prm& p, int l, float* sm) {
    const int tid = opaque_tid(), w = __builtin_amdgcn_readfirstlane(tid >> 6), lane = tid & 63, c = lane & 31, h = lane >> 5;
    for (int wi = (int)blockIdx.x - ((int)gridDim.x >= 256 ? 128 : 0); wi < 128; wi += gridDim.x) {
        if (wi < 0) continue;
        const int ib = wi & 7, type = (wi >> 3) & 1, g = (wi >> 4) & 1, b = wi >> 5;
        const bf16_t* kv = p.KVB + ((((size_t)(0 * 2 + type) * NB_ + b) * 2 + g) * T_) * 64 + 8 * h;
        const bf16_t* wb = p.Wct + (size_t)(l * 2 + type) * 128 * 1024 + (size_t)c * 1024 + 8 * h;
        f32x16_t acc0, acc1;
#pragma unroll
        for (int v = 0; v < 16; ++v) { acc0[v] = 0.f; acc1[v] = 0.f; }
        const int i0 = 32 * ib + c;
#pragma unroll
        for (int l2 = 0; l2 < 2; ++l2) {
            const int ll = 2 * w + l2; const int tlo = 16 * i0 + ll, thi = min(tlo + 16, T_ - 1);
            bf16x8_t fa[4], fb[4], b00[4], b01[4], b10[4], b11[4];
#pragma unroll
            for (int ks = 0; ks < 4; ++ks) {
                fa[ks] = *(const bf16x8_t*)(kv + (size_t)tlo * 64 + ks * 16); fb[ks] = *(const bf16x8_t*)(kv + (size_t)thi * 64 + ks * 16);
                const bf16_t* wk = wb + ll * 64 + ks * 16;
                b00[ks] = *(const bf16x8_t*)(wk); b01[ks] = *(const bf16x8_t*)(wk + 32 * 1024); b10[ks] = *(const bf16x8_t*)(wk + 64 * 1024); b11[ks] = *(const bf16x8_t*)(wk + 96 * 1024);
            }
#pragma unroll
            for (int ks = 0; ks < 4; ++ks) {
                acc0 = __builtin_amdgcn_mfma_f32_32x32x16_bf16(fa[ks], b00[ks], acc0, 0, 0, 0);
                acc1 = __builtin_amdgcn_mfma_f32_32x32x16_bf16(fa[ks], b01[ks], acc1, 0, 0, 0);
                acc0 = __builtin_amdgcn_mfma_f32_32x32x16_bf16(fb[ks], b10[ks], acc0, 0, 0, 0);
                acc1 = __builtin_amdgcn_mfma_f32_32x32x16_bf16(fb[ks], b11[ks], acc1, 0, 0, 0);
            }
        }
        __syncthreads();
        float* part = sm + w * 2048;
#pragma unroll
        for (int v = 0; v < 16; ++v) { const int i = (v & 3) + 8 * (v >> 2) + 4 * h; part[i * 64 + c] = acc0[v]; part[i * 64 + 32 + c] = acc1[v]; }
        __syncthreads();
        bf16_t* o = p.KC + ((((size_t)b * 2 + g) * 2 + type) * 256 + 32 * ib) * 64;
#pragma unroll
        for (int q = 0; q < 4; ++q) { const int idx = tid + NTHR * q, i = idx >> 6, e = idx & 63; float a = cb_val(p.cb, (l * 2 + type) * 64 + e);
#pragma unroll
            for (int ww = 0; ww < 8; ++ww) a += sm[ww * 2048 + idx];
            o[idx] = (32 * ib + i) == 255 ? (bf16_t)0 : f2bf(a); }
    }
}
DEV void phase_mix1(const Prm& p, int l, float* sm) {
    cmp_prompt_fast(p, l, sm);
    for (int item = blockIdx.x; item < 512 + NREQ; item += gridDim.x) convpool_item(p, l, item, sm);
}
DEV void phase_attn(const Prm& p, int l, float* sm) {
    const int spos = (int)(blockIdx.x % 3u);
    for (int k = blockIdx.x; k < 256; k += gridDim.x) {
        const int bg = k >> 5, pi = k & 31;
#pragma unroll 1
        for (int s = 0; s < 3; ++s) {
            const int what = s == spos ? 2 : (s < spos ? s : s - 1);
            if (what == 2) attn_sample_item(p, l, k >> 1, k & 1, (unsigned char*)sm);
            else attn_prompt_unit(p, l, bg >> 1, bg & 1, what == 0 ? 63 - pi : pi, (unsigned char*)sm);
        }
    }
}
DEV void phase_final(const Prm& p) {
    const int tid = opaque_tid(), wv = tid >> 6, lane = tid & 63;
    float4 g[4];
#pragma unroll
    for (int i = 0; i < 4; ++i) g[i] = *(const float4*)(p.final_norm + i * 256 + lane * 4);
    for (int m0 = (blockIdx.x * 8 + wv) * 2; m0 < MP; m0 += gridDim.x * 16) {
        uint2 v[2][4]; float rs[2];
#pragma unroll
        for (int rr = 0; rr < 2; ++rr) { rs[rr] = row_rs(p.SSb, m0 + rr);
#pragma unroll
            for (int i = 0; i < 4; ++i) v[rr][i] = *(const uint2*)(p.XB + (size_t)(m0 + rr) * D_ + i * 256 + lane * 4); }
#pragma unroll
        for (int rr = 0; rr < 2; ++rr)
#pragma unroll
            for (int i = 0; i < 4; ++i) { const uint2 a = v[rr][i]; const float r = rs[rr];
                const float x0 = __uint_as_float(a.x << 16), x1 = __uint_as_float(a.x & 0xffff0000u), x2 = __uint_as_float(a.y << 16), x3 = __uint_as_float(a.y & 0xffff0000u);
                *(float4*)(p.out + (size_t)(m0 + rr) * D_ + i * 256 + lane * 4) = make_float4(x0 * r * g[i].x, x1 * r * g[i].y, x2 * r * g[i].z, x3 * r * g[i].w); }
    }
}

enum { PH_PREP = 0, PH_IN, PH_MIX1, PH_ATTN, PH_OUT, PH_GU, PH_DOWN, PH_FINAL, PH_DOWNR };
template <int PH> DEV void run_phase(const Prm& p, int l, unsigned char* lds) {
    float* sm = (float*)lds;
    if constexpr (PH == PH_PREP) phase_prep(p, sm);
    if constexpr (PH == PH_IN) { EpiIn e{p, l, nullptr};
        const bool cf = l == 0 && (blockIdx.x & 1);
        if (cf) cmp_sample_fast(p, 0, lds);
        gemm_fast(lds, p.XB, p.Wt_in + (size_t)l * NIN * D_, M_, NIN, D_, e);
        if (l == 0 && !cf) cmp_sample_fast(p, 0, lds);
        if (l == 0) { const int nfull = (M_ / 256) * (NIN / 256) % (int)gridDim.x; if ((int)blockIdx.x >= nfull) prep_weights(p, sm, 576 / 4, 2944 / 4, (int)blockIdx.x - nfull, (int)gridDim.x - nfull); } }
    if constexpr (PH == PH_MIX1) phase_mix1(p, l, sm);
    if constexpr (PH == PH_ATTN) phase_attn(p, l, sm);
    if constexpr (PH == PH_OUT) { EpiRes e{p, 1, p.SSa, true}; gemm_fast(lds, p.MIX, p.Wt_out + (size_t)l * D_ * D_, M_, D_, D_, e);
        if (l == 0 && blockIdx.x >= 8) prep_weights(p, sm, 2944 / 4, 2 * 2944 / 4, (int)blockIdx.x - 8, (int)gridDim.x - 8); }
    if constexpr (PH == PH_GU) { EpiGU e{p, nullptr}; gemm_fast(lds, p.XB, p.Wt_gu + (size_t)l * NGU * D_, M_, NGU, D_, e); }
    if constexpr (PH == PH_DOWN) { EpiRes e{p, 2, p.SSb, l + 1 < NL_}; const bf16_t* W = p.Wt_down + (size_t)l * D_ * DFF;
        const bool cf = l == 0 && (blockIdx.x & 1);
        if (cf) cmp_sample_fast(p, 1, lds);
        gemm_fast(lds, p.ACT, W, MP, D_, DFF, e);
        gemm_split(lds, p.ACT, W, D_, DFF, 256, p.SLAB);
        if (l == 0 && !cf) cmp_sample_fast(p, 1, lds); }
    if constexpr (PH == PH_FINAL) phase_final(p);
    if constexpr (PH == PH_DOWNR) { if (l + 1 < NL_) { EpiRes e{p, 2, p.SSb, true}; gemm_reduce(p.SLAB, D_, DFF / 256, e); } else gemm_reduce_final(p, p.SLAB, DFF / 256); }
}
template <int PH> __global__ void __launch_bounds__(NTHR, 2) k_phase(Prm p, int l) {
    extern __shared__ __attribute__((aligned(16))) unsigned char lds[];
    run_phase<PH>(p, l, lds);
}
__global__ void __launch_bounds__(NTHR, 2) k_mega(Prm p) {
    extern __shared__ __attribute__((aligned(16))) unsigned char lds[];
    if (threadIdx.x == 0) *(uint4*)(lds + LDS_BYTES - 16) = make_uint4(0u, 0u, 0u, 0u);
    __syncthreads();
    const XcdBarrier bar = xcd_barrier_post(p.bar, (volatile LAS unsigned*)(lds + LDS_BYTES - 16));
    run_phase<PH_PREP>(p, 0, lds); xcd_barrier(bar);
#define LAYER(l) do { run_phase<PH_IN>(p, l, lds); xcd_barrier(bar); run_phase<PH_MIX1>(p, l, lds); xcd_barrier(bar); run_phase<PH_ATTN>(p, l, lds); xcd_barrier(bar); \
        run_phase<PH_OUT>(p, l, lds); xcd_barrier(bar); run_phase<PH_GU>(p, l, lds); xcd_barrier(bar); run_phase<PH_DOWN>(p, l, lds); xcd_barrier(bar); run_phase<PH_DOWNR>(p, l, lds); } while (0)
    LAYER(0); xcd_barrier(bar); LAYER(1);
#undef LAYER
    run_phase<PH_FINAL>(p, 0, lds);
}

constexpr bool ONE_LAUNCH = true;
static size_t carve(size_t& off, size_t bytes) { const size_t o = off; off += (bytes + 255) & ~(size_t)255; return o; }
template <int PH> static void launch_phase(const Prm& p, int l, int grid, hipStream_t stream) {
    static bool attr = false;
    if (!attr) { (void)hipFuncSetAttribute((const void*)k_phase<PH>, hipFuncAttributeMaxDynamicSharedMemorySize, LDS_BYTES); attr = true; }
    hipLaunchKernelGGL(k_phase<PH>, dim3(grid), dim3(NTHR), LDS_BYTES, stream, p, l);
}
extern "C" void kernel_launch(void* const* d_in, const int* in_sizes, int n_in, void* d_out, int out_size, void* d_ws, size_t ws_size, hipStream_t stream) {
    Prm p{};
    p.x_prompt = (const float*)d_in[0]; p.x_sample = (const float*)d_in[1]; p.cache_cmp = (const float*)d_in[2]; p.cache_slc = (const float*)d_in[3]; p.cache_win = (const float*)d_in[4];
    p.state_conv = (const float*)d_in[5]; p.state_pool = (const float*)d_in[6]; p.page_table = (const int*)d_in[7]; p.rel_bias = (const float*)d_in[8]; p.norm1 = (const float*)d_in[9];
    p.w_in = (const float*)d_in[10]; p.conv_dw = (const float*)d_in[11]; p.conv_b = (const float*)d_in[12]; p.conv_ln_g = (const float*)d_in[13]; p.conv_ln_b = (const float*)d_in[14];
    p.pool_w = (const float*)d_in[15]; p.pool_scale = (const float*)d_in[16]; p.pe_k = (const float*)d_in[17]; p.wk = (const float*)d_in[18]; p.pe_v = (const float*)d_in[19]; p.wv = (const float*)d_in[20];
    p.w_out = (const float*)d_in[21]; p.norm2 = (const float*)d_in[22]; p.w_gu = (const float*)d_in[23]; p.w_down = (const float*)d_in[24]; p.final_norm = (const float*)d_in[25];
    p.out = (float*)d_out;
    char* ws = (char*)d_ws; size_t off = 0;
    p.bar = (unsigned*)(ws + carve(off, 16384));
    p.Wt_in = (bf16_t*)(ws + carve(off, (size_t)NL_ * NIN * D_ * 2)); p.Wt_out = (bf16_t*)(ws + carve(off, (size_t)NL_ * D_ * D_ * 2));
    p.Wt_gu = (bf16_t*)(ws + carve(off, (size_t)NL_ * NGU * D_ * 2)); p.Wt_down = (bf16_t*)(ws + carve(off, (size_t)NL_ * D_ * DFF * 2));
    p.Wct = (bf16_t*)(ws + carve(off, (size_t)2 * 2 * 128 * 1024 * 2)); p.cb = (float*)(ws + carve(off, 4 * 256 * 4));
    p.XB = (bf16_t*)(ws + carve(off, (size_t)M_ * D_ * 2)); p.SSa = (float*)(ws + carve(off, (size_t)M_ * 16 * 4)); p.SSb = (float*)(ws + carve(off, (size_t)M_ * 16 * 4));
    p.G = (float*)(ws + carve(off, (size_t)M_ * 256 * 4)); p.U = (float*)(ws + carve(off, (size_t)M_ * 256 * 4));
    p.Q = (bf16_t*)(ws + carve(off, (size_t)M_ * 512 * 2)); p.KVB = (bf16_t*)(ws + carve(off, (size_t)3 * 2 * NB_ * 2 * T_ * 64 * 2));
    p.GATES = (float*)(ws + carve(off, (size_t)M_ * 24 * 4));
    p.KC = (bf16_t*)(ws + carve(off, (size_t)NB_ * 2 * 2 * 256 * 64 * 2)); p.KCS = (bf16_t*)(ws + carve(off, (size_t)NL_ * NREQ * 2 * 2 * 128 * 64 * 2));
    p.MIX = (bf16_t*)(ws + carve(off, (size_t)M_ * D_ * 2)); p.X1 = (float*)(ws + carve(off, (size_t)M_ * D_ * 4)); p.X2 = (float*)(ws + carve(off, (size_t)M_ * D_ * 4));
    p.ACT = (bf16_t*)(ws + carve(off, (size_t)M_ * DFF * 2)); p.BIASL2 = (float*)(ws + carve(off, 1024 * 4)); p.SLAB = (float*)(ws + carve(off, (size_t)11 * MS * D_ * 4));
    if (off > ws_size || out_size != (int)O_END) { fprintf(stderr, "kernel_launch: bad sizes (ws %zu need %zu, out %d expect %zu)\n", ws_size, off, out_size, (size_t)O_END); return; }
    static int grid = 0;
    if (!grid) {
        int dev = 0, cus = 0, per_cu = 0;
        (void)hipGetDevice(&dev); (void)hipDeviceGetAttribute(&cus, hipDeviceAttributeMultiprocessorCount, dev);
        (void)hipFuncSetAttribute((const void*)k_mega, hipFuncAttributeMaxDynamicSharedMemorySize, LDS_BYTES);
        (void)hipOccupancyMaxActiveBlocksPerMultiprocessor(&per_cu, (const void*)k_mega, NTHR, LDS_BYTES);
        if (per_cu < 1) fprintf(stderr, "kernel_launch: occupancy query reports %d workgroups per CU\n", per_cu);
        grid = cus > 0 ? cus : 256;
    }
    (void)hipMemsetAsync(p.bar, 0, XCD_BAR_WORDS * sizeof(unsigned), stream);
    if (ONE_LAUNCH) {
        hipLaunchKernelGGL(k_mega, dim3(grid), dim3(NTHR), LDS_BYTES, stream, p);
    } else {
        launch_phase<PH_PREP>(p, 0, grid, stream);
        for (int l = 0; l < NL_; ++l) {
            launch_phase<PH_IN>(p, l, grid, stream); launch_phase<PH_MIX1>(p, l, grid, stream); launch_phase<PH_ATTN>(p, l, grid, stream);
            launch_phase<PH_OUT>(p, l, grid, stream); launch_phase<PH_GU>(p, l, grid, stream); launch_phase<PH_DOWN>(p, l, grid, stream); launch_phase<PH_DOWNR>(p, l, grid, stream);
        }
        launch_phase<PH_FINAL>(p, 0, grid, stream);
    }
}
```

```cpp
#include <hip/hip_runtime.h>
#include <stdint.h>
#include <stdio.h>

typedef unsigned short bf16_t;
#define DEV __device__ __forceinline__

constexpr int D_ = 1024, NB_ = 4, T_ = 4096, NL_ = 2, NREQ = 128, NS_ = 4, PAST_ = 2048, NPG = 16, NPHYS = 2560;
constexpr int MP = NB_ * T_, MS = NREQ * NS_, M_ = MP + MS;
constexpr int NIN = 2304, DFF = 2816, NGU = 5632, INW = 2072;
constexpr float QSCALE = 0.18033688011112042f;
constexpr float LOG2E = 1.4426950408889634f;

constexpr size_t O_YP = 0, O_YS = O_YP + (size_t)MP * D_, O_CMPP = O_YS + (size_t)MS * D_, O_SLCP = O_CMPP + (size_t)NL_ * NB_ * T_ * 256,
                 O_WINP = O_SLCP + (size_t)NL_ * NB_ * T_ * 256, O_CONVP = O_WINP + (size_t)NL_ * NB_ * 512 * 256, O_POOLP = O_CONVP + (size_t)NL_ * NB_ * 30 * 256,
                 O_CMPS = O_POOLP + (size_t)NL_ * NB_ * 15 * 256, O_SLCS = O_CMPS + (size_t)NL_ * NREQ * 4 * 256, O_WINS = O_SLCS + (size_t)NL_ * NREQ * 4 * 256,
                 O_CONVS = O_WINS + (size_t)NL_ * NREQ * 512 * 256, O_POOLS = O_CONVS + (size_t)NL_ * NREQ * 30 * 256, O_END = O_POOLS + (size_t)NL_ * NREQ * 15 * 256;

__device__ const unsigned char kBucket[128] = {0, 1, 2, 3, 4, 5, 6, 7, 8, 9, 10, 11, 12, 13, 14, 15, 16, 16, 16, 17, 17, 18, 18, 18, 19, 19, 19, 20, 20, 20, 20, 21, 21, 21, 21, 22, 22, 22, 22, 22, 23, 23, 23, 23, 23, 23, 24, 24, 24, 24, 24, 24, 25, 25, 25, 25, 25, 25, 25, 26, 26, 26, 26, 26, 26, 26, 26, 27, 27, 27, 27, 27, 27, 27, 27, 27, 27, 28, 28, 28, 28, 28, 28, 28, 28, 28, 28, 29, 29, 29, 29, 29, 29, 29, 29, 29, 29, 29, 29, 30, 30, 30, 30, 30, 30, 30, 30, 30, 30, 30, 30, 30, 30, 31, 31, 31, 31, 31, 31, 31, 31, 31, 31, 31, 31, 31, 31, 31};

struct Prm {
    const float *x_prompt, *x_sample, *cache_cmp, *cache_slc, *cache_win, *state_conv, *state_pool;
    const int* page_table;
    const float *rel_bias, *norm1, *w_in, *conv_dw, *conv_b, *conv_ln_g, *conv_ln_b, *pool_w, *pool_scale, *pe_k, *wk, *pe_v, *wv, *w_out, *norm2, *w_gu, *w_down, *final_norm;
    float* out;
    unsigned* bar;
    bf16_t *Wt_in, *Wt_out, *Wt_gu, *Wt_down, *Wct;
    float* cb;
    bf16_t* XB;
    float *SSa, *SSb, *G, *U;
    bf16_t *Q, *KVB;
    float* GATES;
    bf16_t *KC, *KCS, *MIX;
    float *X1, *X2;
    bf16_t* ACT;
    float* BIASL2;
    float* SLAB;
};

DEV int opaque_tid() { int t = threadIdx.x; asm volatile("" : "+v"(t)); return t; }
DEV float bf2f(bf16_t v) { return __uint_as_float((unsigned)v << 16); }
DEV bf16_t f2bf(float f) { unsigned u = __float_as_uint(f); u += 0x7fffu + ((u >> 16) & 1u); return (bf16_t)(u >> 16); }
DEV unsigned cvt_pk_bf16(float lo, float hi) { unsigned r; asm("v_cvt_pk_bf16_f32 %0, %1, %2\n\ts_nop 1" : "=v"(r) : "v"(lo), "v"(hi)); return r; }
DEV unsigned pack2(float a, float b) { return cvt_pk_bf16(a, b); }
DEV float wave_sum(float v) { for (int o = 32; o > 0; o >>= 1) v += __shfl_xor(v, o); return v; }
DEV float wave_max(float v) { for (int o = 32; o > 0; o >>= 1) v = fmaxf(v, __shfl_xor(v, o)); return v; }
DEV float sigmoidf_(float x) { return __builtin_amdgcn_rcpf(1.f + __builtin_amdgcn_exp2f(-1.4426950408889634f * x)); }

constexpr int NTHR = 512;
constexpr int LDS_BYTES = 159744;

#define XB_TMO      128
#define XB_XCNT(j)  (256  + 64 * (j))
#define XB_XSUB(j)  (1280 + 64 * (j))
#define XB_XGEN(j)  (2304 + 64 * (j))
#define XB_TOP      3328
#define XB_TOPGEN   3392
#define XCD_BAR_WORDS 3456
#define XB_SPIN_CAP (1u << 24)
#define LAS __attribute__((address_space(3)))
__device__ __forceinline__ unsigned xb_ld(unsigned* p)              { return __hip_atomic_load(p, __ATOMIC_RELAXED, __HIP_MEMORY_SCOPE_AGENT); }
__device__ __forceinline__ unsigned xb_add(unsigned* p, unsigned v) { return __hip_atomic_fetch_add(p, v, __ATOMIC_RELAXED, __HIP_MEMORY_SCOPE_AGENT); }
__device__ __forceinline__ unsigned xb_xcc_id() { return (unsigned)__builtin_amdgcn_s_getreg((3 << 11) | 20) & 0xFu; }
#define XB_SPIN(cond, bar) do { unsigned _sp = 0; while (cond) { __builtin_amdgcn_s_sleep(1); \
    if ((++_sp & 255u) == 0u) { if (xb_ld(&(bar)[XB_TMO])) break; if (_sp > XB_SPIN_CAP) { atomicAdd(&(bar)[XB_TMO], 1u); break; } } } } while (0)
struct XcdBarrier { unsigned* bar; unsigned x; volatile LAS unsigned* st; };
__device__ __forceinline__ XcdBarrier xcd_barrier_post(unsigned* bar, volatile LAS unsigned* st) {
    XcdBarrier b; b.bar = bar; b.x = xb_xcc_id(); b.st = st;
    if (threadIdx.x == 0) (void)xb_add(&bar[XB_XCNT(b.x)], 1u);
    return b;
}
__device__ __forceinline__ void xcd_barrier_complete(unsigned* bar, unsigned x, unsigned& nloc, unsigned& nx) {
    const unsigned G = gridDim.x * gridDim.y * gridDim.z;
    unsigned sum, cnt, mine, sp = 0u;
    for (;;) {
        sum = 0u; cnt = 0u; mine = 0u;
#pragma unroll
        for (unsigned j = 0; j < 16; ++j) { const unsigned c = xb_ld(&bar[XB_XCNT(j)]); sum += c; cnt += (c > 0u) ? 1u : 0u; mine = (j == x) ? c : mine; }
        if (sum == G) break;
        __builtin_amdgcn_s_sleep(1);
        if ((++sp & 255u) == 0u) { if (xb_ld(&bar[XB_TMO])) break; if (sp > XB_SPIN_CAP) { atomicAdd(&bar[XB_TMO], 1u); break; } }
    }
    nloc = mine > 0u ? mine : 1u; nx = cnt > 0u ? cnt : 1u;
}
__device__ __forceinline__ void xcd_barrier(const XcdBarrier& b) {
    asm volatile("s_waitcnt vmcnt(0)" ::: "memory");
    __syncthreads();
    if (threadIdx.x == 0) {
        unsigned* bar = b.bar;
        __builtin_amdgcn_s_waitcnt(0);
        unsigned nloc = b.st[0], nx = b.st[1];
        if (nloc == 0u) { xcd_barrier_complete(bar, b.x, nloc, nx); b.st[0] = nloc; b.st[1] = nx; }
        const unsigned old = xb_add(&bar[XB_XSUB(b.x)], 1u);
        const unsigned gen = old / nloc;
        if (old + 1u == (gen + 1u) * nloc) {
            __builtin_amdgcn_fence(__ATOMIC_RELEASE, "agent");
            asm volatile("s_waitcnt vmcnt(0)" ::: "memory");
            const unsigned og = xb_add(&bar[XB_TOP], 1u);
            const unsigned tg = og / nx;
            if (og + 1u == (tg + 1u) * nx) xb_add(&bar[XB_TOPGEN], 1u);
            else XB_SPIN(xb_ld(&bar[XB_TOPGEN]) == tg, bar);
            __builtin_amdgcn_fence(__ATOMIC_ACQUIRE, "agent");
            xb_add(&bar[XB_XGEN(b.x)], 1u);
            asm volatile("s_waitcnt vmcnt(0)" ::: "memory");
        } else {
            XB_SPIN(xb_ld(&bar[XB_XGEN(b.x)]) == gen, bar);
            __builtin_amdgcn_fence(__ATOMIC_ACQUIRE, "agent");
            asm volatile("s_waitcnt vmcnt(0)" ::: "memory");
        }
    }
    __syncthreads();
}

DEV int srccol(int mode, int n) {
    if (mode == 0) { if (n < 512) { const int t = n >> 8, j = n & 255; return j < 128 ? 128 * t + j : 256 + 128 * t + (j - 128); } return n < INW ? n : -1; }
    if (mode == 2) { const int t = n >> 8, j = n & 255; return j < 128 ? 128 * t + j : DFF + 128 * t + (j - 128); }
    return n;
}
#define WDESC(tg) \
    const int l_ = (tg) / TPL, r_ = (tg) % TPL, which = r_ < 576 ? 0 : (r_ < 832 ? 1 : (r_ < 2240 ? 2 : 3)), tl = r_ - (which == 0 ? 0 : (which == 1 ? 576 : (which == 2 ? 832 : 2240))); \
    const float* src = which == 0 ? p.w_in + (size_t)l_ * D_ * INW : (which == 1 ? p.w_out + (size_t)l_ * D_ * D_ : (which == 2 ? p.w_gu + (size_t)l_ * D_ * NGU : p.w_down + (size_t)l_ * DFF * D_)); \
    const float* gain = which == 0 ? p.norm1 + l_ * D_ : (which == 2 ? p.norm2 + l_ * D_ : nullptr); \
    bf16_t* dst = which == 0 ? p.Wt_in + (size_t)l_ * NIN * D_ : (which == 1 ? p.Wt_out + (size_t)l_ * D_ * D_ : (which == 2 ? p.Wt_gu + (size_t)l_ * NGU * D_ : p.Wt_down + (size_t)l_ * D_ * DFF)); \
    const int K = which == 3 ? DFF : D_, Ns = which == 0 ? INW : (which == 2 ? NGU : D_), ntn = which == 0 ? NIN / 64 : (which == 2 ? NGU / 64 : D_ / 64), mode = which == 0 ? 0 : (which == 2 ? 2 : 1); \
    const int n0 = (tl % ntn) * 64, k0 = (tl / ntn) * 64;
DEV void prep_weights(const Prm& p, float* sm, int vb_first, int vb_end, int bidx, int nblk) {
    const int tid = opaque_tid();
    constexpr int TPL = (NIN / 64) * 16 + 16 * 16 + (NGU / 64) * 16 + 16 * (DFF / 64);
    static_assert(TPL == 2944, "tile counts");
    for (int vb = vb_first + bidx; vb < vb_end; vb += nblk) {
        float4 v[8];
#pragma unroll
        for (int q = 0; q < 4; ++q) {
            WDESC(vb * 4 + q)
#pragma unroll
            for (int i = 0; i < 2; ++i) { const int idx = tid + 512 * i, k = idx >> 4, n4 = (idx & 15) * 4; const int sc = srccol(mode, n0 + n4);
                float4 x = make_float4(0.f, 0.f, 0.f, 0.f);
                if (sc >= 0) { x = *(const float4*)(src + (size_t)(k0 + k) * Ns + sc); if (gain) { const float gk = gain[k0 + k]; x.x *= gk; x.y *= gk; x.z *= gk; x.w *= gk; } }
                v[q * 2 + i] = x; }
            (void)dst; (void)K;
        }
        __syncthreads();
#pragma unroll
        for (int q = 0; q < 4; ++q)
#pragma unroll
            for (int i = 0; i < 2; ++i) { const int idx = tid + 512 * i, k = idx >> 4, n4 = (idx & 15) * 4; float* t = sm + q * (64 * 65) + k * 65 + n4; t[0] = v[q * 2 + i].x; t[1] = v[q * 2 + i].y; t[2] = v[q * 2 + i].z; t[3] = v[q * 2 + i].w; }
        __syncthreads();
#pragma unroll
        for (int q = 0; q < 4; ++q) {
            WDESC(vb * 4 + q)
            const int k8 = tid & 7, n = tid >> 3; const float* t = sm + q * (64 * 65) + (8 * k8) * 65 + n;
            uint4 w; w.x = pack2(t[0], t[65]); w.y = pack2(t[130], t[195]); w.z = pack2(t[260], t[325]); w.w = pack2(t[390], t[455]);
            *(uint4*)(dst + (size_t)(n0 + n) * K + k0 + 8 * k8) = w;
            (void)src; (void)gain; (void)Ns; (void)mode;
        }
    }
}
#undef WDESC
DEV float cb_val(const float* cb, int i) { return ((cb[i] + cb[256 + i]) + cb[512 + i]) + cb[768 + i]; }
DEV void phase_prep(const Prm& p, float* sm) {
    const int tid = opaque_tid(); const size_t gt = (size_t)blockIdx.x * NTHR + tid, gn = (size_t)gridDim.x * NTHR;
    for (size_t base = gt; base < (size_t)2 * 2 * 128 * 1024; base += gn * 4) {
        float v[4];
#pragma unroll
        for (int i = 0; i < 4; ++i) { const size_t idx = base + gn * i; v[i] = 0.f;
            if (idx < (size_t)2 * 2 * 128 * 1024) { const int k = idx & 1023, n = (idx >> 10) & 127, type = (idx >> 17) & 1, l = (int)(idx >> 18);
                const float* src = (type ? p.wv : p.wk) + (size_t)l * 32 * 64 * 64; const int half = n >> 6, e = n & 63; v[i] = src[(size_t)(half * 1024 + k) * 64 + e]; } }
#pragma unroll
        for (int i = 0; i < 4; ++i) { const size_t idx = base + gn * i; if (idx < (size_t)2 * 2 * 128 * 1024) p.Wct[idx] = f2bf(v[i]); }
    }
    if ((int)blockIdx.x >= (int)gridDim.x - 16) {
        const int wq = (int)blockIdx.x - ((int)gridDim.x - 16), lt = wq >> 2, qk = wq & 3, l = lt >> 1, type = lt & 1, e = tid & 63, kq = tid >> 6;
        const float* w = (type ? p.wv : p.wk) + (size_t)l * 32 * 64 * 64; const float* pe = (type ? p.pe_v : p.pe_k) + (size_t)l * 32 * 64;
        float acc = 0.f;
#pragma unroll 1
        for (int k0 = qk * 512 + kq * 64; k0 < qk * 512 + kq * 64 + 64; k0 += 64) {
            float wv[64];
#pragma unroll
            for (int i = 0; i < 64; ++i) wv[i] = w[(size_t)(k0 + i) * 64 + e];
#pragma unroll
            for (int i = 0; i < 64; ++i) acc += pe[k0 + i] * wv[i];
        }
        sm[tid] = acc; __syncthreads();
        if (tid < 64) { float a = 0.f; for (int q = 0; q < 8; ++q) a += sm[q * 64 + tid]; p.cb[qk * 256 + lt * 64 + tid] = a; }
        __syncthreads(); }
    if (gt < 1024) { const int dist = (int)gt & 127, gr = (int)gt >> 7; p.BIASL2[gt] = p.rel_bias[kBucket[dist] * 8 + gr] * LOG2E; }
    {
        const int wv = tid >> 6, lane = tid & 63;
        for (int m0 = (blockIdx.x * 8 + wv) * 2; m0 < M_; m0 += gridDim.x * 16) {
            float4 v[2][4];
#pragma unroll
            for (int rr = 0; rr < 2; ++rr) { const int m = m0 + rr; const float* x = m < MP ? p.x_prompt + (size_t)m * D_ : p.x_sample + (size_t)(m - MP) * D_;
#pragma unroll
                for (int i = 0; i < 4; ++i) v[rr][i] = *(const float4*)(x + i * 256 + lane * 4); }
#pragma unroll
            for (int rr = 0; rr < 2; ++rr) { const int m = m0 + rr; float sq = 0.f;
#pragma unroll
                for (int i = 0; i < 4; ++i) { const float4 a = v[rr][i]; sq += (a.x * a.x + a.y * a.y) + (a.z * a.z + a.w * a.w); uint2 w; w.x = pack2(a.x, a.y); w.y = pack2(a.z, a.w); *(uint2*)(p.XB + (size_t)m * D_ + i * 256 + lane * 4) = w; }
                sq = wave_sum(sq);
                if (lane < 16) p.SSb[(size_t)m * 16 + lane] = lane == 0 ? sq : 0.f; }
        }
    }
    prep_weights(p, sm, 0, 576 / 4, (int)blockIdx.x, (int)gridDim.x);
}
DEV float row_rs(const float* SS, int m) {
    const float4* q = (const float4*)(SS + (size_t)m * 16); const float4 a = q[0], b = q[1], c = q[2], d = q[3];
    float s = 0.f; s += a.x; s += a.y; s += a.z; s += a.w; s += b.x; s += b.y; s += b.z; s += b.w; s += c.x; s += c.y; s += c.z; s += c.w; s += d.x; s += d.y; s += d.z; s += d.w;
    return rsqrtf(s * (1.f / 1024.f) + 1e-6f); }
DEV void st8f(float* dst, const float (&v)[8]) { *(float4*)dst = make_float4(v[0], v[1], v[2], v[3]); *(float4*)(dst + 4) = make_float4(v[4], v[5], v[6], v[7]); }
DEV void st8b(bf16_t* dst, const float (&v)[8]) { uint4 w; w.x = pack2(v[0], v[1]); w.y = pack2(v[2], v[3]); w.z = pack2(v[4], v[5]); w.w = pack2(v[6], v[7]); *(uint4*)dst = w; }

struct EpiIn {
    static constexpr bool HAS_SS = false, USE_RS = true, HAS_AUX = false;
    const Prm& p; int l; float* ss;
    DEV const float* ss_src() const { return p.SSb; }
    DEV float apply(int m, int pn, int j, const float (&lo_)[8], const float (&hi_)[8], float rs) const {
        float lo[8], hi[8];
#pragma unroll
        for (int i = 0; i < 8; ++i) { lo[i] = lo_[i] * rs; hi[i] = hi_[i] * rs; }
        const bool samp = m >= MP; const int b = m / T_, t = m % T_, req = (m - MP) >> 2, s = (m - MP) & 3;
        if (pn < 2) {
            float g[8];
#pragma unroll
            for (int i = 0; i < 8; ++i) g[i] = lo[i] * sigmoidf_(hi[i]);
            const int c = 128 * pn + j;
            st8f(p.G + (size_t)m * 256 + c, g);
            if (!samp) { if (t >= T_ - 30) st8f(p.out + O_CONVP + ((size_t)(l * NB_ + b) * 30 + (t - (T_ - 30))) * 256 + c, g); }
            else st8f(p.out + O_CONVS + ((size_t)(l * NREQ + req) * 30 + 26 + s) * 256 + c, g);
        } else if (pn == 2) {
            st8f(p.U + (size_t)m * 256 + j, lo); st8f(p.U + (size_t)m * 256 + 128 + j, hi);
            if (!samp) { if (t >= T_ - 15) { float* o = p.out + O_POOLP + ((size_t)(l * NB_ + b) * 15 + (t - (T_ - 15))) * 256; st8f(o + j, lo); st8f(o + 128 + j, hi); } }
            else { float* o = p.out + O_POOLS + ((size_t)(l * NREQ + req) * 15 + 11 + s) * 256; st8f(o + j, lo); st8f(o + 128 + j, hi); }
        } else if (pn < 5) {
            const int g = pn - 3; float a[8], c[8];
#pragma unroll
            for (int i = 0; i < 8; ++i) { a[i] = lo[i] * QSCALE; c[i] = hi[i] * QSCALE; }
            st8b(p.Q + (size_t)m * 512 + g * 256 + j, a); st8b(p.Q + (size_t)m * 512 + g * 256 + 128 + j, c);
        } else if (pn < 8) {
            const int br = pn - 5, g = j >> 6, d = j & 63;
            long long oo;
            if (!samp) oo = br == 0 ? (long long)(O_CMPP + ((size_t)(l * NB_ + b) * T_ + t) * 256) : (br == 1 ? (long long)(O_SLCP + ((size_t)(l * NB_ + b) * T_ + t) * 256)
                          : (t >= T_ - 512 ? (long long)(O_WINP + ((size_t)(l * NB_ + b) * 512 + (t - (T_ - 512))) * 256) : -1ll));
            else oo = br == 0 ? (long long)(O_CMPS + ((size_t)(l * NREQ + req) * 4 + s) * 256) : (br == 1 ? (long long)(O_SLCS + ((size_t)(l * NREQ + req) * 4 + s) * 256)
                          : (long long)(O_WINS + ((size_t)(l * NREQ + req) * 512 + 508 + s) * 256));
            if (oo >= 0) { st8f(p.out + oo + j, lo); st8f(p.out + oo + 128 + j, hi); }
            if (!samp) {
                bf16_t* kb = p.KVB + ((((size_t)(br * 2) * NB_ + b) * 2 + g) * T_ + t) * 64 + d;
                st8b(kb, lo); st8b(kb + (size_t)NB_ * 2 * T_ * 64, hi);
            }
        } else {
            if (j < 24) {
#pragma unroll
                for (int i = 0; i < 8; ++i) p.GATES[(size_t)m * 24 + j + i] = sigmoidf_(lo[i]);
            }
        }
        return 0.f;
    }
};
struct EpiRes {
    static constexpr bool HAS_SS = true, USE_RS = false, HAS_AUX = true;
    const Prm& p; int mode;
    float* ss; bool keep_f32;
    struct Aux { float4 r0, r1, r2, r3; };
    DEV Aux fetch(int m, int pn, int j) const {
        const int c = pn * 256 + j; Aux a;
        if (mode == 0) {
            const float* rb = (m < MP ? p.x_prompt + (size_t)m * D_ : p.x_sample + (size_t)(m - MP) * D_) + c;
            a.r0 = *(const float4*)(rb); a.r1 = *(const float4*)(rb + 4); a.r2 = *(const float4*)(rb + 128); a.r3 = *(const float4*)(rb + 132);
        } else {
            const bf16_t* rb = p.XB + (size_t)m * D_ + c; const uint4 u = *(const uint4*)rb, v = *(const uint4*)(rb + 128);
            a.r0 = make_float4(__uint_as_float(u.x << 16), __uint_as_float(u.x & 0xffff0000u), __uint_as_float(u.y << 16), __uint_as_float(u.y & 0xffff0000u));
            a.r1 = make_float4(__uint_as_float(u.z << 16), __uint_as_float(u.z & 0xffff0000u), __uint_as_float(u.w << 16), __uint_as_float(u.w & 0xffff0000u));
            a.r2 = make_float4(__uint_as_float(v.x << 16), __uint_as_float(v.x & 0xffff0000u), __uint_as_float(v.y << 16), __uint_as_float(v.y & 0xffff0000u));
            a.r3 = make_float4(__uint_as_float(v.z << 16), __uint_as_float(v.z & 0xffff0000u), __uint_as_float(v.w << 16), __uint_as_float(v.w & 0xffff0000u));
        }
        return a;
    }
    DEV float apply(int m, int pn, int j, const float (&lo)[8], const float (&hi)[8]) const { return apply(m, pn, j, lo, hi, fetch(m, pn, j)); }
    DEV float apply(int m, int pn, int j, const float (&lo)[8], const float (&hi)[8], const Aux& ax) const {
        const int c = pn * 256 + j;
        float a[8], h[8]; float sq = 0.f;
        const float4 r0 = ax.r0, r1 = ax.r1, r2 = ax.r2, r3 = ax.r3;
        a[0] = lo[0] + r0.x; a[1] = lo[1] + r0.y; a[2] = lo[2] + r0.z; a[3] = lo[3] + r0.w; a[4] = lo[4] + r1.x; a[5] = lo[5] + r1.y; a[6] = lo[6] + r1.z; a[7] = lo[7] + r1.w;
        h[0] = hi[0] + r2.x; h[1] = hi[1] + r2.y; h[2] = hi[2] + r2.z; h[3] = hi[3] + r2.w; h[4] = hi[4] + r3.x; h[5] = hi[5] + r3.y; h[6] = hi[6] + r3.z; h[7] = hi[7] + r3.w;
#pragma unroll
        for (int i = 0; i < 8; ++i) sq += a[i] * a[i] + h[i] * h[i];
        st8b(p.XB + (size_t)m * D_ + c, a); st8b(p.XB + (size_t)m * D_ + c + 128, h);
        return sq;
    }
};
struct EpiGU {
    static constexpr bool HAS_SS = false, USE_RS = true, HAS_AUX = false;
    const Prm& p; float* ss;
    DEV const float* ss_src() const { return p.SSa; }
    DEV float apply(int m, int pn, int j, const float (&lo)[8], const float (&hi)[8], float rs) const {
        float a[8];
#pragma unroll
        for (int i = 0; i < 8; ++i) { const float g = lo[i] * rs, u = hi[i] * rs; a[i] = g * sigmoidf_(g) * u; }
        st8b(p.ACT + (size_t)m * DFF + pn * 128 + j, a);
        return 0.f;
    }
};

namespace pg8 {
#define PG8_LAS __attribute__((address_space(3)))
using ::bf16_t;
typedef short bf16x8 __attribute__((ext_vector_type(8)));
typedef float f32x4 __attribute__((ext_vector_type(4)));
typedef unsigned u32x4 __attribute__((ext_vector_type(4)));
constexpr int BM = 256, BK = 64, HALF = 128, HTB = HALF * BK * 2  , STAGE_BYTES = 8 * HTB, NXCD = 8, WGM = 8;

__host__ __device__ __forceinline__ int lds_byte(int r, int c) { const int st = (r >> 4) * 2 + (c >> 5), rr = r & 15, cc = c & 31, ob = rr * 64 + cc * 2; return st * 1024 + (ob ^ (((ob >> 9) & 1) << 5)); }
__host__ __device__ __forceinline__ void stage_rc(int b, int& R, int& C) { const int st = b / 1024, sb = b % 1024, swz = sb ^ (((sb >> 9) & 1) << 5); R = (st >> 1) * 16 + swz / 64; C = (st & 1) * 32 + (swz % 64) / 2; }
__host__ __device__ __forceinline__ int perm32(int rho) { const int n = rho >> 4, i = rho & 15; return 8 * (i >> 2) + 4 * n + (i & 3); }

struct Unit { int pm, pn, kq; };
struct Gemm { const bf16_t* A; const bf16_t* Bt; int M, N, K, Kl; };

struct StaticOrder {
    int nM, nN, nwg, G, c;
    __host__ __device__ void init(int M, int N, int G_, int c_) { nM = M / BM; nN = N / BM; nwg = nM * nN; G = G_; c = c_; }
    __host__ __device__ bool next(int i, Unit& u) const {
        const long L = (long)i * G + c; if (L >= nwg) return false;
        int wgid = (int)L; { const int q = nwg / NXCD, r = nwg % NXCD, xcd = wgid % NXCD, off = wgid / NXCD; wgid = (xcd < r ? xcd * (q + 1) : r * (q + 1) + (xcd - r) * q) + off; }
        const int nig = WGM * nN, gid = wgid / nig, fm = gid * WGM, gsz = (nM - fm) < WGM ? (nM - fm) : WGM;
        u.pm = fm + ((wgid % nig) % gsz); u.pn = (wgid % nig) / gsz; u.kq = 0; return true;
    }
    __device__ __forceinline__ void a_ready(const Unit&) const {}
    __device__ __forceinline__ void done(const Unit&) const {}
};

template <class Epi, class Sched, bool ALIGN_EPI = false, bool SP2 = false>
__device__ __forceinline__ void gemm_phase(PG8_LAS unsigned char* lds, const Gemm g, const Sched& S, const Epi& E) {
    const int tid = opaque_tid(), wid = __builtin_amdgcn_readfirstlane(tid >> 6), lane = tid & 63, wr = wid >> 2, wc = wid & 3, fr = lane & 15, fq = lane >> 4;
    const int K = g.K, nt = g.Kl / BK;
    unsigned voffA[2], voffB[2];
#pragma unroll
    for (int i = 0; i < 2; ++i) { int R, C; stage_rc(tid * 16 + i * 8192, R, C); const int Rb = Epi::PERM ? ((R & ~31) + perm32(R & 31)) : R;
        voffA[i] = (unsigned)(R * K + C) * 2u; voffB[i] = (unsigned)(Rb * K + C) * 2u; }
    const size_t kstep = (size_t)(BK * 2);
    const size_t hstep = (size_t)HALF * K * 2;
    const size_t tstep = 2 * hstep;
    const unsigned ldsw = (unsigned)wid * 1024u;
    const int aoff = lds_byte(wr * 64 + fr, fq * 8), boff = lds_byte(wc * 32 + fr, fq * 8);
#define PG8_SA(b, h) (((b) * 2 + (h)) * HTB)
#define PG8_SB(b, h) ((4 + (b) * 2 + (h)) * HTB)
#define PG8_STAGE(bufoff, gbase, voff) do { _Pragma("unroll") for (int _i = 0; _i < 2; ++_i) \
        __builtin_amdgcn_global_load_lds((const unsigned*)((const char*)(gbase) + (voff)[_i]), (PG8_LAS unsigned*)(lds + (bufoff) + ldsw + _i * 8192), 16, 0, 0); } while (0)
#define PG8_LDA(dst, b, h) do { _Pragma("unroll") for (int m = 0; m < 4; ++m) _Pragma("unroll") for (int k = 0; k < 2; ++k) dst[m][k] = *(const PG8_LAS bf16x8*)(lds + PG8_SA(b, h) + aoff + m * 2048 + k * 1024); } while (0)
#define PG8_LDB(dst, b, h) do { _Pragma("unroll") for (int n = 0; n < 2; ++n) _Pragma("unroll") for (int k = 0; k < 2; ++k) dst[n][k] = *(const PG8_LAS bf16x8*)(lds + PG8_SB(b, h) + boff + n * 2048 + k * 1024); } while (0)
#define PG8_MMA(ai, bj, At, Bt) do { __builtin_amdgcn_s_setprio(1); _Pragma("unroll") for (int m = 0; m < 4; ++m) _Pragma("unroll") for (int n = 0; n < 2; ++n) _Pragma("unroll") for (int k = 0; k < 2; ++k) \
        acc[ai][bj][m][n] = __builtin_amdgcn_mfma_f32_16x16x32_bf16(Bt[n][k], At[m][k], acc[ai][bj][m][n], 0, 0, 0); __builtin_amdgcn_s_setprio(0); } while (0)
#define PG8_WAIT_V(n) asm volatile("s_waitcnt vmcnt(" #n ")" ::: "memory")
#define PG8_WAIT_L(n) asm volatile("s_waitcnt lgkmcnt(" #n ")" ::: "memory")
#define PG8_BAR __builtin_amdgcn_s_barrier()
#define PG8_SCHED __builtin_amdgcn_sched_barrier(0)
    Unit cur, nxt; int ui = 0;
    if (!S.next(0, cur)) return;
    f32x4 acc[2][2][4][2];
#pragma unroll
    for (int a = 0; a < 2; ++a)
#pragma unroll
        for (int b = 0; b < 2; ++b)
#pragma unroll
            for (int m = 0; m < 4; ++m)
#pragma unroll
                for (int n = 0; n < 2; ++n) acc[a][b][m][n] = (f32x4){0.f, 0.f, 0.f, 0.f};
    bf16x8 At[4][2], B0[2][2], B1[2][2];
    const unsigned kqb = (unsigned)g.Kl * 2u;
    const char* cA = (const char*)g.A + (size_t)cur.pm * tstep + (unsigned)cur.kq * kqb; const char* cB = (const char*)g.Bt + (size_t)cur.pn * tstep + (unsigned)cur.kq * kqb;
    S.a_ready(cur);
    if constexpr (SP2) {
        PG8_STAGE(PG8_SB(0, 0), cB, voffB); PG8_STAGE(PG8_SB(0, 1), cB + hstep, voffB); PG8_STAGE(PG8_SA(0, 0), cA, voffA); PG8_STAGE(PG8_SA(0, 1), cA + hstep, voffA);
        if (wr == 1) PG8_BAR;
        PG8_WAIT_V(2); PG8_BAR;
        PG8_STAGE(PG8_SB(1, 0), cB + kstep, voffB); PG8_STAGE(PG8_SA(1, 0), cA + kstep, voffA); PG8_STAGE(PG8_SB(1, 1), cB + hstep + kstep, voffB);
        PG8_WAIT_V(6); PG8_BAR;
    } else {
        PG8_STAGE(PG8_SB(0, 0), cB, voffB); PG8_STAGE(PG8_SA(0, 0), cA, voffA); PG8_STAGE(PG8_SB(0, 1), cB + hstep, voffB); PG8_STAGE(PG8_SA(0, 1), cA + hstep, voffA);
        if (wr == 1) PG8_BAR;
        PG8_WAIT_V(4); PG8_BAR;
        PG8_STAGE(PG8_SB(1, 0), cB + kstep, voffB); PG8_STAGE(PG8_SA(1, 0), cA + kstep, voffA); PG8_STAGE(PG8_SB(1, 1), cB + hstep + kstep, voffB);
        PG8_WAIT_V(6); PG8_BAR;
    }
    for (;;) {
        const bool has_next = S.next(ui + 1, nxt);
        const char* nA = has_next ? (const char*)g.A + (size_t)nxt.pm * tstep + (unsigned)nxt.kq * kqb : cA; const char* nB = has_next ? (const char*)g.Bt + (size_t)nxt.pn * tstep + (unsigned)nxt.kq * kqb : cB;
        for (int t = 0; t < nt; t += 2) {
            const bool last = (t == nt - 2);
            const char* a1 = cA + (size_t)(t + 1) * kstep;
            const char* a2 = last ? nA : cA + (size_t)(t + 2) * kstep; const char* b2 = last ? nB : cB + (size_t)(t + 2) * kstep;
            const char* a3 = a2 + kstep; const char* b3 = b2 + kstep;
            if (last && has_next) S.a_ready(nxt);
            if constexpr (SP2) {
            PG8_LDB(B0, 0, 0); PG8_LDB(B1, 0, 1); PG8_SCHED; PG8_LDA(At, 0, 0); PG8_STAGE(PG8_SA(1, 1), a1 + hstep, voffA);
            PG8_WAIT_V(8); PG8_WAIT_L(0); PG8_BAR; PG8_MMA(0, 0, At, B0); PG8_MMA(0, 1, At, B1); PG8_BAR; PG8_SCHED;
            PG8_LDA(At, 0, 1); PG8_STAGE(PG8_SB(0, 0), b2, voffB); PG8_STAGE(PG8_SB(0, 1), b2 + hstep, voffB); PG8_STAGE(PG8_SA(0, 0), a2, voffA);
            PG8_WAIT_V(8); PG8_WAIT_L(0); PG8_BAR; PG8_MMA(1, 0, At, B0); PG8_MMA(1, 1, At, B1); PG8_BAR; PG8_SCHED;
            PG8_LDB(B0, 1, 0); PG8_LDB(B1, 1, 1); PG8_SCHED; PG8_LDA(At, 1, 0); PG8_STAGE(PG8_SA(0, 1), a2 + hstep, voffA);
            PG8_WAIT_V(8); PG8_WAIT_L(0); PG8_BAR; PG8_MMA(0, 0, At, B0); PG8_MMA(0, 1, At, B1); PG8_BAR; PG8_SCHED;
            PG8_LDA(At, 1, 1); PG8_STAGE(PG8_SB(1, 0), b3, voffB); PG8_STAGE(PG8_SB(1, 1), b3 + hstep, voffB); PG8_STAGE(PG8_SA(1, 0), a3, voffA);
            PG8_WAIT_V(8); PG8_WAIT_L(0); PG8_BAR; PG8_MMA(1, 0, At, B0); PG8_MMA(1, 1, At, B1); PG8_BAR; PG8_SCHED;
            } else {
            PG8_LDB(B0, 0, 0); PG8_SCHED; PG8_LDA(At, 0, 0); PG8_STAGE(PG8_SA(1, 1), a1 + hstep, voffA);
            PG8_WAIT_L(8); PG8_BAR; PG8_WAIT_L(0); PG8_MMA(0, 0, At, B0); PG8_BAR; PG8_SCHED;
            PG8_LDB(B1, 0, 1); PG8_STAGE(PG8_SB(0, 0), b2, voffB);
            PG8_BAR; PG8_WAIT_L(0); PG8_MMA(0, 1, At, B1); PG8_BAR;
            PG8_LDA(At, 0, 1); PG8_STAGE(PG8_SA(0, 0), a2, voffA);
            PG8_BAR; PG8_WAIT_L(0); PG8_MMA(1, 0, At, B0); PG8_BAR; PG8_SCHED;
            PG8_STAGE(PG8_SB(0, 1), b2 + hstep, voffB);
            PG8_WAIT_V(6); PG8_BAR; PG8_MMA(1, 1, At, B1); PG8_BAR;
            PG8_LDB(B0, 1, 0); PG8_SCHED; PG8_LDA(At, 1, 0); PG8_STAGE(PG8_SA(0, 1), a2 + hstep, voffA);
            PG8_WAIT_L(8); PG8_BAR; PG8_WAIT_L(0); PG8_MMA(0, 0, At, B0); PG8_BAR; PG8_SCHED;
            PG8_LDB(B1, 1, 1); PG8_STAGE(PG8_SB(1, 0), b3, voffB);
            PG8_BAR; PG8_WAIT_L(0); PG8_MMA(0, 1, At, B1); PG8_BAR;
            PG8_LDA(At, 1, 1); PG8_STAGE(PG8_SA(1, 0), a3, voffA);
            PG8_BAR; PG8_WAIT_L(0); PG8_MMA(1, 0, At, B0); PG8_BAR; PG8_SCHED;
            PG8_STAGE(PG8_SB(1, 1), b3 + hstep, voffB);
            PG8_WAIT_V(6); PG8_BAR; PG8_MMA(1, 1, At, B1); PG8_BAR;
            }
        }
        if constexpr (ALIGN_EPI) { if (wr == 0) PG8_BAR; }
        if constexpr (!Epi::AFTER_DRAIN) { E(acc, cur, wr, wc, fr, fq); S.done(cur); }
        if (!has_next) break;
#pragma unroll
        for (int a = 0; a < 2; ++a)
#pragma unroll
            for (int b = 0; b < 2; ++b)
#pragma unroll
                for (int m = 0; m < 4; ++m)
#pragma unroll
                    for (int n = 0; n < 2; ++n) acc[a][b][m][n] = (f32x4){0.f, 0.f, 0.f, 0.f};
        cur = nxt; cA = nA; cB = nB; ++ui;
        if constexpr (ALIGN_EPI) { if (wr == 1) PG8_BAR; }
    }
    PG8_WAIT_V(0);
    if constexpr (!ALIGN_EPI) { if (wr == 0) PG8_BAR; }
    PG8_BAR;
    if constexpr (Epi::AFTER_DRAIN) { E.fused(acc, cur, wr, wc, fr, fq, lds, wid, lane); S.done(cur); }
#undef PG8_SA
#undef PG8_SB
#undef PG8_STAGE
#undef PG8_LDA
#undef PG8_LDB
#undef PG8_MMA
#undef PG8_WAIT_V
#undef PG8_WAIT_L
#undef PG8_BAR
#undef PG8_SCHED
}
}

constexpr int RSL_OFF = 131072;
template <class E> struct EpiAdapt {
    static constexpr bool PERM = true, AFTER_DRAIN = false;
    const E& e; const float* rsl; mutable int ui;
    __device__ __forceinline__ void operator()(const pg8::f32x4 (&acc)[2][2][4][2], const pg8::Unit& u, int wr, int wc, int fr, int fq) const {
        const int j = wc * 32 + 8 * fq;
        float rsv[2][4];
        if constexpr (E::USE_RS) {
#pragma unroll
            for (int ai = 0; ai < 2; ++ai)
#pragma unroll
                for (int m = 0; m < 4; ++m) rsv[ai][m] = rsl[ui * 256 + ai * 128 + wr * 64 + m * 16 + fr];
        }
        if constexpr (E::HAS_AUX) {
            int row = u.pm * 256 + wr * 64 + fr; asm volatile("" : "+v"(row));
            typename E::Aux nx = e.fetch(row, u.pn, j);
#pragma unroll
            for (int g = 0; g < 8; ++g) {
                const int ai = g >> 2, m = g & 3;
                const typename E::Aux cu = nx;
                if (g < 7) { int rn = u.pm * 256 + ((g + 1) >> 2) * 128 + wr * 64 + ((g + 1) & 3) * 16 + fr; asm volatile("" : "+v"(rn)); nx = e.fetch(rn, u.pn, j); }
                float lo[8], hi[8];
#pragma unroll
                for (int i = 0; i < 4; ++i) { lo[i] = acc[ai][0][m][0][i]; lo[4 + i] = acc[ai][0][m][1][i]; hi[i] = acc[ai][1][m][0][i]; hi[4 + i] = acc[ai][1][m][1][i]; }
                float sq = e.apply(row, u.pn, j, lo, hi, cu);
                if (E::HAS_SS) { sq += __shfl_xor(sq, 16); sq += __shfl_xor(sq, 32); if (fq == 0) e.ss[(size_t)row * 16 + u.pn * 4 + wc] = sq; }
                row = u.pm * 256 + ((g + 1) >> 2) * 128 + wr * 64 + ((g + 1) & 3) * 16 + fr; asm volatile("" : "+v"(row));
            }
        } else {
#pragma unroll
            for (int ai = 0; ai < 2; ++ai)
#pragma unroll
                for (int m = 0; m < 4; ++m) {
                    int row = u.pm * 256 + ai * 128 + wr * 64 + m * 16 + fr;
                    asm volatile("" : "+v"(row));
                    float lo[8], hi[8];
#pragma unroll
                    for (int i = 0; i < 4; ++i) { lo[i] = acc[ai][0][m][0][i]; lo[4 + i] = acc[ai][0][m][1][i]; hi[i] = acc[ai][1][m][0][i]; hi[4 + i] = acc[ai][1][m][1][i]; }
                    float sq = e.apply(row, u.pn, j, lo, hi, rsv[ai][m]);
                    if (E::HAS_SS) { sq += __shfl_xor(sq, 16); sq += __shfl_xor(sq, 32); if (fq == 0) e.ss[(size_t)row * 16 + u.pn * 4 + wc] = sq; }
                }
        }
        ++ui;
    }
};
template <class E> DEV void gemm_fast(unsigned char* lds, const bf16_t* A, const bf16_t* Bt, int M, int N, int K, const E& e) {
    pg8::Gemm g{A, Bt, M, N, K, K}; pg8::StaticOrder S; S.init(M, N, (int)gridDim.x, (int)blockIdx.x);
    const float* rsl = (const float*)(lds + RSL_OFF);
    if constexpr (E::USE_RS) {
        const int tid = opaque_tid(); pg8::Unit u;
        __syncthreads();
        for (int i = tid >> 8; S.next(i, u); i += 2) ((float*)(lds + RSL_OFF))[i * 256 + (tid & 255)] = row_rs(e.ss_src(), u.pm * 256 + (tid & 255));
        __syncthreads();
    }
    EpiAdapt<E> ad{e, rsl, 0};
    pg8::gemm_phase<EpiAdapt<E>, pg8::StaticOrder, true, true>((PG8_LAS unsigned char*)lds, g, S, ad);
}

struct SplitOrder {
    int npn, nkq, G, c;
    __device__ bool next(int i, pg8::Unit& u) const { const long L = (long)i * G + (G - 1 - c); if (L >= 2L * npn * nkq) return false; const int x = (int)L; u.pm = MP / 256 + (x & 1); u.pn = (x >> 1) % npn; u.kq = (x >> 1) / npn; return true; }
    __device__ __forceinline__ void a_ready(const pg8::Unit&) const {}
    __device__ __forceinline__ void done(const pg8::Unit&) const {}
};
struct EpiPartial {
    static constexpr bool PERM = true, AFTER_DRAIN = false;
    float* slab; int N;
    __device__ __forceinline__ void operator()(const pg8::f32x4 (&acc)[2][2][4][2], const pg8::Unit& u, int wr, int wc, int fr, int fq) const {
        const int j = wc * 32 + 8 * fq;
#pragma unroll
        for (int ai = 0; ai < 2; ++ai)
#pragma unroll
            for (int m = 0; m < 4; ++m) {
                const int rs = (u.pm - MP / 256) * 256 + ai * 128 + wr * 64 + m * 16 + fr;
                float* o = slab + ((size_t)u.kq * MS + rs) * N + u.pn * 256 + j;
                *(pg8::f32x4*)(o) = acc[ai][0][m][0]; *(pg8::f32x4*)(o + 4) = acc[ai][0][m][1]; *(pg8::f32x4*)(o + 128) = acc[ai][1][m][0]; *(pg8::f32x4*)(o + 132) = acc[ai][1][m][1];
            }
    }
};
DEV void gemm_split(unsigned char* lds, const bf16_t* A, const bf16_t* Bt, int N, int K, int Kl, float* slab) {
    pg8::Gemm g{A, Bt, M_, N, K, Kl}; SplitOrder S{N / 256, K / Kl, (int)gridDim.x, (int)blockIdx.x};
    EpiPartial ep{slab, N};
    pg8::gemm_phase<EpiPartial, SplitOrder, false, false>((PG8_LAS unsigned char*)lds, g, S, ep);
}
template <class E> DEV void gemm_reduce(const float* slab, int N, int nkq, const E& e) {
    const int ntn = N / 256, total = MS * ntn * 16;
    for (int gid = blockIdx.x * NTHR + opaque_tid(); gid < total; gid += gridDim.x * NTHR) {
        const int jj = gid & 15, pn = (gid >> 4) % ntn, rs = (gid >> 4) / ntn, j = jj * 8;
        float lo[8], hi[8];
#pragma unroll
        for (int i = 0; i < 8; ++i) { lo[i] = 0.f; hi[i] = 0.f; }
#pragma unroll
        for (int kq = 0; kq < nkq; ++kq) {
            const float* o = slab + ((size_t)kq * MS + rs) * N + pn * 256 + j;
            const float4 a = *(const float4*)(o), b = *(const float4*)(o + 4), c = *(const float4*)(o + 128), d = *(const float4*)(o + 132);
            lo[0] += a.x; lo[1] += a.y; lo[2] += a.z; lo[3] += a.w; lo[4] += b.x; lo[5] += b.y; lo[6] += b.z; lo[7] += b.w;
            hi[0] += c.x; hi[1] += c.y; hi[2] += c.z; hi[3] += c.w; hi[4] += d.x; hi[5] += d.y; hi[6] += d.z; hi[7] += d.w;
        }
        float sq = e.apply(MP + rs, pn, j, lo, hi);
        if (E::HAS_SS) { sq += __shfl_xor(sq, 1); sq += __shfl_xor(sq, 2); if ((jj & 3) == 0) e.ss[(size_t)(MP + rs) * 16 + pn * 4 + (jj >> 2)] = sq; }
    }
}

DEV void gemm_reduce_final(const Prm& p, const float* slab, int nkq_) {
    constexpr int N = D_, ntn = N / 256, total = MS * ntn * 16, nkq = DFF / 256; (void)nkq_;
    for (int gid = blockIdx.x * NTHR + opaque_tid(); gid < total; gid += gridDim.x * NTHR) {
        const int jj = gid & 15, pn = (gid >> 4) % ntn, rs = (gid >> 4) / ntn, j = jj * 8, c = pn * 256 + j;
        float lo[8], hi[8];
#pragma unroll
        for (int i = 0; i < 8; ++i) { lo[i] = 0.f; hi[i] = 0.f; }
#pragma unroll
        for (int kq = 0; kq < nkq; ++kq) {
            const float* o = slab + ((size_t)kq * MS + rs) * N + c;
            const float4 a = *(const float4*)(o), b = *(const float4*)(o + 4), cc = *(const float4*)(o + 128), d = *(const float4*)(o + 132);
            lo[0] += a.x; lo[1] += a.y; lo[2] += a.z; lo[3] += a.w; lo[4] += b.x; lo[5] += b.y; lo[6] += b.z; lo[7] += b.w;
            hi[0] += cc.x; hi[1] += cc.y; hi[2] += cc.z; hi[3] += cc.w; hi[4] += d.x; hi[5] += d.y; hi[6] += d.z; hi[7] += d.w;
        }
        const bf16_t* rb = p.XB + (size_t)(MP + rs) * D_ + c; const uint4 u = *(const uint4*)rb, v = *(const uint4*)(rb + 128);
        const unsigned uu[4] = {u.x, u.y, u.z, u.w}, vv[4] = {v.x, v.y, v.z, v.w};
        float sq = 0.f;
#pragma unroll
        for (int i = 0; i < 4; ++i) { lo[2 * i] += __uint_as_float(uu[i] << 16); lo[2 * i + 1] += __uint_as_float(uu[i] & 0xffff0000u); hi[2 * i] += __uint_as_float(vv[i] << 16); hi[2 * i + 1] += __uint_as_float(vv[i] & 0xffff0000u); }
#pragma unroll
        for (int i = 0; i < 8; ++i) sq += lo[i] * lo[i] + hi[i] * hi[i];
        sq = wave_sum(sq);
        const float r = rsqrtf(sq * (1.f / 1024.f) + 1e-6f);
        const float* g = p.final_norm + c; float* y = p.out + (size_t)(MP + rs) * D_ + c;
        const float4 g0 = *(const float4*)(g), g1 = *(const float4*)(g + 4), g2 = *(const float4*)(g + 128), g3 = *(const float4*)(g + 132);
        *(float4*)(y) = make_float4(lo[0] * r * g0.x, lo[1] * r * g0.y, lo[2] * r * g0.z, lo[3] * r * g0.w); *(float4*)(y + 4) = make_float4(lo[4] * r * g1.x, lo[5] * r * g1.y, lo[6] * r * g1.z, lo[7] * r * g1.w);
        *(float4*)(y + 128) = make_float4(hi[0] * r * g2.x, hi[1] * r * g2.y, hi[2] * r * g2.z, hi[3] * r * g2.w); *(float4*)(y + 132) = make_float4(hi[4] * r * g3.x, hi[5] * r * g3.y, hi[6] * r * g3.z, hi[7] * r * g3.w);
    }
}

DEV void convpool_item(const Prm& p, int l, int item, float* sm) {
    float* cbuf = sm; float* pbuf = sm + 62 * 256; float* yb = sm + (62 + 47) * 256;
    const int tid = opaque_tid(), c = tid & 255, half = tid >> 8, wave = tid >> 6, lane = tid & 63;
    const bool samp = item >= 512; const int NT = samp ? 4 : 32, ntok = NT / 2;
    int m0, t0 = 0, req = 0;
    if (!samp) { m0 = item * 32; t0 = m0 % T_; } else { req = item - 512; m0 = MP + req * 4; }
    __syncthreads();
    {
        float4 vc[8], vp[6];
#pragma unroll
        for (int i = 0; i < 8; ++i) { const int idx = tid + NTHR * i, r = idx >> 6, c4 = (idx & 63) * 4, rel = r - 30; float4 v = make_float4(0.f, 0.f, 0.f, 0.f);
            if (r < NT + 30) { if (!samp) { if (t0 + rel >= 0) v = *(const float4*)(p.G + (size_t)(m0 + rel) * 256 + c4); }
                else { if (rel < 0) v = *(const float4*)(p.state_conv + ((size_t)(l * NREQ + req) * 30 + r) * 256 + c4); else v = *(const float4*)(p.G + (size_t)(m0 + rel) * 256 + c4); } }
            vc[i] = v; }
#pragma unroll
        for (int i = 0; i < 6; ++i) { const int idx = tid + NTHR * i, r = idx >> 6, c4 = (idx & 63) * 4, rel = r - 15; float4 v = make_float4(0.f, 0.f, 0.f, 0.f);
            if (r < NT + 15) { if (!samp) { if (t0 + rel >= 0) v = *(const float4*)(p.U + (size_t)(m0 + rel) * 256 + c4); }
                else { if (rel < 0) v = *(const float4*)(p.state_pool + ((size_t)(l * NREQ + req) * 15 + r) * 256 + c4); else v = *(const float4*)(p.U + (size_t)(m0 + rel) * 256 + c4); } }
            vp[i] = v; }
#pragma unroll
        for (int i = 0; i < 8; ++i) { const int idx = tid + NTHR * i, r = idx >> 6, c4 = (idx & 63) * 4; if (r < NT + 30) *(float4*)(cbuf + r * 256 + c4) = vc[i]; }
#pragma unroll
        for (int i = 0; i < 6; ++i) { const int idx = tid + NTHR * i, r = idx >> 6, c4 = (idx & 63) * 4; if (r < NT + 15) *(float4*)(pbuf + r * 256 + c4) = vp[i]; }
    }
    __syncthreads();
    {
        const float cbias = p.conv_b[l * 256 + c];
        float dw[31];
#pragma unroll
        for (int w = 0; w < 31; ++w) dw[w] = p.conv_dw[(size_t)(l * 31 + w) * 256 + c];
        const float* bp = cbuf + (half * ntok) * 256 + c;
        if (!samp) {
#pragma unroll 1
            for (int k4 = 0; k4 < 4; ++k4) {
                float a0 = cbias, a1 = cbias, a2 = cbias, a3 = cbias;
#pragma unroll
                for (int rr = 0; rr < 34; ++rr) {
                    const float v = bp[(k4 * 4 + rr) * 256];
                    if (rr < 31) a0 += v * dw[rr];
                    if (rr >= 1 && rr < 32) a1 += v * dw[rr - 1];
                    if (rr >= 2 && rr < 33) a2 += v * dw[rr - 2];
                    if (rr >= 3) a3 += v * dw[rr - 3];
                }
                float* yo = yb + (half * ntok + k4 * 4) * 256 + c; yo[0] = a0; yo[256] = a1; yo[512] = a2; yo[768] = a3;
            }
        } else {
            float a0 = cbias, a1 = cbias;
#pragma unroll
            for (int rr = 0; rr < 32; ++rr) { const float v = bp[rr * 256]; if (rr < 31) a0 += v * dw[rr]; if (rr >= 1) a1 += v * dw[rr - 1]; }
            float* yo = yb + (half * ntok) * 256 + c; yo[0] = a0; yo[256] = a1;
        }
    }
    if (samp) {
        for (int idx = tid; idx < 26 * 256; idx += NTHR) p.out[O_CONVS + ((size_t)(l * NREQ + req) * 30) * 256 + idx] = cbuf[4 * 256 + idx];
        for (int idx = tid; idx < 11 * 256; idx += NTHR) p.out[O_POOLS + ((size_t)(l * NREQ + req) * 15) * 256 + idx] = pbuf[4 * 256 + idx];
    }
    __syncthreads();
    for (int tok = wave; tok < NT; tok += 8) {
        const float4 v = *(const float4*)(yb + tok * 256 + lane * 4);
        const float mean = wave_sum((v.x + v.y) + (v.z + v.w)) * (1.f / 256.f);
        const float x0 = v.x - mean, x1 = v.y - mean, x2 = v.z - mean, x3 = v.w - mean;
        const float var = wave_sum((x0 * x0 + x1 * x1) + (x2 * x2 + x3 * x3)) * (1.f / 256.f);
        const float r = rsqrtf(var + 1e-6f);
        const float4 g = *(const float4*)(p.conv_ln_g + l * 256 + lane * 4), bb = *(const float4*)(p.conv_ln_b + l * 256 + lane * 4);
        float y0 = x0 * r * g.x + bb.x, y1 = x1 * r * g.y + bb.y, y2 = x2 * r * g.z + bb.z, y3 = x3 * r * g.w + bb.w;
        y0 *= sigmoidf_(y0); y1 *= sigmoidf_(y1); y2 *= sigmoidf_(y2); y3 *= sigmoidf_(y3);
        uint2 w; w.x = pack2(y0, y1); w.y = pack2(y2, y3);
        *(uint2*)(p.MIX + (size_t)(m0 + tok) * D_ + lane * 4) = w;
    }
    __syncthreads();
    {
        const int w = 2 << (c >> 6);
#pragma unroll 1
        for (int k = 0; k < ntok; ++k) {
            const int tok = half * ntok + k; float v[16];
#pragma unroll
            for (int i = 0; i < 16; ++i) v[i] = pbuf[(tok + 15 - i) * 256 + c];
            float sacc = v[0] + v[1];
#pragma unroll
            for (int i = 2; i < 16; ++i) sacc += i < w ? v[i] : 0.f;
            const int cnt = samp ? w : min(w, t0 + tok + 1);
            yb[tok * 256 + c] = sacc / (float)cnt - v[0];
        }
    }
    __syncthreads();
    {
        const int e = tid & 63, g = (tid >> 6) & 3; const float sc = p.pool_scale[l * 256 + g * 64 + e];
        const float* wp = p.pool_w + (size_t)(l * 4 + g) * 64 * 64 + e;
        float wr[64];
#pragma unroll
        for (int cc = 0; cc < 64; ++cc) wr[cc] = wp[cc * 64];
#pragma unroll 1
        for (int k = 0; k < ntok; ++k) {
            const int tok = half * ntok + k; float acc = 0.f; const float* yr = yb + tok * 256 + g * 64;
#pragma unroll
            for (int c4 = 0; c4 < 16; ++c4) { const float4 y = *(const float4*)(yr + c4 * 4); acc += y.x * wr[c4 * 4] + y.y * wr[c4 * 4 + 1] + y.z * wr[c4 * 4 + 2] + y.w * wr[c4 * 4 + 3]; }
            p.MIX[(size_t)(m0 + tok) * D_ + 256 + g * 64 + e] = f2bf(acc * sc);
        }
    }
}
typedef short bf16x8_t __attribute__((ext_vector_type(8)));
typedef short s16x4_t __attribute__((ext_vector_type(4)));
typedef float f32x16_t __attribute__((ext_vector_type(16)));
DEV unsigned off64(unsigned row, unsigned ch) { return 1024u * (row >> 3) + 512u * (ch >> 2) + 64u * (row & 7) + 16u * ((ch & 3) ^ ((row >> 2) & 3)); }
enum { AM_FAR = 0, AM_NEAR = 1, AM_DIAG = 2, AM_WINFIRST = 3, AM_CMP = 4 };
constexpr int AT_RING = 6, AT_KB = 0, AT_VB = AT_RING * 8192, AT_BT = 2 * AT_RING * 8192, AT_PA = AT_BT + 2048, AT_SELM = AT_PA + 32768, AT_LDS = AT_SELM + 512;
static_assert(AT_LDS <= LDS_BYTES - 16, "attention LDS map");

struct AttnState { f32x16_t O0, O1; float m, l; };

template <bool PRIO = false> DEV void attn_qk(const unsigned char* kb, unsigned ka0, const bf16x8_t (&qf)[4], f32x16_t& S0, f32x16_t& S1) {
#pragma unroll
    for (int i = 0; i < 16; ++i) { S0[i] = 0.f; S1[i] = 0.f; }
    if (PRIO) __builtin_amdgcn_s_setprio(1);
#pragma unroll
    for (int ks = 0; ks < 4; ++ks) {
        const unsigned a = (ka0 ^ ((ks & 1) ? 32u : 0u)) + 512u * (ks >> 1);
        const bf16x8_t a0 = *(const bf16x8_t*)(kb + a), a1 = *(const bf16x8_t*)(kb + a + 4096);
        S0 = __builtin_amdgcn_mfma_f32_32x32x16_bf16(a0, qf[ks], S0, 0, 0, 0);
        S1 = __builtin_amdgcn_mfma_f32_32x32x16_bf16(a1, qf[ks], S1, 0, 0, 0);
    }
    if (PRIO) __builtin_amdgcn_s_setprio(0);
}
template <bool PRIO = false> DEV void attn_pv(unsigned vbase, unsigned va_rel, const f32x16_t& pa, const f32x16_t& pb, f32x16_t& O0, f32x16_t& O1) {
    const unsigned vb_addr0 = vbase + va_rel, vb1 = vbase + (va_rel ^ 32u) + 1024u;
#pragma unroll
    for (int k4 = 0; k4 < 4; ++k4) {
        const f32x16_t& P = (k4 < 2) ? pa : pb; const int s = k4 & 1;
        unsigned w[4];
#pragma unroll
        for (int i = 0; i < 4; ++i) w[i] = cvt_pk_bf16(P[8 * s + 2 * i], P[8 * s + 2 * i + 1]);
        bf16x8_t pf; { typedef unsigned u32x4_t __attribute__((ext_vector_type(4))); u32x4_t t = {w[0], w[1], w[2], w[3]}; pf = __builtin_bit_cast(bf16x8_t, t); }
        s16x4_t v00, v01, v10, v11;
        asm volatile("ds_read_b64_tr_b16 %0, %4 offset:%6\n\tds_read_b64_tr_b16 %1, %5 offset:%6\n\tds_read_b64_tr_b16 %2, %4 offset:%7\n\tds_read_b64_tr_b16 %3, %5 offset:%7\n\ts_waitcnt lgkmcnt(0)"
                     : "=&v"(v00), "=&v"(v01), "=&v"(v10), "=&v"(v11) : "v"(vb_addr0), "v"(vb1), "i"(2048 * k4), "i"(2048 * k4 + 512) : "memory");
        const bf16x8_t a0 = __builtin_shufflevector(v00, v01, 0, 1, 2, 3, 4, 5, 6, 7), a1 = __builtin_shufflevector(v10, v11, 0, 1, 2, 3, 4, 5, 6, 7);
        if (PRIO) __builtin_amdgcn_s_setprio(1);
        O0 = __builtin_amdgcn_mfma_f32_32x32x16_bf16(a0, pf, O0, 0, 0, 0);
        O1 = __builtin_amdgcn_mfma_f32_32x32x16_bf16(a1, pf, O1, 0, 0, 0);
        if (PRIO) __builtin_amdgcn_s_setprio(0);
    }
}
template <int MODE> DEV void attn_bias(f32x16_t& S0, f32x16_t& S1, int dl, float lb, const float* bt_r) {
    constexpr int STEP = MODE == AM_CMP ? 16 : 1;
#pragma unroll
    for (int u = 0; u < 2; ++u)
#pragma unroll
        for (int v = 0; v < 16; ++v) {
            float s = u ? S1[v] : S0[v];
            const int dist = dl - STEP * (32 * u + (v & 3) + 8 * (v >> 2));
            if (MODE == AM_FAR) s += lb;
            else if (MODE == AM_WINFIRST) s = dist < 512 ? s + lb : -1e30f;
            else if (MODE == AM_NEAR) s += bt_r[min(max(dist, 0), 127)] + lb;
            else s = dist >= 0 ? s + bt_r[min(max(dist, 0), 127)] : -1e30f;
            if (u) S1[v] = s; else S0[v] = s;
        }
}
template <bool MASKED> DEV float attn_tilemax(const f32x16_t& S0, const f32x16_t& S1) {
    float t = fmaxf(S0[0], S1[0]);
#pragma unroll
    for (int v = 1; v < 16; ++v) t = fmaxf(t, fmaxf(S0[v], S1[v]));
    return fmaxf(t, __shfl_xor(t, 32));
}
template <bool MASKED> DEV float attn_exp(f32x16_t& S0, f32x16_t& S1, float mref, float scale) {
    float sum = 0.f;
#pragma unroll
    for (int v = 0; v < 16; ++v) {
        float e0 = __builtin_amdgcn_exp2f(S0[v] - mref), e1 = __builtin_amdgcn_exp2f(S1[v] - mref);
        if (MASKED) { e0 = S0[v] > -1e29f ? e0 : 0.f; e1 = S1[v] > -1e29f ? e1 : 0.f; }
        e0 *= scale; e1 *= scale;
        S0[v] = e0; S1[v] = e1; sum += e0 + e1;
    }
    return sum;
}
template <int MODE> DEV void attn_tile(const unsigned char* kb, unsigned ka0, unsigned vbase, unsigned va_rel, const bf16x8_t (&qf)[4], AttnState& st, int dl, float lb, const float* bt_r) {
    constexpr bool MASKED = MODE >= AM_DIAG;
    f32x16_t S0, S1;
    attn_qk(kb, ka0, qf, S0, S1);
    attn_bias<MODE>(S0, S1, dl, lb, bt_r);
    const float tm = attn_tilemax<MASKED>(S0, S1);
    const float mn = fmaxf(st.m, tm), alpha = __builtin_amdgcn_exp2f(st.m - mn);
    st.m = mn;
    const float ps = attn_exp<MASKED>(S0, S1, mn, 1.f);
    st.l = st.l * alpha + ps;
#pragma unroll
    for (int v = 0; v < 16; ++v) { st.O0[v] *= alpha; st.O1[v] *= alpha; }
    attn_pv(vbase, va_rel, S0, S1, st.O0, st.O1);
}

DEV void attn_prompt_unit(const Prm& p, int l, int b, int g, int qb, unsigned char* lds) {
    const int tid = opaque_tid(), w = tid >> 6, lane = tid & 63, c = lane & 31, h = lane >> 5, qi = c >> 2, r = c & 3;
    float* BT = (float*)(lds + AT_BT); float* PA = (float*)(lds + AT_PA) + w * 1024; float* PB = PA + 512;
    unsigned* SELM = (unsigned*)(lds + AT_SELM) + w * 16;
    __syncthreads();
    BT[tid] = p.BIASL2[g * 512 + tid];
#pragma unroll
    for (int i = 0; i < 16; ++i) ((float*)(lds + AT_PA))[tid + 512 * i] = 0.f;
    const int tq = 64 * qb + 8 * w + qi; const size_t mrow = (size_t)b * T_ + tq;
    bf16x8_t qf[4];
#pragma unroll
    for (int ks = 0; ks < 4; ++ks) qf[ks] = *(const bf16x8_t*)(p.Q + mrow * 512 + g * 256 + r * 64 + ks * 16 + 8 * h);
    const float gc = p.GATES[mrow * 24 + g * 4 + r], gs = p.GATES[mrow * 24 + 8 + g * 4 + r], gw = p.GATES[mrow * 24 + 16 + g * 4 + r];
    const float* bt_r = BT + r * 128;
    const unsigned ka0 = 1024u * ((unsigned)c >> 3) + 64u * (c & 7) + 16u * ((unsigned)h ^ (((unsigned)c >> 2) & 3u));
    const unsigned blk = (lane >> 4) & 1, q4 = (lane & 15) >> 2, pp = lane & 3;
    const unsigned va_rel = 64u * (4u * h + q4) + 8u * (pp & 1) + 16u * ((2u * blk + (pp >> 1)) ^ (unsigned)h);
    const unsigned lds_base = (unsigned)(size_t)(LAS unsigned char*)lds;
    const bf16_t* KCb = p.KC + (((size_t)b * 2 + g) * 2 + 0) * 256 * 64; const bf16_t* VCb = KCb + 256 * 64;
    const bf16_t* KSb = p.KVB + ((((size_t)(1 * 2 + 0) * NB_ + b) * 2 + g) * T_) * 64; const bf16_t* VSb = p.KVB + ((((size_t)(1 * 2 + 1) * NB_ + b) * 2 + g) * T_) * 64;
    const bf16_t* KWb = p.KVB + ((((size_t)(2 * 2 + 0) * NB_ + b) * 2 + g) * T_) * 64; const bf16_t* VWb = p.KVB + ((((size_t)(2 * 2 + 1) * NB_ + b) * 2 + g) * T_) * 64;
    const int nC = (4 * qb + 66) >> 6, nS = qb + 1, w0 = qb > 8 ? qb - 8 : 0, nW = qb - w0 + 1, J = 2 * nC + nS + nW;
    const int ws = __builtin_amdgcn_readfirstlane(w);
    const int ldrow = 8 * ws + ((lane >> 2) & 7), ldch = 4 * (lane >> 5) + ((lane & 3) ^ ((2 * ws + ((lane >> 4) & 1)) & 3));
    const size_t ldsrc = (size_t)ldrow * 64 + ldch * 8;
    auto job_src = [&](int ji, const bf16_t*& kp, const bf16_t*& vp) {
        if (ji < nC) { kp = KCb + (size_t)ji * 4096; vp = VCb + (size_t)ji * 4096; }
        else if (ji < 2 * nC) { kp = KCb + (size_t)(ji - nC) * 4096; vp = VCb + (size_t)(ji - nC) * 4096; }
        else if (ji < 2 * nC + nS) { kp = KSb + (size_t)(ji - 2 * nC) * 4096; vp = VSb + (size_t)(ji - 2 * nC) * 4096; }
        else { kp = KWb + (size_t)(w0 + ji - 2 * nC - nS) * 4096; vp = VWb + (size_t)(w0 + ji - 2 * nC - nS) * 4096; }
    };
    auto dma = [&](int ji) {
        const bf16_t* kp; const bf16_t* vp; job_src(ji, kp, vp); const int bufo = (ji % AT_RING) * 8192 + ws * 1024;
        __builtin_amdgcn_global_load_lds((const unsigned*)(kp + ldsrc), (LAS unsigned*)(lds + AT_KB + bufo), 16, 0, 0);
        __builtin_amdgcn_global_load_lds((const unsigned*)(vp + ldsrc), (LAS unsigned*)(lds + AT_VB + bufo), 16, 0, 0);
    };
    dma(0); dma(1); dma(2); dma(3);
    asm volatile("s_waitcnt vmcnt(4) lgkmcnt(0)" ::: "memory");
    __builtin_amdgcn_s_barrier();
    asm volatile("" ::: "memory");
    const float b31 = bt_r[127];
    AttnState st;
#pragma unroll
    for (int v = 0; v < 16; ++v) { st.O0[v] = 0.f; st.O1[v] = 0.f; }
    st.m = -1e30f; st.l = 0.f;
    f32x16_t A0, A1;
#pragma unroll
    for (int v = 0; v < 16; ++v) { A0[v] = 0.f; A1[v] = 0.f; }
    float mC = -1e30f, invC = 0.f; unsigned mlo = 0xffffffffu, mhi = 0xffffffffu;
    for (int jp = 0; jp < J; jp += 2) {
      const int nnew = (jp + 4 < J ? 1 : 0) + (jp + 5 < J ? 1 : 0);
      if (jp + 4 < J) dma(jp + 4);
      if (jp + 5 < J) dma(jp + 5);
#pragma unroll 1
      for (int ji = jp; ji < jp + 2 && ji < J; ++ji) {
        const unsigned char* kb = lds + AT_KB + (ji % AT_RING) * 8192; const unsigned vbase = lds_base + AT_VB + (ji % AT_RING) * 8192;
        if (ji < nC) {
            const int dl = tq - 31 - 1024 * ji - 64 * h;
            f32x16_t S0, S1; attn_qk(kb, ka0, qf, S0, S1); attn_bias<AM_CMP>(S0, S1, dl, 0.f, bt_r);
            const float tm = attn_tilemax<true>(S0, S1); const float mn = fmaxf(st.m, tm), alpha = __builtin_amdgcn_exp2f(st.m - mn); st.m = mn;
            st.l = st.l * alpha + attn_exp<true>(S0, S1, mn, 1.f);
            if (ji == nC - 1) { const float lt = st.l + __shfl_xor(st.l, 32); mC = st.m; invC = lt > 0.f ? 1.f / lt : 0.f; }
        } else if (ji < 2 * nC) {
            const int ct = ji - nC; const int dl = tq - 31 - 1024 * ct - 64 * h;
            f32x16_t S0, S1; attn_qk(kb, ka0, qf, S0, S1); attn_bias<AM_CMP>(S0, S1, dl, 0.f, bt_r);
            (void)attn_exp<true>(S0, S1, mC, invC);
            if (qb >= 16) {
#pragma unroll
                for (int u = 0; u < 2; ++u)
#pragma unroll
                    for (int qd = 0; qd < 4; ++qd) {
                        const f32x16_t& P = u ? S1 : S0;
                        float qs = (P[4 * qd] + P[4 * qd + 1]) + (P[4 * qd + 2] + P[4 * qd + 3]), ls = P[4 * qd + 3];
                        qs += __shfl_xor(qs, 1); qs += __shfl_xor(qs, 2); ls += __shfl_xor(ls, 1); ls += __shfl_xor(ls, 2);
                        const int jq = 16 * ct + 8 * u + 2 * qd + h;
                        if (r == 0) { PA[qi * 64 + jq] = qs; if (jq + 1 < 64) PB[qi * 64 + jq + 1] = ls; }
                    }
            }
            attn_pv(vbase, va_rel, S0, S1, st.O0, st.O1);
        } else if (ji < 2 * nC + nS) {
            const int j = ji - 2 * nC; const int dl = tq - 64 * j - 4 * h;
            const bool sel = j < 32 ? ((mlo >> j) & 1u) : ((mhi >> (j - 32)) & 1u);
            if (j == qb) attn_tile<AM_DIAG>(kb, ka0, vbase, va_rel, qf, st, dl, 0.f, bt_r);
            else if (__ballot(sel) != 0ull) {
                if (j >= qb - 2) attn_tile<AM_NEAR>(kb, ka0, vbase, va_rel, qf, st, dl, sel ? 0.f : -1e30f, bt_r);
                else attn_tile<AM_FAR>(kb, ka0, vbase, va_rel, qf, st, dl, sel ? b31 : -1e30f, bt_r);
            }
        } else {
            const int kbi = w0 + ji - 2 * nC - nS; const int dl = tq - 64 * kbi - 4 * h;
            if (kbi == qb) attn_tile<AM_DIAG>(kb, ka0, vbase, va_rel, qf, st, dl, 0.f, bt_r);
            else if (kbi >= qb - 2) attn_tile<AM_NEAR>(kb, ka0, vbase, va_rel, qf, st, dl, 0.f, bt_r);
            else if (kbi == qb - 8) attn_tile<AM_WINFIRST>(kb, ka0, vbase, va_rel, qf, st, dl, b31, bt_r);
            else attn_tile<AM_FAR>(kb, ka0, vbase, va_rel, qf, st, dl, b31, bt_r);
        }
        if (ji == jp + 1 || ji == J - 1) {
            if (nnew == 2) asm volatile("s_waitcnt vmcnt(4) lgkmcnt(0)" ::: "memory"); else if (nnew == 1) asm volatile("s_waitcnt vmcnt(2) lgkmcnt(0)" ::: "memory"); else asm volatile("s_waitcnt vmcnt(0) lgkmcnt(0)" ::: "memory");
            __builtin_amdgcn_s_barrier();
            asm volatile("" ::: "memory");
        }
        if (ji == 2 * nC - 1) {
#pragma unroll
            for (int v = 0; v < 16; ++v) { A0[v] = gc * st.O0[v]; A1[v] = gc * st.O1[v]; st.O0[v] = 0.f; st.O1[v] = 0.f; }
            st.m = -1e30f; st.l = 0.f;
            __syncthreads();
            if (qb >= 16) {
                for (int q = 0; q < 8; ++q) {
                    const bool cand = lane >= 1 && lane <= qb - 2;
                    const float sc = cand ? PA[q * 64 + lane] + PB[q * 64 + lane] : -1.f;
                    int cnt = 0;
                    for (int i = 1; i <= qb - 2; ++i) { const float si = __builtin_bit_cast(float, __builtin_amdgcn_readlane(__builtin_bit_cast(int, sc), i)); cnt += (si > sc || (si == sc && i < lane)) ? 1 : 0; }
                    const unsigned long long bal = __ballot(cand && cnt < 13) | 1ull | (1ull << qb) | (1ull << (qb - 1));
                    if (lane == 0) { SELM[q * 2] = (unsigned)bal; SELM[q * 2 + 1] = (unsigned)(bal >> 32); }
                }
            }
            __syncthreads();
            if (qb >= 16) { mlo = SELM[qi * 2]; mhi = SELM[qi * 2 + 1]; }
        }
        if (ji == 2 * nC + nS - 1 || ji == J - 1) {
            const float lt = st.l + __shfl_xor(st.l, 32); const float sc = (ji == J - 1 ? gw : gs) * (lt > 0.f ? 1.f / lt : 0.f);
#pragma unroll
            for (int v = 0; v < 16; ++v) { A0[v] += sc * st.O0[v]; A1[v] += sc * st.O1[v]; st.O0[v] = 0.f; st.O1[v] = 0.f; }
            st.m = -1e30f; st.l = 0.f;
        }
      }
    }
    bf16_t* o = p.MIX + mrow * D_ + 512 + g * 256 + r * 64 + 4 * h;
#pragma unroll
    for (int dt = 0; dt < 2; ++dt)
#pragma unroll
        for (int qd = 0; qd < 4; ++qd) {
            const f32x16_t& A = dt ? A1 : A0; uint2 wv; wv.x = cvt_pk_bf16(A[4 * qd], A[4 * qd + 1]); wv.y = cvt_pk_bf16(A[4 * qd + 2], A[4 * qd + 3]);
            *(uint2*)(o + 32 * dt + 8 * qd) = wv;
        }
}

constexpr int CS_G = 17408, CS_BUF = 2 * CS_G, CS_B = 2 * CS_BUF, CS_BB = 16384;
DEV void cmp_sample_item(const Prm& p, int l, int req, int type, unsigned char* lds) {
    const int tid = opaque_tid(), w = tid >> 6, lane = tid & 63, c = lane & 31, h = lane >> 5, g = w >> 2, ib = w & 3;
    const int cidx = tid & 15, rsub = tid >> 4, lg = cidx >> 3, lch = cidx & 7;
    __syncthreads();
    if (tid < 64) { const int bufi = tid >> 5, gg = (tid >> 4) & 1, ch = tid & 7; if ((tid & 15) < 8) *(uint4*)(lds + bufi * CS_BUF + gg * CS_G + off64(128, ch)) = make_uint4(0u, 0u, 0u, 0u); }
    const float* src[4]; unsigned dst[4];
#pragma unroll
    for (int ps = 0; ps < 4; ++ps) { const int i = ps * 32 + rsub; const int page = p.page_table[req * NPG + (i >> 3)];
        src[ps] = p.cache_cmp + (((((size_t)l * NPHYS + page) * 128 + (i & 7) * 16) * 2 + type) * 2) * 64 + cidx * 8; dst[ps] = lg * CS_G + off64(i, lch); }
    const bf16_t* wsrc = p.Wct + (size_t)(l * 2 + type) * 128 * 1024 + (size_t)(tid >> 2) * 1024 + (tid & 3) * 16;
    const unsigned wdst0 = CS_B + off64(tid >> 2, (tid & 3) * 2), wdst1 = CS_B + off64(tid >> 2, (tid & 3) * 2 + 1);
    float4 ra[4], rb[4], rc[4], rd[4]; uint4 wq0, wq1, wq2, wq3;
#pragma unroll
    for (int ps = 0; ps < 4; ++ps) { rc[ps] = *(const float4*)(src[ps]); rd[ps] = *(const float4*)(src[ps] + 4); }
    wq2 = *(const uint4*)(wsrc); wq3 = *(const uint4*)(wsrc + 8);
#pragma unroll
    for (int ps = 0; ps < 4; ++ps) { ra[ps] = *(const float4*)(src[ps] + 256); rb[ps] = *(const float4*)(src[ps] + 256 + 4); }
    wq0 = *(const uint4*)(wsrc + 64); wq1 = *(const uint4*)(wsrc + 64 + 8);
#pragma unroll
    for (int ps = 0; ps < 4; ++ps) { uint4 wv; wv.x = cvt_pk_bf16(rc[ps].x, rc[ps].y); wv.y = cvt_pk_bf16(rc[ps].z, rc[ps].w); wv.z = cvt_pk_bf16(rd[ps].x, rd[ps].y); wv.w = cvt_pk_bf16(rd[ps].z, rd[ps].w); *(uint4*)(lds + dst[ps]) = wv; }
    *(uint4*)(lds + wdst0) = wq2; *(uint4*)(lds + wdst1) = wq3;
    __syncthreads();
    f32x16_t acc0, acc1;
#pragma unroll
    for (int v = 0; v < 16; ++v) { acc0[v] = 0.f; acc1[v] = 0.f; }
    const unsigned alo = g * CS_G + off64(32 * ib + c, h), ahi = g * CS_G + off64(32 * ib + c + 1, h);
    const unsigned bo = CS_B + off64(c, h);
#define CS_ISSUE(RA, RB, W0, W1, st) do { _Pragma("unroll") for (int ps = 0; ps < 4; ++ps) { RA[ps] = *(const float4*)(src[ps] + (size_t)(st) * 256); RB[ps] = *(const float4*)(src[ps] + (size_t)(st) * 256 + 4); } \
        W0 = *(const uint4*)(wsrc + (st) * 64); W1 = *(const uint4*)(wsrc + (st) * 64 + 8); } while (0)
#define CS_COMMIT(RA, RB, W0, W1, st) do { unsigned char* nb = lds + ((st) & 1) * CS_BUF; _Pragma("unroll") for (int ps = 0; ps < 4; ++ps) { uint4 wv; wv.x = cvt_pk_bf16(RA[ps].x, RA[ps].y); wv.y = cvt_pk_bf16(RA[ps].z, RA[ps].w); \
        wv.z = cvt_pk_bf16(RB[ps].x, RB[ps].y); wv.w = cvt_pk_bf16(RB[ps].z, RB[ps].w); *(uint4*)(nb + dst[ps]) = wv; } \
        *(uint4*)(lds + ((st) & 1) * CS_BB + wdst0) = W0; *(uint4*)(lds + ((st) & 1) * CS_BB + wdst1) = W1; } while (0)
#define CS_COMPUTE(st) do { const unsigned char* ab = lds + ((st) & 1) * CS_BUF; const unsigned char* bb = lds + ((st) & 1) * CS_BB; _Pragma("unroll") for (int ks = 0; ks < 4; ++ks) { \
        const unsigned sw = (ks & 1) ? 32u : 0u, ad = 512u * (ks >> 1); \
        const bf16x8_t fa = *(const bf16x8_t*)(ab + (alo ^ sw) + ad), fb = *(const bf16x8_t*)(ab + (ahi ^ sw) + ad); \
        const unsigned char* bk = bb + (bo ^ sw) + ad; \
        const bf16x8_t b00 = *(const bf16x8_t*)(bk), b01 = *(const bf16x8_t*)(bk + 4096), b10 = *(const bf16x8_t*)(bk + 8192), b11 = *(const bf16x8_t*)(bk + 12288); \
        acc0 = __builtin_amdgcn_mfma_f32_32x32x16_bf16(fa, b00, acc0, 0, 0, 0); acc1 = __builtin_amdgcn_mfma_f32_32x32x16_bf16(fa, b01, acc1, 0, 0, 0); \
        acc0 = __builtin_amdgcn_mfma_f32_32x32x16_bf16(fb, b10, acc0, 0, 0, 0); acc1 = __builtin_amdgcn_mfma_f32_32x32x16_bf16(fb, b11, acc1, 0, 0, 0); } } while (0)
#pragma unroll 1
    for (int ll = 0; ll < 16; ll += 2) {
        if (ll + 2 < 16) CS_ISSUE(rc, rd, wq2, wq3, ll + 2);
        CS_COMPUTE(ll);
        CS_COMMIT(ra, rb, wq0, wq1, ll + 1);
        __syncthreads();
        if (ll + 3 < 16) CS_ISSUE(ra, rb, wq0, wq1, ll + 3);
        CS_COMPUTE(ll + 1);
        if (ll + 2 < 16) CS_COMMIT(rc, rd, wq2, wq3, ll + 2);
        __syncthreads();
    }
#undef CS_ISSUE
#undef CS_COMMIT
#undef CS_COMPUTE
    bf16_t* o = p.KCS + (((((size_t)l * NREQ + req) * 2 + g) * 2 + type) * 128) * 64;
    const float cb0 = cb_val(p.cb, (l * 2 + type) * 64 + c), cb1 = cb_val(p.cb, (l * 2 + type) * 64 + 32 + c);
#pragma unroll
    for (int v = 0; v < 16; ++v) {
        const int i = 32 * ib + (v & 3) + 8 * (v >> 2) + 4 * h;
        o[(size_t)i * 64 + c] = i == 127 ? (bf16_t)0 : f2bf(acc0[v] + cb0); o[(size_t)i * 64 + 32 + c] = i == 127 ? (bf16_t)0 : f2bf(acc1[v] + cb1);
    }
}
DEV void cmp_sample_fast(const Prm& p, int l, unsigned char* lds) {
    for (int it = blockIdx.x; it < NREQ * 2; it += gridDim.x) cmp_sample_item(p, l, it >> 1, it & 1, lds);
}

constexpr int AS_BT = 131072, AS_PA = AS_BT + 2048, AS_SELM = AS_PA + 4096, AS_PARK = AS_SELM + 64, AS_PARK2 = AS_PARK + 8 * 2048, AS_LDS = AS_PARK2 + 8 * 256;
static_assert(AS_LDS <= LDS_BYTES - 32, "sample attention LDS map");
template <int NH = 2, class RowFn, class DstFn> DEV void as_load_f32(unsigned char* kt, unsigned char* vt, int lane, RowFn rowp, DstFn dstp) {
    const int rsub = lane >> 4, li = lane & 15;
    constexpr int NI = 16 / NH;
#pragma unroll 1
    for (int hf = 0; hf < NH; ++hf) {
        float4 kx[NI], vx[NI];
#pragma unroll
        for (int it = 0; it < NI; ++it) { const float* rp = rowp(32 * hf + 4 * it + rsub);
            if (rp) { kx[it] = *(const float4*)(rp + li * 4); vx[it] = *(const float4*)(rp + 128 + li * 4); } else { kx[it] = make_float4(0.f, 0.f, 0.f, 0.f); vx[it] = kx[it]; } }
#pragma unroll
        for (int it = 0; it < NI; ++it) { const unsigned o = off64(32 * hf + 4 * it + rsub, li >> 1) + 8 * (li & 1);
            uint2 a, b; a.x = cvt_pk_bf16(kx[it].x, kx[it].y); a.y = cvt_pk_bf16(kx[it].z, kx[it].w); b.x = cvt_pk_bf16(vx[it].x, vx[it].y); b.y = cvt_pk_bf16(vx[it].z, vx[it].w);
            *(uint2*)(kt + o) = a; *(uint2*)(vt + o) = b;
            float* dp = dstp(32 * hf + 4 * it + rsub); if (dp) { *(float4*)(dp + li * 4) = kx[it]; *(float4*)(dp + 128 + li * 4) = vx[it]; } }
    }
}
DEV void as_load_bf16(unsigned char* t, const bf16_t* src, int lane) {
    uint4 v[8];
#pragma unroll
    for (int it = 0; it < 8; ++it) v[it] = *(const uint4*)(src + (size_t)(8 * it + (lane >> 3)) * 64 + (lane & 7) * 8);
#pragma unroll
    for (int it = 0; it < 8; ++it) *(uint4*)(t + off64(8 * it + (lane >> 3), lane & 7)) = v[it];
}
template <int MODE, bool FM> DEV void attn_tile_m(const unsigned char* kb, unsigned ka0, unsigned vbase, unsigned va_rel, const bf16x8_t (&qf)[4], AttnState& st, int dl, float lb, const float* bt_r) {
    constexpr bool MASKED = FM || MODE >= AM_DIAG;
    f32x16_t S0, S1;
    attn_qk(kb, ka0, qf, S0, S1);
    attn_bias<MODE>(S0, S1, dl, lb, bt_r);
    const float tm = attn_tilemax<MASKED>(S0, S1);
    const float mn = fmaxf(st.m, tm), alpha = __builtin_amdgcn_exp2f(st.m - mn);
    st.m = mn;
    const float ps = attn_exp<MASKED>(S0, S1, mn, 1.f);
    st.l = st.l * alpha + ps;
#pragma unroll
    for (int v = 0; v < 16; ++v) { st.O0[v] *= alpha; st.O1[v] *= alpha; }
    attn_pv(vbase, va_rel, S0, S1, st.O0, st.O1);
}
#define AS_WAVE_SYNC() do { asm volatile("s_waitcnt lgkmcnt(0)" ::: "memory"); __builtin_amdgcn_wave_barrier(); } while (0)
DEV void attn_sample_item(const Prm& p, int l, int req, int g, unsigned char* lds) {
    const int tid = opaque_tid(), w = __builtin_amdgcn_readfirstlane(tid >> 6), lane = tid & 63, c = lane & 31, h = lane >> 5, qi = (c >> 2) & 3, r = c & 3; const bool real = c < 16;
    float* BT = (float*)(lds + AS_BT); float* PA = (float*)(lds + AS_PA); float* PB = PA + 512; unsigned* SELM = (unsigned*)(lds + AS_SELM);
    unsigned char* kt = lds + w * 16384; unsigned char* vt = kt + 8192;
    __syncthreads();
    BT[tid] = p.BIASL2[g * 512 + tid]; PA[tid] = 0.f; PA[512 + tid] = 0.f;
    const int tq = PAST_ + qi; const size_t mrow = (size_t)MP + req * 4 + qi;
    bf16x8_t qf[4];
#pragma unroll
    for (int ks = 0; ks < 4; ++ks) { qf[ks] = *(const bf16x8_t*)(p.Q + mrow * 512 + g * 256 + r * 64 + ks * 16 + 8 * h); if (!real) qf[ks] = (bf16x8_t){0, 0, 0, 0, 0, 0, 0, 0}; }
    const float gc = p.GATES[mrow * 24 + g * 4 + r], gs = p.GATES[mrow * 24 + 8 + g * 4 + r], gw = p.GATES[mrow * 24 + 16 + g * 4 + r];
    const float* bt_r = BT + r * 128;
    const unsigned ka0 = 1024u * ((unsigned)c >> 3) + 64u * (c & 7) + 16u * ((unsigned)h ^ (((unsigned)c >> 2) & 3u));
    const unsigned blk = (lane >> 4) & 1, q4 = (lane & 15) >> 2, pp = lane & 3;
    const unsigned va_rel = 64u * (4u * h + q4) + 8u * (pp & 1) + 16u * ((2u * blk + (pp >> 1)) ^ (unsigned)h);
    const unsigned vbase = (unsigned)(size_t)(LAS unsigned char*)vt;
    __syncthreads();
    const float b31 = bt_r[127];
    AttnState sw, ss;
#pragma unroll
    for (int v = 0; v < 16; ++v) { sw.O0[v] = 0.f; sw.O1[v] = 0.f; ss.O0[v] = 0.f; ss.O1[v] = 0.f; }
    sw.m = -1e30f; sw.l = 0.f; ss.m = -1e30f; ss.l = 0.f;
    const size_t lr = (size_t)l * NREQ + req;
    const bf16_t* kc = p.KCS + ((lr * 2 + g) * 2 + 0) * 128 * 64; const bf16_t* vc = kc + 128 * 64;
    if (w == 0) {
        uint4 k0[8], k1[8], v0[8], v1[8];
        const int lr8 = lane >> 3, lc8 = (lane & 7) * 8;
#pragma unroll
        for (int it = 0; it < 8; ++it) { const size_t o = (size_t)(8 * it + lr8) * 64 + lc8; k0[it] = *(const uint4*)(kc + o); k1[it] = *(const uint4*)(kc + 4096 + o); }
#pragma unroll
        for (int it = 0; it < 8; ++it) { const unsigned o = off64(8 * it + lr8, lane & 7); *(uint4*)(kt + o) = k0[it]; *(uint4*)(vt + o) = k1[it]; }
        AS_WAVE_SYNC();
        f32x16_t A0, A1, B0, B1;
        attn_qk(kt, ka0, qf, A0, A1); attn_qk(vt, ka0, qf, B0, B1);
        attn_bias<AM_CMP>(A0, A1, tq - 31 - 64 * h, 0.f, bt_r); attn_bias<AM_CMP>(B0, B1, tq - 31 - 1024 - 64 * h, 0.f, bt_r);
        const float mC = fmaxf(attn_tilemax<true>(A0, A1), attn_tilemax<true>(B0, B1));
        float lC = attn_exp<true>(A0, A1, mC, 1.f); lC += attn_exp<true>(B0, B1, mC, 1.f);
        const float lt = lC + __shfl_xor(lC, 32), invC = lt > 0.f ? 1.f / lt : 0.f;
#pragma unroll
        for (int v = 0; v < 16; ++v) { A0[v] *= invC; A1[v] *= invC; B0[v] *= invC; B1[v] *= invC; }
        AS_WAVE_SYNC();
#pragma unroll
        for (int it = 0; it < 8; ++it) { const size_t o = (size_t)(8 * it + lr8) * 64 + lc8; v0[it] = *(const uint4*)(vc + o); v1[it] = *(const uint4*)(vc + 4096 + o); }
#pragma unroll
        for (int it = 0; it < 8; ++it) { const unsigned o = off64(8 * it + lr8, lane & 7); *(uint4*)(kt + o) = v0[it]; *(uint4*)(vt + o) = v1[it]; }
#pragma unroll
        for (int ct = 0; ct < 2; ++ct)
#pragma unroll
            for (int u = 0; u < 2; ++u)
#pragma unroll
                for (int qd = 0; qd < 4; ++qd) {
                    const f32x16_t& P = ct ? (u ? B1 : B0) : (u ? A1 : A0);
                    float qs = (P[4 * qd] + P[4 * qd + 1]) + (P[4 * qd + 2] + P[4 * qd + 3]), ls = P[4 * qd + 3];
                    qs += __shfl_xor(qs, 1); qs += __shfl_xor(qs, 2); ls += __shfl_xor(ls, 1); ls += __shfl_xor(ls, 2);
                    const int jq = 16 * ct + 8 * u + 2 * qd + h;
                    if (r == 0 && real) { PA[qi * 64 + jq] = qs; PB[qi * 64 + jq + 1] = ls; }
                }
        AS_WAVE_SYNC();
        attn_pv((unsigned)(size_t)(LAS unsigned char*)kt, va_rel, A0, A1, sw.O0, sw.O1);
        attn_pv(vbase, va_rel, B0, B1, sw.O0, sw.O1);
        AS_WAVE_SYNC();
    } else {
        for (int t = 0; t < 2; ++t) {
            const int wt = w - 1 + 7 * t; if (wt >= 9) break;
            as_load_f32<1>(kt, vt, lane, [&](int k) -> const float* { const int idx = 64 * wt + k;
                if (idx < 512) return p.cache_win + (lr * 512 + idx) * 256 + g * 64;
                if (idx < 516) return p.out + O_WINS + (lr * 512 + 508 + (idx - 512)) * 256 + g * 64;
                return nullptr; },
                [&](int k) -> float* { const int idx = 64 * wt + k; return (idx >= 4 && idx < 512) ? p.out + O_WINS + (lr * 512 + (idx - 4)) * 256 + g * 64 : nullptr; });
            AS_WAVE_SYNC();
            const int dl = 512 + qi - 64 * wt - 4 * h;
            if (wt == 0) attn_tile_m<AM_WINFIRST, false>(kt, ka0, vbase, va_rel, qf, sw, dl, b31, bt_r);
            else if (wt == 8) attn_tile_m<AM_DIAG, false>(kt, ka0, vbase, va_rel, qf, sw, dl, 0.f, bt_r);
            else if (wt >= 6) attn_tile_m<AM_NEAR, false>(kt, ka0, vbase, va_rel, qf, sw, dl, 0.f, bt_r);
            else attn_tile_m<AM_FAR, false>(kt, ka0, vbase, va_rel, qf, sw, dl, b31, bt_r);
            AS_WAVE_SYNC();
        }
    }
    if (real) {
        unsigned* park = (unsigned*)(lds + AS_PARK + w * 2048) + (h * 16 + (c & 15)) * 16;
        *(float2*)(lds + AS_PARK2 + w * 256 + (h * 16 + (c & 15)) * 8) = make_float2(sw.m, sw.l);
        uint4 q0, q1, q2, q3;
        q0.x = cvt_pk_bf16(sw.O0[0], sw.O0[1]); q0.y = cvt_pk_bf16(sw.O0[2], sw.O0[3]); q0.z = cvt_pk_bf16(sw.O0[4], sw.O0[5]); q0.w = cvt_pk_bf16(sw.O0[6], sw.O0[7]);
        q1.x = cvt_pk_bf16(sw.O0[8], sw.O0[9]); q1.y = cvt_pk_bf16(sw.O0[10], sw.O0[11]); q1.z = cvt_pk_bf16(sw.O0[12], sw.O0[13]); q1.w = cvt_pk_bf16(sw.O0[14], sw.O0[15]);
        q2.x = cvt_pk_bf16(sw.O1[0], sw.O1[1]); q2.y = cvt_pk_bf16(sw.O1[2], sw.O1[3]); q2.z = cvt_pk_bf16(sw.O1[4], sw.O1[5]); q2.w = cvt_pk_bf16(sw.O1[6], sw.O1[7]);
        q3.x = cvt_pk_bf16(sw.O1[8], sw.O1[9]); q3.y = cvt_pk_bf16(sw.O1[10], sw.O1[11]); q3.z = cvt_pk_bf16(sw.O1[12], sw.O1[13]); q3.w = cvt_pk_bf16(sw.O1[14], sw.O1[15]);
        *(uint4*)(park) = q0; *(uint4*)(park + 4) = q1; *(uint4*)(park + 8) = q2; *(uint4*)(park + 12) = q3;
    }
#pragma unroll
    for (int v = 0; v < 16; ++v) { sw.O0[v] = 0.f; sw.O1[v] = 0.f; }
    sw.m = 0.f; sw.l = 0.f;
    if (w == 0) {
        for (int q = 0; q < 4; ++q) {
            const bool cand = lane >= 1 && lane <= 30;
            const float sc = cand ? PA[q * 64 + lane] + PB[q * 64 + lane] : -1.f;
            int cnt = 0;
            for (int i = 1; i <= 30; ++i) { const float si = __builtin_bit_cast(float, __builtin_amdgcn_readlane(__builtin_bit_cast(int, sc), i)); cnt += (si > sc || (si == sc && i < lane)) ? 1 : 0; }
            const unsigned long long bal = __ballot(cand && cnt < 13) | 1ull | (1ull << 31) | (1ull << 32);
            if (lane == 0) { SELM[q * 2] = (unsigned)bal; SELM[q * 2 + 1] = (unsigned)(bal >> 32); }
        }
    }
    __syncthreads();
    unsigned long long um = 0ull;
#pragma unroll
    for (int q = 0; q < 4; ++q) um |= (unsigned long long)SELM[q * 2] | ((unsigned long long)SELM[q * 2 + 1] << 32);
    um = ((unsigned long long)__builtin_amdgcn_readfirstlane((unsigned)(um >> 32)) << 32) | (unsigned)__builtin_amdgcn_readfirstlane((unsigned)um);
    while (um) {
        int j = -1;
        for (int k = 0; k < 8 && um; ++k) { const int jj = __ffsll((long long)um) - 1; um &= um - 1ull; if (k == w) j = jj; }
        if (j >= 0) {
            const int page = j < 32 ? p.page_table[req * NPG + (j >> 1)] : 0;
            const float* sbase = j < 32 ? p.cache_slc + ((((size_t)l * NPHYS + page) * 128 + (j & 1) * 64) * 4 + g) * 64 : p.out + O_SLCS + (lr * 4) * 256 + g * 64;
            const int nrow = j < 32 ? 64 : 4;
            as_load_f32<1>(kt, vt, lane, [&](int k) -> const float* { return k < nrow ? sbase + (size_t)k * 256 : nullptr; }, [](int) -> float* { return nullptr; });
        }
        AS_WAVE_SYNC();
        if (j >= 0) {
            const bool sel = (SELM[qi * 2 + (j >> 5)] >> (j & 31)) & 1u;
            const int dl = tq - 64 * j - 4 * h;
            if (j == 32) attn_tile_m<AM_DIAG, true>(kt, ka0, vbase, va_rel, qf, ss, dl, 0.f, bt_r);
            else if (j >= 30) attn_tile_m<AM_NEAR, true>(kt, ka0, vbase, va_rel, qf, ss, dl, sel ? 0.f : -1e30f, bt_r);
            else attn_tile_m<AM_FAR, true>(kt, ka0, vbase, va_rel, qf, ss, dl, sel ? b31 : -1e30f, bt_r);
        }
        AS_WAVE_SYNC();
    }
    if (real) {
        const unsigned* park = (const unsigned*)(lds + AS_PARK + w * 2048) + (h * 16 + (c & 15)) * 16;
        const float2 ml2 = *(const float2*)(lds + AS_PARK2 + w * 256 + (h * 16 + (c & 15)) * 8); sw.m = ml2.x; sw.l = ml2.y;
        const uint4 q0 = *(const uint4*)(park), q1 = *(const uint4*)(park + 4), q2 = *(const uint4*)(park + 8), q3 = *(const uint4*)(park + 12);
        const unsigned u0[8] = {q0.x, q0.y, q0.z, q0.w, q1.x, q1.y, q1.z, q1.w}, u1[8] = {q2.x, q2.y, q2.z, q2.w, q3.x, q3.y, q3.z, q3.w};
#pragma unroll
        for (int v = 0; v < 8; ++v) { sw.O0[2 * v] = __uint_as_float(u0[v] << 16); sw.O0[2 * v + 1] = __uint_as_float(u0[v] & 0xffff0000u); sw.O1[2 * v] = __uint_as_float(u1[v] << 16); sw.O1[2 * v + 1] = __uint_as_float(u1[v] & 0xffff0000u); }
    }
    float* MO = (float*)(lds + w * 16384);
    float* ML = (float*)(lds + w * 16384 + 8192);
    {
        const float lts = ss.l + __shfl_xor(ss.l, 32), ltw = sw.l + __shfl_xor(sw.l, 32);
        if (real) {
#pragma unroll
            for (int dt = 0; dt < 2; ++dt)
#pragma unroll
                for (int qd = 0; qd < 4; ++qd) {
                    const f32x16_t& A = dt ? ss.O1 : ss.O0; const f32x16_t& B = dt ? sw.O1 : sw.O0; const int d = 32 * dt + 8 * qd + 4 * h;
                    *(float4*)(MO + c * 64 + d) = make_float4(A[4 * qd], A[4 * qd + 1], A[4 * qd + 2], A[4 * qd + 3]);
                    *(float4*)(MO + 1024 + c * 64 + d) = make_float4(B[4 * qd], B[4 * qd + 1], B[4 * qd + 2], B[4 * qd + 3]);
                }
            if (h == 0) { ML[c * 2] = ss.m; ML[c * 2 + 1] = lts; ML[32 + c * 2] = sw.m; ML[32 + c * 2 + 1] = ltw; }
        }
    }
    __syncthreads();
    for (int o = tid; o < 1024; o += NTHR) {
        const int cc = o >> 6, d = o & 63, q = cc >> 2, rr = cc & 3; const size_t mr = (size_t)MP + req * 4 + q;
        float res = p.GATES[mr * 24 + g * 4 + rr] * ((const float*)(lds + 0 * 16384))[1024 + cc * 64 + d];
#pragma unroll
        for (int br = 0; br < 2; ++br) {
            float M = -1e30f;
            for (int ww = (br == 1 ? 1 : 0); ww < 8; ++ww) M = fmaxf(M, ((const float*)(lds + ww * 16384 + 8192))[br * 32 + cc * 2]);
            float num = 0.f, den = 0.f;
            for (int ww = (br == 1 ? 1 : 0); ww < 8; ++ww) { const float* ml = (const float*)(lds + ww * 16384 + 8192) + br * 32 + cc * 2; const float f = __builtin_amdgcn_exp2f(ml[0] - M);
                num += f * ((const float*)(lds + ww * 16384))[br * 1024 + cc * 64 + d]; den += f * ml[1]; }
            res += p.GATES[mr * 24 + (br == 0 ? 8 : 16) + g * 4 + rr] * (den > 0.f ? num / den : 0.f);
        }
        p.MIX[mr * D_ + 512 + g * 256 + rr * 64 + d] = f2bf(res);
    }
}

DEV void cmp_prompt_fast(const Prm& p, int l, float* sm) {
    const int tid = opaque_tid(), w = __builtin_amdgcn_readfirstlane(tid >> 6), lane = tid & 63, c = lane & 31, h = lane >> 5;
    for (int wi = (int)blockIdx.x - ((int)gridDim.x >= 256 ? 128 : 0); wi < 128; wi += gridDim.x) {
        if (wi < 0) continue;
        const int ib = wi & 7, type = (wi >> 3) & 1, g = (wi >> 4) & 1, b = wi >> 5;
        const bf16_t* kv = p.KVB + ((((size_t)(0 * 2 + type) * NB_ + b) * 2 + g) * T_) * 64 + 8 * h;
        const bf16_t* wb = p.Wct + (size_t)(l * 2 + type) * 128 * 1024 + (size_t)c * 1024 + 8 * h;
        f32x16_t acc0, acc1;
#pragma unroll
        for (int v = 0; v < 16; ++v) { acc0[v] = 0.f; acc1[v] = 0.f; }
        const int i0 = 32 * ib + c;
#pragma unroll
        for (int l2 = 0; l2 < 2; ++l2) {
            const int ll = 2 * w + l2; const int tlo = 16 * i0 + ll, thi = min(tlo + 16, T_ - 1);
            bf16x8_t fa[4], fb[4], b00[4], b01[4], b10[4], b11[4];
#pragma unroll
            for (int ks = 0; ks < 4; ++ks) {
                fa[ks] = *(const bf16x8_t*)(kv + (size_t)tlo * 64 + ks * 16); fb[ks] = *(const bf16x8_t*)(kv + (size_t)thi * 64 + ks * 16);
                const bf16_t* wk = wb + ll * 64 + ks * 16;
                b00[ks] = *(const bf16x8_t*)(wk); b01[ks] = *(const bf16x8_t*)(wk + 32 * 1024); b10[ks] = *(const bf16x8_t*)(wk + 64 * 1024); b11[ks] = *(const bf16x8_t*)(wk + 96 * 1024);
            }
#pragma unroll
            for (int ks = 0; ks < 4; ++ks) {
                acc0 = __builtin_amdgcn_mfma_f32_32x32x16_bf16(fa[ks], b00[ks], acc0, 0, 0, 0);
                acc1 = __builtin_amdgcn_mfma_f32_32x32x16_bf16(fa[ks], b01[ks], acc1, 0, 0, 0);
                acc0 = __builtin_amdgcn_mfma_f32_32x32x16_bf16(fb[ks], b10[ks], acc0, 0, 0, 0);
                acc1 = __builtin_amdgcn_mfma_f32_32x32x16_bf16(fb[ks], b11[ks], acc1, 0, 0, 0);
            }
        }
        __syncthreads();
        float* part = sm + w * 2048;
#pragma unroll
        for (int v = 0; v < 16; ++v) { const int i = (v & 3) + 8 * (v >> 2) + 4 * h; part[i * 64 + c] = acc0[v]; part[i * 64 + 32 + c] = acc1[v]; }
        __syncthreads();
        bf16_t* o = p.KC + ((((size_t)b * 2 + g) * 2 + type) * 256 + 32 * ib) * 64;
#pragma unroll
        for (int q = 0; q < 4; ++q) { const int idx = tid + NTHR * q, i = idx >> 6, e = idx & 63; float a = cb_val(p.cb, (l * 2 + type) * 64 + e);
#pragma unroll
            for (int ww = 0; ww < 8; ++ww) a += sm[ww * 2048 + idx];
            o[idx] = (32 * ib + i) == 255 ? (bf16_t)0 : f2bf(a); }
    }
}
DEV void phase_mix1(const Prm& p, int l, float* sm) {
    cmp_prompt_fast(p, l, sm);
    for (int item = blockIdx.x; item < 512 + NREQ; item += gridDim.x) convpool_item(p, l, item, sm);
}
DEV void phase_attn(const Prm& p, int l, float* sm) {
    const int spos = (int)(blockIdx.x % 3u);
    for (int k = blockIdx.x; k < 256; k += gridDim.x) {
        const int bg = k >> 5, pi = k & 31;
#pragma unroll 1
        for (int s = 0; s < 3; ++s) {
            const int what = s == spos ? 2 : (s < spos ? s : s - 1);
            if (what == 2) attn_sample_item(p, l, k >> 1, k & 1, (unsigned char*)sm);
            else attn_prompt_unit(p, l, bg >> 1, bg & 1, what == 0 ? 63 - pi : pi, (unsigned char*)sm);
        }
    }
}
DEV void phase_final(const Prm& p) {
    const int tid = opaque_tid(), wv = tid >> 6, lane = tid & 63;
    float4 g[4];
#pragma unroll
    for (int i = 0; i < 4; ++i) g[i] = *(const float4*)(p.final_norm + i * 256 + lane * 4);
    for (int m0 = (blockIdx.x * 8 + wv) * 2; m0 < MP; m0 += gridDim.x * 16) {
        uint2 v[2][4]; float rs[2];
#pragma unroll
        for (int rr = 0; rr < 2; ++rr) { rs[rr] = row_rs(p.SSb, m0 + rr);
#pragma unroll
            for (int i = 0; i < 4; ++i) v[rr][i] = *(const uint2*)(p.XB + (size_t)(m0 + rr) * D_ + i * 256 + lane * 4); }
#pragma unroll
        for (int rr = 0; rr < 2; ++rr)
#pragma unroll
            for (int i = 0; i < 4; ++i) { const uint2 a = v[rr][i]; const float r = rs[rr];
                const float x0 = __uint_as_float(a.x << 16), x1 = __uint_as_float(a.x & 0xffff0000u), x2 = __uint_as_float(a.y << 16), x3 = __uint_as_float(a.y & 0xffff0000u);
                *(float4*)(p.out + (size_t)(m0 + rr) * D_ + i * 256 + lane * 4) = make_float4(x0 * r * g[i].x, x1 * r * g[i].y, x2 * r * g[i].z, x3 * r * g[i].w); }
    }
}

enum { PH_PREP = 0, PH_IN, PH_MIX1, PH_ATTN, PH_OUT, PH_GU, PH_DOWN, PH_FINAL, PH_DOWNR };
template <int PH> DEV void run_phase(const Prm& p, int l, unsigned char* lds) {
    float* sm = (float*)lds;
    if constexpr (PH == PH_PREP) phase_prep(p, sm);
    if constexpr (PH == PH_IN) { EpiIn e{p, l, nullptr};
        const bool cf = l == 0 && (blockIdx.x & 1);
        if (cf) cmp_sample_fast(p, 0, lds);
        gemm_fast(lds, p.XB, p.Wt_in + (size_t)l * NIN * D_, M_, NIN, D_, e);
        if (l == 0 && !cf) cmp_sample_fast(p, 0, lds);
        if (l == 0) { const int nfull = (M_ / 256) * (NIN / 256) % (int)gridDim.x; if ((int)blockIdx.x >= nfull) prep_weights(p, sm, 576 / 4, 2944 / 4, (int)blockIdx.x - nfull, (int)gridDim.x - nfull); } }
    if constexpr (PH == PH_MIX1) phase_mix1(p, l, sm);
    if constexpr (PH == PH_ATTN) phase_attn(p, l, sm);
    if constexpr (PH == PH_OUT) { EpiRes e{p, 1, p.SSa, true}; gemm_fast(lds, p.MIX, p.Wt_out + (size_t)l * D_ * D_, M_, D_, D_, e);
        if (l == 0 && blockIdx.x >= 8) prep_weights(p, sm, 2944 / 4, 2 * 2944 / 4, (int)blockIdx.x - 8, (int)gridDim.x - 8); }
    if constexpr (PH == PH_GU) { EpiGU e{p, nullptr}; gemm_fast(lds, p.XB, p.Wt_gu + (size_t)l * NGU * D_, M_, NGU, D_, e); }
    if constexpr (PH == PH_DOWN) { EpiRes e{p, 2, p.SSb, l + 1 < NL_}; const bf16_t* W = p.Wt_down + (size_t)l * D_ * DFF;
        const bool cf = l == 0 && (blockIdx.x & 1);
        if (cf) cmp_sample_fast(p, 1, lds);
        gemm_fast(lds, p.ACT, W, MP, D_, DFF, e);
        gemm_split(lds, p.ACT, W, D_, DFF, 256, p.SLAB);
        if (l == 0 && !cf) cmp_sample_fast(p, 1, lds); }
    if constexpr (PH == PH_FINAL) phase_final(p);
    if constexpr (PH == PH_DOWNR) { if (l + 1 < NL_) { EpiRes e{p, 2, p.SSb, true}; gemm_reduce(p.SLAB, D_, DFF / 256, e); } else gemm_reduce_final(p, p.SLAB, DFF / 256); }
}
template <int PH> __global__ void __launch_bounds__(NTHR, 2) k_phase(Prm p, int l) {
    extern __shared__ __attribute__((aligned(16))) unsigned char lds[];
    run_phase<PH>(p, l, lds);
}
__global__ void __launch_bounds__(NTHR, 2) k_mega(Prm p) {
    extern __shared__ __attribute__((aligned(16))) unsigned char lds[];
    if (threadIdx.x == 0) *(uint4*)(lds + LDS_BYTES - 16) = make_uint4(0u, 0u, 0u, 0u);
    __syncthreads();
    const XcdBarrier bar = xcd_barrier_post(p.bar, (volatile LAS unsigned*)(lds + LDS_BYTES - 16));
    run_phase<PH_PREP>(p, 0, lds); xcd_barrier(bar);
#define LAYER(l) do { run_phase<PH_IN>(p, l, lds); xcd_barrier(bar); run_phase<PH_MIX1>(p, l, lds); xcd_barrier(bar); run_phase<PH_ATTN>(p, l, lds); xcd_barrier(bar); \
        run_phase<PH_OUT>(p, l, lds); xcd_barrier(bar); run_phase<PH_GU>(p, l, lds); xcd_barrier(bar); run_phase<PH_DOWN>(p, l, lds); xcd_barrier(bar); run_phase<PH_DOWNR>(p, l, lds); } while (0)
    LAYER(0); xcd_barrier(bar); LAYER(1);
#undef LAYER
    run_phase<PH_FINAL>(p, 0, lds);
}

constexpr bool ONE_LAUNCH = true;
static size_t carve(size_t& off, size_t bytes) { const size_t o = off; off += (bytes + 255) & ~(size_t)255; return o; }
template <int PH> static void launch_phase(const Prm& p, int l, int grid, hipStream_t stream) {
    static bool attr = false;
    if (!attr) { (void)hipFuncSetAttribute((const void*)k_phase<PH>, hipFuncAttributeMaxDynamicSharedMemorySize, LDS_BYTES); attr = true; }
    hipLaunchKernelGGL(k_phase<PH>, dim3(grid), dim3(NTHR), LDS_BYTES, stream, p, l);
}
extern "C" void kernel_launch(void* const* d_in, const int* in_sizes, int n_in, void* d_out, int out_size, void* d_ws, size_t ws_size, hipStream_t stream) {
    Prm p{};
    p.x_prompt = (const float*)d_in[0]; p.x_sample = (const float*)d_in[1]; p.cache_cmp = (const float*)d_in[2]; p.cache_slc = (const float*)d_in[3]; p.cache_win = (const float*)d_in[4];
    p.state_conv = (const float*)d_in[5]; p.state_pool = (const float*)d_in[6]; p.page_table = (const int*)d_in[7]; p.rel_bias = (const float*)d_in[8]; p.norm1 = (const float*)d_in[9];
    p.w_in = (const float*)d_in[10]; p.conv_dw = (const float*)d_in[11]; p.conv_b = (const float*)d_in[12]; p.conv_ln_g = (const float*)d_in[13]; p.conv_ln_b = (const float*)d_in[14];
    p.pool_w = (const float*)d_in[15]; p.pool_scale = (const float*)d_in[16]; p.pe_k = (const float*)d_in[17]; p.wk = (const float*)d_in[18]; p.pe_v = (const float*)d_in[19]; p.wv = (const float*)d_in[20];
    p.w_out = (const float*)d_in[21]; p.norm2 = (const float*)d_in[22]; p.w_gu = (const float*)d_in[23]; p.w_down = (const float*)d_in[24]; p.final_norm = (const float*)d_in[25];
    p.out = (float*)d_out;
    char* ws = (char*)d_ws; size_t off = 0;
    p.bar = (unsigned*)(ws + carve(off, 16384));
    p.Wt_in = (bf16_t*)(ws + carve(off, (size_t)NL_ * NIN * D_ * 2)); p.Wt_out = (bf16_t*)(ws + carve(off, (size_t)NL_ * D_ * D_ * 2));
    p.Wt_gu = (bf16_t*)(ws + carve(off, (size_t)NL_ * NGU * D_ * 2)); p.Wt_down = (bf16_t*)(ws + carve(off, (size_t)NL_ * D_ * DFF * 2));
    p.Wct = (bf16_t*)(ws + carve(off, (size_t)2 * 2 * 128 * 1024 * 2)); p.cb = (float*)(ws + carve(off, 4 * 256 * 4));
    p.XB = (bf16_t*)(ws + carve(off, (size_t)M_ * D_ * 2)); p.SSa = (float*)(ws + carve(off, (size_t)M_ * 16 * 4)); p.SSb = (float*)(ws + carve(off, (size_t)M_ * 16 * 4));
    p.G = (float*)(ws + carve(off, (size_t)M_ * 256 * 4)); p.U = (float*)(ws + carve(off, (size_t)M_ * 256 * 4));
    p.Q = (bf16_t*)(ws + carve(off, (size_t)M_ * 512 * 2)); p.KVB = (bf16_t*)(ws + carve(off, (size_t)3 * 2 * NB_ * 2 * T_ * 64 * 2));
    p.GATES = (float*)(ws + carve(off, (size_t)M_ * 24 * 4));
    p.KC = (bf16_t*)(ws + carve(off, (size_t)NB_ * 2 * 2 * 256 * 64 * 2)); p.KCS = (bf16_t*)(ws + carve(off, (size_t)NL_ * NREQ * 2 * 2 * 128 * 64 * 2));
    p.MIX = (bf16_t*)(ws + carve(off, (size_t)M_ * D_ * 2)); p.X1 = (float*)(ws + carve(off, (size_t)M_ * D_ * 4)); p.X2 = (float*)(ws + carve(off, (size_t)M_ * D_ * 4));
    p.ACT = (bf16_t*)(ws + carve(off, (size_t)M_ * DFF * 2)); p.BIASL2 = (float*)(ws + carve(off, 1024 * 4)); p.SLAB = (float*)(ws + carve(off, (size_t)11 * MS * D_ * 4));
    if (off > ws_size || out_size != (int)O_END) { fprintf(stderr, "kernel_launch: bad sizes (ws %zu need %zu, out %d expect %zu)\n", ws_size, off, out_size, (size_t)O_END); return; }
    static int grid = 0;
    if (!grid) {
        int dev = 0, cus = 0, per_cu = 0;
        (void)hipGetDevice(&dev); (void)hipDeviceGetAttribute(&cus, hipDeviceAttributeMultiprocessorCount, dev);
        (void)hipFuncSetAttribute((const void*)k_mega, hipFuncAttributeMaxDynamicSharedMemorySize, LDS_BYTES);
        (void)hipOccupancyMaxActiveBlocksPerMultiprocessor(&per_cu, (const void*)k_mega, NTHR, LDS_BYTES);
        if (per_cu < 1) fprintf(stderr, "kernel_launch: occupancy query reports %d workgroups per CU\n", per_cu);
        grid = cus > 0 ? cus : 256;
    }
    (void)hipMemsetAsync(p.bar, 0, XCD_BAR_WORDS * sizeof(unsigned), stream);
    if (ONE_LAUNCH) {
        hipLaunchKernelGGL(k_mega, dim3(grid), dim3(NTHR), LDS_BYTES, stream, p);
    } else {
        launch_phase<PH_PREP>(p, 0, grid, stream);
        for (int l = 0; l < NL_; ++l) {
            launch_phase<PH_IN>(p, l, grid, stream); launch_phase<PH_MIX1>(p, l, grid, stream); launch_phase<PH_ATTN>(p, l, grid, stream);
            launch_phase<PH_OUT>(p, l, grid, stream); launch_phase<PH_GU>(p, l, grid, stream); launch_phase<PH_DOWN>(p, l, grid, stream); launch_phase<PH_DOWNR>(p, l, grid, stream);
        }
        launch_phase<PH_FINAL>(p, 0, grid, stream);
    }
}
```

```cpp
#include <hip/hip_runtime.h>
#include <stdint.h>
#include <stdio.h>

typedef unsigned short bf16_t;
#define DEV __device__ __forceinline__

constexpr int D_ = 1024, NB_ = 4, T_ = 4096, NL_ = 2, NREQ = 128, NS_ = 4, PAST_ = 2048, NPG = 16, NPHYS = 2560;
constexpr int MP = NB_ * T_, MS = NREQ * NS_, M_ = MP + MS;
constexpr int NIN = 2304, DFF = 2816, NGU = 5632, INW = 2072;
constexpr float QSCALE = 0.18033688011112042f;
constexpr float LOG2E = 1.4426950408889634f;

constexpr size_t O_YP = 0, O_YS = O_YP + (size_t)MP * D_, O_CMPP = O_YS + (size_t)MS * D_, O_SLCP = O_CMPP + (size_t)NL_ * NB_ * T_ * 256,
                 O_WINP = O_SLCP + (size_t)NL_ * NB_ * T_ * 256, O_CONVP = O_WINP + (size_t)NL_ * NB_ * 512 * 256, O_POOLP = O_CONVP + (size_t)NL_ * NB_ * 30 * 256,
                 O_CMPS = O_POOLP + (size_t)NL_ * NB_ * 15 * 256, O_SLCS = O_CMPS + (size_t)NL_ * NREQ * 4 * 256, O_WINS = O_SLCS + (size_t)NL_ * NREQ * 4 * 256,
                 O_CONVS = O_WINS + (size_t)NL_ * NREQ * 512 * 256, O_POOLS = O_CONVS + (size_t)NL_ * NREQ * 30 * 256, O_END = O_POOLS + (size_t)NL_ * NREQ * 15 * 256;

__device__ const unsigned char kBucket[128] = {0, 1, 2, 3, 4, 5, 6, 7, 8, 9, 10, 11, 12, 13, 14, 15, 16, 16, 16, 17, 17, 18, 18, 18, 19, 19, 19, 20, 20, 20, 20, 21, 21, 21, 21, 22, 22, 22, 22, 22, 23, 23, 23, 23, 23, 23, 24, 24, 24, 24, 24, 24, 25, 25, 25, 25, 25, 25, 25, 26, 26, 26, 26, 26, 26, 26, 26, 27, 27, 27, 27, 27, 27, 27, 27, 27, 27, 28, 28, 28, 28, 28, 28, 28, 28, 28, 28, 29, 29, 29, 29, 29, 29, 29, 29, 29, 29, 29, 29, 30, 30, 30, 30, 30, 30, 30, 30, 30, 30, 30, 30, 30, 30, 31, 31, 31, 31, 31, 31, 31, 31, 31, 31, 31, 31, 31, 31, 31};

struct Prm {
    const float *x_prompt, *x_sample, *cache_cmp, *cache_slc, *cache_win, *state_conv, *state_pool;
    const int* page_table;
    const float *rel_bias, *norm1, *w_in, *conv_dw, *conv_b, *conv_ln_g, *conv_ln_b, *pool_w, *pool_scale, *pe_k, *wk, *pe_v, *wv, *w_out, *norm2, *w_gu, *w_down, *final_norm;
    float* out;
    unsigned* bar;
    bf16_t *Wt_in, *Wt_out, *Wt_gu, *Wt_down, *Wct;
    float* cb;
    bf16_t* XB;
    float *SSa, *SSb, *G, *U;
    bf16_t *Q, *KVB;
    float* GATES;
    bf16_t *KC, *KCS, *MIX;
    float *X1, *X2;
    bf16_t* ACT;
    float* BIASL2;
    float* SLAB;
};

DEV int opaque_tid() { int t = threadIdx.x; asm volatile("" : "+v"(t)); return t; }
DEV float bf2f(bf16_t v) { return __uint_as_float((unsigned)v << 16); }
DEV bf16_t f2bf(float f) { unsigned u = __float_as_uint(f); u += 0x7fffu + ((u >> 16) & 1u); return (bf16_t)(u >> 16); }
DEV unsigned cvt_pk_bf16(float lo, float hi) { unsigned r; asm("v_cvt_pk_bf16_f32 %0, %1, %2\n\ts_nop 1" : "=v"(r) : "v"(lo), "v"(hi)); return r; }
DEV unsigned pack2(float a, float b) { return cvt_pk_bf16(a, b); }
DEV float wave_sum(float v) { for (int o = 32; o > 0; o >>= 1) v += __shfl_xor(v, o); return v; }
DEV float wave_max(float v) { for (int o = 32; o > 0; o >>= 1) v = fmaxf(v, __shfl_xor(v, o)); return v; }
DEV float sigmoidf_(float x) { return __builtin_amdgcn_rcpf(1.f + __builtin_amdgcn_exp2f(-1.4426950408889634f * x)); }

constexpr int NTHR = 512;
constexpr int LDS_BYTES = 159744;

#define XB_TMO      128
#define XB_XCNT(j)  (256  + 64 * (j))
#define XB_XSUB(j)  (1280 + 64 * (j))
#define XB_XGEN(j)  (2304 + 64 * (j))
#define XB_TOP      3328
#define XB_TOPGEN   3392
#define XCD_BAR_WORDS 3456
#define XB_SPIN_CAP (1u << 24)
#define LAS __attribute__((address_space(3)))
__device__ __forceinline__ unsigned xb_ld(unsigned* p)              { return __hip_atomic_load(p, __ATOMIC_RELAXED, __HIP_MEMORY_SCOPE_AGENT); }
__device__ __forceinline__ unsigned xb_add(unsigned* p, unsigned v) { return __hip_atomic_fetch_add(p, v, __ATOMIC_RELAXED, __HIP_MEMORY_SCOPE_AGENT); }
__device__ __forceinline__ unsigned xb_xcc_id() { return (unsigned)__builtin_amdgcn_s_getreg((3 << 11) | 20) & 0xFu; }
#define XB_SPIN(cond, bar) do { unsigned _sp = 0; while (cond) { __builtin_amdgcn_s_sleep(1); \
    if ((++_sp & 255u) == 0u) { if (xb_ld(&(bar)[XB_TMO])) break; if (_sp > XB_SPIN_CAP) { atomicAdd(&(bar)[XB_TMO], 1u); break; } } } } while (0)
struct XcdBarrier { unsigned* bar; unsigned x; volatile LAS unsigned* st; };
__device__ __forceinline__ XcdBarrier xcd_barrier_post(unsigned* bar, volatile LAS unsigned* st) {
    XcdBarrier b; b.bar = bar; b.x = xb_xcc_id(); b.st = st;
    if (threadIdx.x == 0) (void)xb_add(&bar[XB_XCNT(b.x)], 1u);
    return b;
}
__device__ __forceinline__ void xcd_barrier_complete(unsigned* bar, unsigned x, unsigned& nloc, unsigned& nx) {
    const unsigned G = gridDim.x * gridDim.y * gridDim.z;
    unsigned sum, cnt, mine, sp = 0u;
    for (;;) {
        sum = 0u; cnt = 0u; mine = 0u;
#pragma unroll
        for (unsigned j = 0; j < 16; ++j) { const unsigned c = xb_ld(&bar[XB_XCNT(j)]); sum += c; cnt += (c > 0u) ? 1u : 0u; mine = (j == x) ? c : mine; }
        if (sum == G) break;
        __builtin_amdgcn_s_sleep(1);
        if ((++sp & 255u) == 0u) { if (xb_ld(&bar[XB_TMO])) break; if (sp > XB_SPIN_CAP) { atomicAdd(&bar[XB_TMO], 1u); break; } }
    }
    nloc = mine > 0u ? mine : 1u; nx = cnt > 0u ? cnt : 1u;
}
__device__ __forceinline__ void xcd_barrier(const XcdBarrier& b) {
    asm volatile("s_waitcnt vmcnt(0)" ::: "memory");
    __syncthreads();
    if (threadIdx.x == 0) {
        unsigned* bar = b.bar;
        __builtin_amdgcn_s_waitcnt(0);
        unsigned nloc = b.st[0], nx = b.st[1];
        if (nloc == 0u) { xcd_barrier_complete(bar, b.x, nloc, nx); b.st[0] = nloc; b.st[1] = nx; }
        const unsigned old = xb_add(&bar[XB_XSUB(b.x)], 1u);
        const unsigned gen = old / nloc;
        if (old + 1u == (gen + 1u) * nloc) {
            __builtin_amdgcn_fence(__ATOMIC_RELEASE, "agent");
            asm volatile("s_waitcnt vmcnt(0)" ::: "memory");
            const unsigned og = xb_add(&bar[XB_TOP], 1u);
            const unsigned tg = og / nx;
            if (og + 1u == (tg + 1u) * nx) xb_add(&bar[XB_TOPGEN], 1u);
            else XB_SPIN(xb_ld(&bar[XB_TOPGEN]) == tg, bar);
            __builtin_amdgcn_fence(__ATOMIC_ACQUIRE, "agent");
            xb_add(&bar[XB_XGEN(b.x)], 1u);
            asm volatile("s_waitcnt vmcnt(0)" ::: "memory");
        } else {
            XB_SPIN(xb_ld(&bar[XB_XGEN(b.x)]) == gen, bar);
            __builtin_amdgcn_fence(__ATOMIC_ACQUIRE, "agent");
            asm volatile("s_waitcnt vmcnt(0)" ::: "memory");
        }
    }
    __syncthreads();
}

DEV int srccol(int mode, int n) {
    if (mode == 0) { if (n < 512) { const int t = n >> 8, j = n & 255; return j < 128 ? 128 * t + j : 256 + 128 * t + (j - 128); } return n < INW ? n : -1; }
    if (mode == 2) { const int t = n >> 8, j = n & 255; return j < 128 ? 128 * t + j : DFF + 128 * t + (j - 128); }
    return n;
}
#define WDESC(tg) \
    const int l_ = (tg) / TPL, r_ = (tg) % TPL, which = r_ < 576 ? 0 : (r_ < 832 ? 1 : (r_ < 2240 ? 2 : 3)), tl = r_ - (which == 0 ? 0 : (which == 1 ? 576 : (which == 2 ? 832 : 2240))); \
    const float* src = which == 0 ? p.w_in + (size_t)l_ * D_ * INW : (which == 1 ? p.w_out + (size_t)l_ * D_ * D_ : (which == 2 ? p.w_gu + (size_t)l_ * D_ * NGU : p.w_down + (size_t)l_ * DFF * D_)); \
    const float* gain = which == 0 ? p.norm1 + l_ * D_ : (which == 2 ? p.norm2 + l_ * D_ : nullptr); \
    bf16_t* dst = which == 0 ? p.Wt_in + (size_t)l_ * NIN * D_ : (which == 1 ? p.Wt_out + (size_t)l_ * D_ * D_ : (which == 2 ? p.Wt_gu + (size_t)l_ * NGU * D_ : p.Wt_down + (size_t)l_ * D_ * DFF)); \
    const int K = which == 3 ? DFF : D_, Ns = which == 0 ? INW : (which == 2 ? NGU : D_), ntn = which == 0 ? NIN / 64 : (which == 2 ? NGU / 64 : D_ / 64), mode = which == 0 ? 0 : (which == 2 ? 2 : 1); \
    const int n0 = (tl % ntn) * 64, k0 = (tl / ntn) * 64;
DEV void prep_weights(const Prm& p, float* sm, int vb_first, int vb_end, int bidx, int nblk) {
    const int tid = opaque_tid();
    constexpr int TPL = (NIN / 64) * 16 + 16 * 16 + (NGU / 64) * 16 + 16 * (DFF / 64);
    static_assert(TPL == 2944, "tile counts");
    for (int vb = vb_first + bidx; vb < vb_end; vb += nblk) {
        float4 v[8];
#pragma unroll
        for (int q = 0; q < 4; ++q) {
            WDESC(vb * 4 + q)
#pragma unroll
            for (int i = 0; i < 2; ++i) { const int idx = tid + 512 * i, k = idx >> 4, n4 = (idx & 15) * 4; const int sc = srccol(mode, n0 + n4);
                float4 x = make_float4(0.f, 0.f, 0.f, 0.f);
                if (sc >= 0) { x = *(const float4*)(src + (size_t)(k0 + k) * Ns + sc); if (gain) { const float gk = gain[k0 + k]; x.x *= gk; x.y *= gk; x.z *= gk; x.w *= gk; } }
                v[q * 2 + i] = x; }
            (void)dst; (void)K;
        }
        __syncthreads();
#pragma unroll
        for (int q = 0; q < 4; ++q)
#pragma unroll
            for (int i = 0; i < 2; ++i) { const int idx = tid + 512 * i, k = idx >> 4, n4 = (idx & 15) * 4; float* t = sm + q * (64 * 65) + k * 65 + n4; t[0] = v[q * 2 + i].x; t[1] = v[q * 2 + i].y; t[2] = v[q * 2 + i].z; t[3] = v[q * 2 + i].w; }
        __syncthreads();
#pragma unroll
        for (int q = 0; q < 4; ++q) {
            WDESC(vb * 4 + q)
            const int k8 = tid & 7, n = tid >> 3; const float* t = sm + q * (64 * 65) + (8 * k8) * 65 + n;
            uint4 w; w.x = pack2(t[0], t[65]); w.y = pack2(t[130], t[195]); w.z = pack2(t[260], t[325]); w.w = pack2(t[390], t[455]);
            *(uint4*)(dst + (size_t)(n0 + n) * K + k0 + 8 * k8) = w;
            (void)src; (void)gain; (void)Ns; (void)mode;
        }
    }
}
#undef WDESC
DEV float cb_val(const float* cb, int i) { return ((cb[i] + cb[256 + i]) + cb[512 + i]) + cb[768 + i]; }
DEV void phase_prep(const Prm& p, float* sm) {
    const int tid = opaque_tid(); const size_t gt = (size_t)blockIdx.x * NTHR + tid, gn = (size_t)gridDim.x * NTHR;
    for (size_t base = gt; base < (size_t)2 * 2 * 128 * 1024; base += gn * 4) {
        float v[4];
#pragma unroll
        for (int i = 0; i < 4; ++i) { const size_t idx = base + gn * i; v[i] = 0.f;
            if (idx < (size_t)2 * 2 * 128 * 1024) { const int k = idx & 1023, n = (idx >> 10) & 127, type = (idx >> 17) & 1, l = (int)(idx >> 18);
                const float* src = (type ? p.wv : p.wk) + (size_t)l * 32 * 64 * 64; const int half = n >> 6, e = n & 63; v[i] = src[(size_t)(half * 1024 + k) * 64 + e]; } }
#pragma unroll
        for (int i = 0; i < 4; ++i) { const size_t idx = base + gn * i; if (idx < (size_t)2 * 2 * 128 * 1024) p.Wct[idx] = f2bf(v[i]); }
    }
    if ((int)blockIdx.x >= (int)gridDim.x - 16) {
        const int wq = (int)blockIdx.x - ((int)gridDim.x - 16), lt = wq >> 2, qk = wq & 3, l = lt >> 1, type = lt & 1, e = tid & 63, kq = tid >> 6;
        const float* w = (type ? p.wv : p.wk) + (size_t)l * 32 * 64 * 64; const float* pe = (type ? p.pe_v : p.pe_k) + (size_t)l * 32 * 64;
        float acc = 0.f;
#pragma unroll 1
        for (int k0 = qk * 512 + kq * 64; k0 < qk * 512 + kq * 64 + 64; k0 += 64) {
            float wv[64];
#pragma unroll
            for (int i = 0; i < 64; ++i) wv[i] = w[(size_t)(k0 + i) * 64 + e];
#pragma unroll
            for (int i = 0; i < 64; ++i) acc += pe[k0 + i] * wv[i];
        }
        sm[tid] = acc; __syncthreads();
        if (tid < 64) { float a = 0.f; for (int q = 0; q < 8; ++q) a += sm[q * 64 + tid]; p.cb[qk * 256 + lt * 64 + tid] = a; }
        __syncthreads(); }
    if (gt < 1024) { const int dist = (int)gt & 127, gr = (int)gt >> 7; p.BIASL2[gt] = p.rel_bias[kBucket[dist] * 8 + gr] * LOG2E; }
    {
        const int wv = tid >> 6, lane = tid & 63;
        for (int m0 = (blockIdx.x * 8 + wv) * 2; m0 < M_; m0 += gridDim.x * 16) {
            float4 v[2][4];
#pragma unroll
            for (int rr = 0; rr < 2; ++rr) { const int m = m0 + rr; const float* x = m < MP ? p.x_prompt + (size_t)m * D_ : p.x_sample + (size_t)(m - MP) * D_;
#pragma unroll
                for (int i = 0; i < 4; ++i) v[rr][i] = *(const float4*)(x + i * 256 + lane * 4); }
#pragma unroll
            for (int rr = 0; rr < 2; ++rr) { const int m = m0 + rr; float sq = 0.f;
#pragma unroll
                for (int i = 0; i < 4; ++i) { const float4 a = v[rr][i]; sq += (a.x * a.x + a.y * a.y) + (a.z * a.z + a.w * a.w); uint2 w; w.x = pack2(a.x, a.y); w.y = pack2(a.z, a.w); *(uint2*)(p.XB + (size_t)m * D_ + i * 256 + lane * 4) = w; }
                sq = wave_sum(sq);
                if (lane < 16) p.SSb[(size_t)m * 16 + lane] = lane == 0 ? sq : 0.f; }
        }
    }
    prep_weights(p, sm, 0, 576 / 4, (int)blockIdx.x, (int)gridDim.x);
}
DEV float row_rs(const float* SS, int m) {
    const float4* q = (const float4*)(SS + (size_t)m * 16); const float4 a = q[0], b = q[1], c = q[2], d = q[3];
    float s = 0.f; s += a.x; s += a.y; s += a.z; s += a.w; s += b.x; s += b.y; s += b.z; s += b.w; s += c.x; s += c.y; s += c.z; s += c.w; s += d.x; s += d.y; s += d.z; s += d.w;
    return rsqrtf(s * (1.f / 1024.f) + 1e-6f); }
DEV void st8f(float* dst, const float (&v)[8]) { *(float4*)dst = make_float4(v[0], v[1], v[2], v[3]); *(float4*)(dst + 4) = make_float4(v[4], v[5], v[6], v[7]); }
DEV void st8b(bf16_t* dst, const float (&v)[8]) { uint4 w; w.x = pack2(v[0], v[1]); w.y = pack2(v[2], v[3]); w.z = pack2(v[4], v[5]); w.w = pack2(v[6], v[7]); *(uint4*)dst = w; }

struct EpiIn {
    static constexpr bool HAS_SS = false, USE_RS = true, HAS_AUX = false;
    const Prm& p; int l; float* ss;
    DEV const float* ss_src() const { return p.SSb; }
    DEV float apply(int m, int pn, int j, const float (&lo_)[8], const float (&hi_)[8], float rs) const {
        float lo[8], hi[8];
#pragma unroll
        for (int i = 0; i < 8; ++i) { lo[i] = lo_[i] * rs; hi[i] = hi_[i] * rs; }
        const bool samp = m >= MP; const int b = m / T_, t = m % T_, req = (m - MP) >> 2, s = (m - MP) & 3;
        if (pn < 2) {
            float g[8];
#pragma unroll
            for (int i = 0; i < 8; ++i) g[i] = lo[i] * sigmoidf_(hi[i]);
            const int c = 128 * pn + j;
            st8f(p.G + (size_t)m * 256 + c, g);
            if (!samp) { if (t >= T_ - 30) st8f(p.out + O_CONVP + ((size_t)(l * NB_ + b) * 30 + (t - (T_ - 30))) * 256 + c, g); }
            else st8f(p.out + O_CONVS + ((size_t)(l * NREQ + req) * 30 + 26 + s) * 256 + c, g);
        } else if (pn == 2) {
            st8f(p.U + (size_t)m * 256 + j, lo); st8f(p.U + (size_t)m * 256 + 128 + j, hi);
            if (!samp) { if (t >= T_ - 15) { float* o = p.out + O_POOLP + ((size_t)(l * NB_ + b) * 15 + (t - (T_ - 15))) * 256; st8f(o + j, lo); st8f(o + 128 + j, hi); } }
            else { float* o = p.out + O_POOLS + ((size_t)(l * NREQ + req) * 15 + 11 + s) * 256; st8f(o + j, lo); st8f(o + 128 + j, hi); }
        } else if (pn < 5) {
            const int g = pn - 3; float a[8], c[8];
#pragma unroll
            for (int i = 0; i < 8; ++i) { a[i] = lo[i] * QSCALE; c[i] = hi[i] * QSCALE; }
            st8b(p.Q + (size_t)m * 512 + g * 256 + j, a); st8b(p.Q + (size_t)m * 512 + g * 256 + 128 + j, c);
        } else if (pn < 8) {
            const int br = pn - 5, g = j >> 6, d = j & 63;
            long long oo;
            if (!samp) oo = br == 0 ? (long long)(O_CMPP + ((size_t)(l * NB_ + b) * T_ + t) * 256) : (br == 1 ? (long long)(O_SLCP + ((size_t)(l * NB_ + b) * T_ + t) * 256)
                          : (t >= T_ - 512 ? (long long)(O_WINP + ((size_t)(l * NB_ + b) * 512 + (t - (T_ - 512))) * 256) : -1ll));
            else oo = br == 0 ? (long long)(O_CMPS + ((size_t)(l * NREQ + req) * 4 + s) * 256) : (br == 1 ? (long long)(O_SLCS + ((size_t)(l * NREQ + req) * 4 + s) * 256)
                          : (long long)(O_WINS + ((size_t)(l * NREQ + req) * 512 + 508 + s) * 256));
            if (oo >= 0) { st8f(p.out + oo + j, lo); st8f(p.out + oo + 128 + j, hi); }
            if (!samp) {
                bf16_t* kb = p.KVB + ((((size_t)(br * 2) * NB_ + b) * 2 + g) * T_ + t) * 64 + d;
                st8b(kb, lo); st8b(kb + (size_t)NB_ * 2 * T_ * 64, hi);
            }
        } else {
            if (j < 24) {
#pragma unroll
                for (int i = 0; i < 8; ++i) p.GATES[(size_t)m * 24 + j + i] = sigmoidf_(lo[i]);
            }
        }
        return 0.f;
    }
};
struct EpiRes {
    static constexpr bool HAS_SS = true, USE_RS = false, HAS_AUX = true;
    const Prm& p; int mode;
    float* ss; bool keep_f32;
    struct Aux { float4 r0, r1, r2, r3; };
    DEV Aux fetch(int m, int pn, int j) const {
        const int c = pn * 256 + j; Aux a;
        if (mode == 0) {
            const float* rb = (m < MP ? p.x_prompt + (size_t)m * D_ : p.x_sample + (size_t)(m - MP) * D_) + c;
            a.r0 = *(const float4*)(rb); a.r1 = *(const float4*)(rb + 4); a.r2 = *(const float4*)(rb + 128); a.r3 = *(const float4*)(rb + 132);
        } else {
            const bf16_t* rb = p.XB + (size_t)m * D_ + c; const uint4 u = *(const uint4*)rb, v = *(const uint4*)(rb + 128);
            a.r0 = make_float4(__uint_as_float(u.x << 16), __uint_as_float(u.x & 0xffff0000u), __uint_as_float(u.y << 16), __uint_as_float(u.y & 0xffff0000u));
            a.r1 = make_float4(__uint_as_float(u.z << 16), __uint_as_float(u.z & 0xffff0000u), __uint_as_float(u.w << 16), __uint_as_float(u.w & 0xffff0000u));
            a.r2 = make_float4(__uint_as_float(v.x << 16), __uint_as_float(v.x & 0xffff0000u), __uint_as_float(v.y << 16), __uint_as_float(v.y & 0xffff0000u));
            a.r3 = make_float4(__uint_as_float(v.z << 16), __uint_as_float(v.z & 0xffff0000u), __uint_as_float(v.w << 16), __uint_as_float(v.w & 0xffff0000u));
        }
        return a;
    }
    DEV float apply(int m, int pn, int j, const float (&lo)[8], const float (&hi)[8]) const { return apply(m, pn, j, lo, hi, fetch(m, pn, j)); }
    DEV float apply(int m, int pn, int j, const float (&lo)[8], const float (&hi)[8], const Aux& ax) const {
        const int c = pn * 256 + j;
        float a[8], h[8]; float sq = 0.f;
        const float4 r0 = ax.r0, r1 = ax.r1, r2 = ax.r2, r3 = ax.r3;
        a[0] = lo[0] + r0.x; a[1] = lo[1] + r0.y; a[2] = lo[2] + r0.z; a[3] = lo[3] + r0.w; a[4] = lo[4] + r1.x; a[5] = lo[5] + r1.y; a[6] = lo[6] + r1.z; a[7] = lo[7] + r1.w;
        h[0] = hi[0] + r2.x; h[1] = hi[1] + r2.y; h[2] = hi[2] + r2.z; h[3] = hi[3] + r2.w; h[4] = hi[4] + r3.x; h[5] = hi[5] + r3.y; h[6] = hi[6] + r3.z; h[7] = hi[7] + r3.w;
#pragma unroll
        for (int i = 0; i < 8; ++i) sq += a[i] * a[i] + h[i] * h[i];
        st8b(p.XB + (size_t)m * D_ + c, a); st8b(p.XB + (size_t)m * D_ + c + 128, h);
        return sq;
    }
};
struct EpiGU {
    static constexpr bool HAS_SS = false, USE_RS = true, HAS_AUX = false;
    const Prm& p; float* ss;
    DEV const float* ss_src() const { return p.SSa; }
    DEV float apply(int m, int pn, int j, const float (&lo)[8], const float (&hi)[8], float rs) const {
        float a[8];
#pragma unroll
        for (int i = 0; i < 8; ++i) { const float g = lo[i] * rs, u = hi[i] * rs; a[i] = g * sigmoidf_(g) * u; }
        st8b(p.ACT + (size_t)m * DFF + pn * 128 + j, a);
        return 0.f;
    }
};

namespace pg8 {
#define PG8_LAS __attribute__((address_space(3)))
using ::bf16_t;
typedef short bf16x8 __attribute__((ext_vector_type(8)));
typedef float f32x4 __attribute__((ext_vector_type(4)));
typedef unsigned u32x4 __attribute__((ext_vector_type(4)));
constexpr int BM = 256, BK = 64, HALF = 128, HTB = HALF * BK * 2  , STAGE_BYTES = 8 * HTB, NXCD = 8, WGM = 8;

__host__ __device__ __forceinline__ int lds_byte(int r, int c) { const int st = (r >> 4) * 2 + (c >> 5), rr = r & 15, cc = c & 31, ob = rr * 64 + cc * 2; return st * 1024 + (ob ^ (((ob >> 9) & 1) << 5)); }
__host__ __device__ __forceinline__ void stage_rc(int b, int& R, int& C) { const int st = b / 1024, sb = b % 1024, swz = sb ^ (((sb >> 9) & 1) << 5); R = (st >> 1) * 16 + swz / 64; C = (st & 1) * 32 + (swz % 64) / 2; }
__host__ __device__ __forceinline__ int perm32(int rho) { const int n = rho >> 4, i = rho & 15; return 8 * (i >> 2) + 4 * n + (i & 3); }

struct Unit { int pm, pn, kq; };
struct Gemm { const bf16_t* A; const bf16_t* Bt; int M, N, K, Kl; };

struct StaticOrder {
    int nM, nN, nwg, G, c;
    __host__ __device__ void init(int M, int N, int G_, int c_) { nM = M / BM; nN = N / BM; nwg = nM * nN; G = G_; c = c_; }
    __host__ __device__ bool next(int i, Unit& u) const {
        const long L = (long)i * G + c; if (L >= nwg) return false;
        int wgid = (int)L; { const int q = nwg / NXCD, r = nwg % NXCD, xcd = wgid % NXCD, off = wgid / NXCD; wgid = (xcd < r ? xcd * (q + 1) : r * (q + 1) + (xcd - r) * q) + off; }
        const int nig = WGM * nN, gid = wgid / nig, fm = gid * WGM, gsz = (nM - fm) < WGM ? (nM - fm) : WGM;
        u.pm = fm + ((wgid % nig) % gsz); u.pn = (wgid % nig) / gsz; u.kq = 0; return true;
    }
    __device__ __forceinline__ void a_ready(const Unit&) const {}
    __device__ __forceinline__ void done(const Unit&) const {}
};

template <class Epi, class Sched, bool ALIGN_EPI = false, bool SP2 = false>
__device__ __forceinline__ void gemm_phase(PG8_LAS unsigned char* lds, const Gemm g, const Sched& S, const Epi& E) {
    const int tid = opaque_tid(), wid = __builtin_amdgcn_readfirstlane(tid >> 6), lane = tid & 63, wr = wid >> 2, wc = wid & 3, fr = lane & 15, fq = lane >> 4;
    const int K = g.K, nt = g.Kl / BK;
    unsigned voffA[2], voffB[2];
#pragma unroll
    for (int i = 0; i < 2; ++i) { int R, C; stage_rc(tid * 16 + i * 8192, R, C); const int Rb = Epi::PERM ? ((R & ~31) + perm32(R & 31)) : R;
        voffA[i] = (unsigned)(R * K + C) * 2u; voffB[i] = (unsigned)(Rb * K + C) * 2u; }
    const size_t kstep = (size_t)(BK * 2);
    const size_t hstep = (size_t)HALF * K * 2;
    const size_t tstep = 2 * hstep;
    const unsigned ldsw = (unsigned)wid * 1024u;
    const int aoff = lds_byte(wr * 64 + fr, fq * 8), boff = lds_byte(wc * 32 + fr, fq * 8);
#define PG8_SA(b, h) (((b) * 2 + (h)) * HTB)
#define PG8_SB(b, h) ((4 + (b) * 2 + (h)) * HTB)
#define PG8_STAGE(bufoff, gbase, voff) do { _Pragma("unroll") for (int _i = 0; _i < 2; ++_i) \
        __builtin_amdgcn_global_load_lds((const unsigned*)((const char*)(gbase) + (voff)[_i]), (PG8_LAS unsigned*)(lds + (bufoff) + ldsw + _i * 8192), 16, 0, 0); } while (0)
#define PG8_LDA(dst, b, h) do { _Pragma("unroll") for (int m = 0; m < 4; ++m) _Pragma("unroll") for (int k = 0; k < 2; ++k) dst[m][k] = *(const PG8_LAS bf16x8*)(lds + PG8_SA(b, h) + aoff + m * 2048 + k * 1024); } while (0)
#define PG8_LDB(dst, b, h) do { _Pragma("unroll") for (int n = 0; n < 2; ++n) _Pragma("unroll") for (int k = 0; k < 2; ++k) dst[n][k] = *(const PG8_LAS bf16x8*)(lds + PG8_SB(b, h) + boff + n * 2048 + k * 1024); } while (0)
#define PG8_MMA(ai, bj, At, Bt) do { __builtin_amdgcn_s_setprio(1); _Pragma("unroll") for (int m = 0; m < 4; ++m) _Pragma("unroll") for (int n = 0; n < 2; ++n) _Pragma("unroll") for (int k = 0; k < 2; ++k) \
        acc[ai][bj][m][n] = __builtin_amdgcn_mfma_f32_16x16x32_bf16(Bt[n][k], At[m][k], acc[ai][bj][m][n], 0, 0, 0); __builtin_amdgcn_s_setprio(0); } while (0)
#define PG8_WAIT_V(n) asm volatile("s_waitcnt vmcnt(" #n ")" ::: "memory")
#define PG8_WAIT_L(n) asm volatile("s_waitcnt lgkmcnt(" #n ")" ::: "memory")
#define PG8_BAR __builtin_amdgcn_s_barrier()
#define PG8_SCHED __builtin_amdgcn_sched_barrier(0)
    Unit cur, nxt; int ui = 0;
    if (!S.next(0, cur)) return;
    f32x4 acc[2][2][4][2];
#pragma unroll
    for (int a = 0; a < 2; ++a)
#pragma unroll
        for (int b = 0; b < 2; ++b)
#pragma unroll
            for (int m = 0; m < 4; ++m)
#pragma unroll
                for (int n = 0; n < 2; ++n) acc[a][b][m][n] = (f32x4){0.f, 0.f, 0.f, 0.f};
    bf16x8 At[4][2], B0[2][2], B1[2][2];
    const unsigned kqb = (unsigned)g.Kl * 2u;
    const char* cA = (const char*)g.A + (size_t)cur.pm * tstep + (unsigned)cur.kq * kqb; const char* cB = (const char*)g.Bt + (size_t)cur.pn * tstep + (unsigned)cur.kq * kqb;
    S.a_ready(cur);
    if constexpr (SP2) {
        PG8_STAGE(PG8_SB(0, 0), cB, voffB); PG8_STAGE(PG8_SB(0, 1), cB + hstep, voffB); PG8_STAGE(PG8_SA(0, 0), cA, voffA); PG8_STAGE(PG8_SA(0, 1), cA + hstep, voffA);
        if (wr == 1) PG8_BAR;
        PG8_WAIT_V(2); PG8_BAR;
        PG8_STAGE(PG8_SB(1, 0), cB + kstep, voffB); PG8_STAGE(PG8_SA(1, 0), cA + kstep, voffA); PG8_STAGE(PG8_SB(1, 1), cB + hstep + kstep, voffB);
        PG8_WAIT_V(6); PG8_BAR;
    } else {
        PG8_STAGE(PG8_SB(0, 0), cB, voffB); PG8_STAGE(PG8_SA(0, 0), cA, voffA); PG8_STAGE(PG8_SB(0, 1), cB + hstep, voffB); PG8_STAGE(PG8_SA(0, 1), cA + hstep, voffA);
        if (wr == 1) PG8_BAR;
        PG8_WAIT_V(4); PG8_BAR;
        PG8_STAGE(PG8_SB(1, 0), cB + kstep, voffB); PG8_STAGE(PG8_SA(1, 0), cA + kstep, voffA); PG8_STAGE(PG8_SB(1, 1), cB + hstep + kstep, voffB);
        PG8_WAIT_V(6); PG8_BAR;
    }
    for (;;) {
        const bool has_next = S.next(ui + 1, nxt);
        const char* nA = has_next ? (const char*)g.A + (size_t)nxt.pm * tstep + (unsigned)nxt.kq * kqb : cA; const char* nB = has_next ? (const char*)g.Bt + (size_t)nxt.pn * tstep + (unsigned)nxt.kq * kqb : cB;
        for (int t = 0; t < nt; t += 2) {
            const bool last = (t == nt - 2);
            const char* a1 = cA + (size_t)(t + 1) * kstep;
            const char* a2 = last ? nA : cA + (size_t)(t + 2) * kstep; const char* b2 = last ? nB : cB + (size_t)(t + 2) * kstep;
            const char* a3 = a2 + kstep; const char* b3 = b2 + kstep;
            if (last && has_next) S.a_ready(nxt);
            if constexpr (SP2) {
            PG8_LDB(B0, 0, 0); PG8_LDB(B1, 0, 1); PG8_SCHED; PG8_LDA(At, 0, 0); PG8_STAGE(PG8_SA(1, 1), a1 + hstep, voffA);
            PG8_WAIT_V(8); PG8_WAIT_L(0); PG8_BAR; PG8_MMA(0, 0, At, B0); PG8_MMA(0, 1, At, B1); PG8_BAR; PG8_SCHED;
            PG8_LDA(At, 0, 1); PG8_STAGE(PG8_SB(0, 0), b2, voffB); PG8_STAGE(PG8_SB(0, 1), b2 + hstep, voffB); PG8_STAGE(PG8_SA(0, 0), a2, voffA);
            PG8_WAIT_V(8); PG8_WAIT_L(0); PG8_BAR; PG8_MMA(1, 0, At, B0); PG8_MMA(1, 1, At, B1); PG8_BAR; PG8_SCHED;
            PG8_LDB(B0, 1, 0); PG8_LDB(B1, 1, 1); PG8_SCHED; PG8_LDA(At, 1, 0); PG8_STAGE(PG8_SA(0, 1), a2 + hstep, voffA);
            PG8_WAIT_V(8); PG8_WAIT_L(0); PG8_BAR; PG8_MMA(0, 0, At, B0); PG8_MMA(0, 1, At, B1); PG8_BAR; PG8_SCHED;
            PG8_LDA(At, 1, 1); PG8_STAGE(PG8_SB(1, 0), b3, voffB); PG8_STAGE(PG8_SB(1, 1), b3 + hstep, voffB); PG8_STAGE(PG8_SA(1, 0), a3, voffA);
            PG8_WAIT_V(8); PG8_WAIT_L(0); PG8_BAR; PG8_MMA(1, 0, At, B0); PG8_MMA(1, 1, At, B1); PG8_BAR; PG8_SCHED;
            } else {
            PG8_LDB(B0, 0, 0); PG8_SCHED; PG8_LDA(At, 0, 0); PG8_STAGE(PG8_SA(1, 1), a1 + hstep, voffA);
            PG8_WAIT_L(8); PG8_BAR; PG8_WAIT_L(0); PG8_MMA(0, 0, At, B0); PG8_BAR; PG8_SCHED;
            PG8_LDB(B1, 0, 1); PG8_STAGE(PG8_SB(0, 0), b2, voffB);
            PG8_BAR; PG8_WAIT_L(0); PG8_MMA(0, 1, At, B1); PG8_BAR;
            PG8_LDA(At, 0, 1); PG8_STAGE(PG8_SA(0, 0), a2, voffA);
            PG8_BAR; PG8_WAIT_L(0); PG8_MMA(1, 0, At, B0); PG8_BAR; PG8_SCHED;
            PG8_STAGE(PG8_SB(0, 1), b2 + hstep, voffB);
            PG8_WAIT_V(6); PG8_BAR; PG8_MMA(1, 1, At, B1); PG8_BAR;
            PG8_LDB(B0, 1, 0); PG8_SCHED; PG8_LDA(At, 1, 0); PG8_STAGE(PG8_SA(0, 1), a2 + hstep, voffA);
            PG8_WAIT_L(8); PG8_BAR; PG8_WAIT_L(0); PG8_MMA(0, 0, At, B0); PG8_BAR; PG8_SCHED;
            PG8_LDB(B1, 1, 1); PG8_STAGE(PG8_SB(1, 0), b3, voffB);
            PG8_BAR; PG8_WAIT_L(0); PG8_MMA(0, 1, At, B1); PG8_BAR;
            PG8_LDA(At, 1, 1); PG8_STAGE(PG8_SA(1, 0), a3, voffA);
            PG8_BAR; PG8_WAIT_L(0); PG8_MMA(1, 0, At, B0); PG8_BAR; PG8_SCHED;
            PG8_STAGE(PG8_SB(1, 1), b3 + hstep, voffB);
            PG8_WAIT_V(6); PG8_BAR; PG8_MMA(1, 1, At, B1); PG8_BAR;
            }
        }
        if constexpr (ALIGN_EPI) { if (wr == 0) PG8_BAR; }
        if constexpr (!Epi::AFTER_DRAIN) { E(acc, cur, wr, wc, fr, fq); S.done(cur); }
        if (!has_next) break;
#pragma unroll
        for (int a = 0; a < 2; ++a)
#pragma unroll
            for (int b = 0; b < 2; ++b)
#pragma unroll
                for (int m = 0; m < 4; ++m)
#pragma unroll
                    for (int n = 0; n < 2; ++n) acc[a][b][m][n] = (f32x4){0.f, 0.f, 0.f, 0.f};
        cur = nxt; cA = nA; cB = nB; ++ui;
        if constexpr (ALIGN_EPI) { if (wr == 1) PG8_BAR; }
    }
    PG8_WAIT_V(0);
    if constexpr (!ALIGN_EPI) { if (wr == 0) PG8_BAR; }
    PG8_BAR;
    if constexpr (Epi::AFTER_DRAIN) { E.fused(acc, cur, wr, wc, fr, fq, lds, wid, lane); S.done(cur); }
#undef PG8_SA
#undef PG8_SB
#undef PG8_STAGE
#undef PG8_LDA
#undef PG8_LDB
#undef PG8_MMA
#undef PG8_WAIT_V
#undef PG8_WAIT_L
#undef PG8_BAR
#undef PG8_SCHED
}
}

constexpr int RSL_OFF = 131072;
template <class E> struct EpiAdapt {
    static constexpr bool PERM = true, AFTER_DRAIN = false;
    const E& e; const float* rsl; mutable int ui;
    __device__ __forceinline__ void operator()(const pg8::f32x4 (&acc)[2][2][4][2], const pg8::Unit& u, int wr, int wc, int fr, int fq) const {
        const int j = wc * 32 + 8 * fq;
        float rsv[2][4];
        if constexpr (E::USE_RS) {
#pragma unroll
            for (int ai = 0; ai < 2; ++ai)
#pragma unroll
                for (int m = 0; m < 4; ++m) rsv[ai][m] = rsl[ui * 256 + ai * 128 + wr * 64 + m * 16 + fr];
        }
        if constexpr (E::HAS_AUX) {
            int row = u.pm * 256 + wr * 64 + fr; asm volatile("" : "+v"(row));
            typename E::Aux nx = e.fetch(row, u.pn, j);
#pragma unroll
            for (int g = 0; g < 8; ++g) {
                const int ai = g >> 2, m = g & 3;
                const typename E::Aux cu = nx;
                if (g < 7) { int rn = u.pm * 256 + ((g + 1) >> 2) * 128 + wr * 64 + ((g + 1) & 3) * 16 + fr; asm volatile("" : "+v"(rn)); nx = e.fetch(rn, u.pn, j); }
                float lo[8], hi[8];
#pragma unroll
                for (int i = 0; i < 4; ++i) { lo[i] = acc[ai][0][m][0][i]; lo[4 + i] = acc[ai][0][m][1][i]; hi[i] = acc[ai][1][m][0][i]; hi[4 + i] = acc[ai][1][m][1][i]; }
                float sq = e.apply(row, u.pn, j, lo, hi, cu);
                if (E::HAS_SS) { sq += __shfl_xor(sq, 16); sq += __shfl_xor(sq, 32); if (fq == 0) e.ss[(size_t)row * 16 + u.pn * 4 + wc] = sq; }
                row = u.pm * 256 + ((g + 1) >> 2) * 128 + wr * 64 + ((g + 1) & 3) * 16 + fr; asm volatile("" : "+v"(row));
            }
        } else {
#pragma unroll
            for (int ai = 0; ai < 2; ++ai)
#pragma unroll
                for (int m = 0; m < 4; ++m) {
                    int row = u.pm * 256 + ai * 128 + wr * 64 + m * 16 + fr;
                    asm volatile("" : "+v"(row));
                    float lo[8], hi[8];
#pragma unroll
                    for (int i = 0; i < 4; ++i) { lo[i] = acc[ai][0][m][0][i]; lo[4 + i] = acc[ai][0][m][1][i]; hi[i] = acc[ai][1][m][0][i]; hi[4 + i] = acc[ai][1][m][1][i]; }
                    float sq = e.apply(row, u.pn, j, lo, hi, rsv[ai][m]);
                    if (E::HAS_SS) { sq += __shfl_xor(sq, 16); sq += __shfl_xor(sq, 32); if (fq == 0) e.ss[(size_t)row * 16 + u.pn * 4 + wc] = sq; }
                }
        }
        ++ui;
    }
};
template <class E> DEV void gemm_fast(unsigned char* lds, const bf16_t* A, const bf16_t* Bt, int M, int N, int K, const E& e) {
    pg8::Gemm g{A, Bt, M, N, K, K}; pg8::StaticOrder S; S.init(M, N, (int)gridDim.x, (int)blockIdx.x);
    const float* rsl = (const float*)(lds + RSL_OFF);
    if constexpr (E::USE_RS) {
        const int tid = opaque_tid(); pg8::Unit u;
        __syncthreads();
        for (int i = tid >> 8; S.next(i, u); i += 2) ((float*)(lds + RSL_OFF))[i * 256 + (tid & 255)] = row_rs(e.ss_src(), u.pm * 256 + (tid & 255));
        __syncthreads();
    }
    EpiAdapt<E> ad{e, rsl, 0};
    pg8::gemm_phase<EpiAdapt<E>, pg8::StaticOrder, true, true>((PG8_LAS unsigned char*)lds, g, S, ad);
}

struct SplitOrder {
    int npn, nkq, G, c;
    __device__ bool next(int i, pg8::Unit& u) const { const long L = (long)i * G + (G - 1 - c); if (L >= 2L * npn * nkq) return false; const int x = (int)L; u.pm = MP / 256 + (x & 1); u.pn = (x >> 1) % npn; u.kq = (x >> 1) / npn; return true; }
    __device__ __forceinline__ void a_ready(const pg8::Unit&) const {}
    __device__ __forceinline__ void done(const pg8::Unit&) const {}
};
struct EpiPartial {
    static constexpr bool PERM = true, AFTER_DRAIN = false;
    float* slab; int N;
    __device__ __forceinline__ void operator()(const pg8::f32x4 (&acc)[2][2][4][2], const pg8::Unit& u, int wr, int wc, int fr, int fq) const {
        const int j = wc * 32 + 8 * fq;
#pragma unroll
        for (int ai = 0; ai < 2; ++ai)
#pragma unroll
            for (int m = 0; m < 4; ++m) {
                const int rs = (u.pm - MP / 256) * 256 + ai * 128 + wr * 64 + m * 16 + fr;
                float* o = slab + ((size_t)u.kq * MS + rs) * N + u.pn * 256 + j;
                *(pg8::f32x4*)(o) = acc[ai][0][m][0]; *(pg8::f32x4*)(o + 4) = acc[ai][0][m][1]; *(pg8::f32x4*)(o + 128) = acc[ai][1][m][0]; *(pg8::f32x4*)(o + 132) = acc[ai][1][m][1];
            }
    }
};
DEV void gemm_split(unsigned char* lds, const bf16_t* A, const bf16_t* Bt, int N, int K, int Kl, float* slab) {
    pg8::Gemm g{A, Bt, M_, N, K, Kl}; SplitOrder S{N / 256, K / Kl, (int)gridDim.x, (int)blockIdx.x};
    EpiPartial ep{slab, N};
    pg8::gemm_phase<EpiPartial, SplitOrder, false, false>((PG8_LAS unsigned char*)lds, g, S, ep);
}
template <class E> DEV void gemm_reduce(const float* slab, int N, int nkq, const E& e) {
    const int ntn = N / 256, total = MS * ntn * 16;
    for (int gid = blockIdx.x * NTHR + opaque_tid(); gid < total; gid += gridDim.x * NTHR) {
        const int jj = gid & 15, pn = (gid >> 4) % ntn, rs = (gid >> 4) / ntn, j = jj * 8;
        float lo[8], hi[8];
#pragma unroll
        for (int i = 0; i < 8; ++i) { lo[i] = 0.f; hi[i] = 0.f; }
#pragma unroll
        for (int kq = 0; kq < nkq; ++kq) {
            const float* o = slab + ((size_t)kq * MS + rs) * N + pn * 256 + j;
            const float4 a = *(const float4*)(o), b = *(const float4*)(o + 4), c = *(const float4*)(o + 128), d = *(const float4*)(o + 132);
            lo[0] += a.x; lo[1] += a.y; lo[2] += a.z; lo[3] += a.w; lo[4] += b.x; lo[5] += b.y; lo[6] += b.z; lo[7] += b.w;
            hi[0] += c.x; hi[1] += c.y; hi[2] += c.z; hi[3] += c.w; hi[4] += d.x; hi[5] += d.y; hi[6] += d.z; hi[7] += d.w;
        }
        float sq = e.apply(MP + rs, pn, j, lo, hi);
        if (E::HAS_SS) { sq += __shfl_xor(sq, 1); sq += __shfl_xor(sq, 2); if ((jj & 3) == 0) e.ss[(size_t)(MP + rs) * 16 + pn * 4 + (jj >> 2)] = sq; }
    }
}

DEV void gemm_reduce_final(const Prm& p, const float* slab, int nkq_) {
    constexpr int N = D_, ntn = N / 256, total = MS * ntn * 16, nkq = DFF / 256; (void)nkq_;
    for (int gid = blockIdx.x * NTHR + opaque_tid(); gid < total; gid += gridDim.x * NTHR) {
        const int jj = gid & 15, pn = (gid >> 4) % ntn, rs = (gid >> 4) / ntn, j = jj * 8, c = pn * 256 + j;
        float lo[8], hi[8];
#pragma unroll
        for (int i = 0; i < 8; ++i) { lo[i] = 0.f; hi[i] = 0.f; }
#pragma unroll
        for (int kq = 0; kq < nkq; ++kq) {
            const float* o = slab + ((size_t)kq * MS + rs) * N + c;
            const float4 a = *(const float4*)(o), b = *(const float4*)(o + 4), cc = *(const float4*)(o + 128), d = *(const float4*)(o + 132);
            lo[0] += a.x; lo[1] += a.y; lo[2] += a.z; lo[3] += a.w; lo[4] += b.x; lo[5] += b.y; lo[6] += b.z; lo[7] += b.w;
            hi[0] += cc.x; hi[1] += cc.y; hi[2] += cc.z; hi[3] += cc.w; hi[4] += d.x; hi[5] += d.y; hi[6] += d.z; hi[7] += d.w;
        }
        const bf16_t* rb = p.XB + (size_t)(MP + rs) * D_ + c; const uint4 u = *(const uint4*)rb, v = *(const uint4*)(rb + 128);
        const unsigned uu[4] = {u.x, u.y, u.z, u.w}, vv[4] = {v.x, v.y, v.z, v.w};
        float sq = 0.f;
#pragma unroll
        for (int i = 0; i < 4; ++i) { lo[2 * i] += __uint_as_float(uu[i] << 16); lo[2 * i + 1] += __uint_as_float(uu[i] & 0xffff0000u); hi[2 * i] += __uint_as_float(vv[i] << 16); hi[2 * i + 1] += __uint_as_float(vv[i] & 0xffff0000u); }
#pragma unroll
        for (int i = 0; i < 8; ++i) sq += lo[i] * lo[i] + hi[i] * hi[i];
        sq = wave_sum(sq);
        const float r = rsqrtf(sq * (1.f / 1024.f) + 1e-6f);
        const float* g = p.final_norm + c; float* y = p.out + (size_t)(MP + rs) * D_ + c;
        const float4 g0 = *(const float4*)(g), g1 = *(const float4*)(g + 4), g2 = *(const float4*)(g + 128), g3 = *(const float4*)(g + 132);
        *(float4*)(y) = make_float4(lo[0] * r * g0.x, lo[1] * r * g0.y, lo[2] * r * g0.z, lo[3] * r * g0.w); *(float4*)(y + 4) = make_float4(lo[4] * r * g1.x, lo[5] * r * g1.y, lo[6] * r * g1.z, lo[7] * r * g1.w);
        *(float4*)(y + 128) = make_float4(hi[0] * r * g2.x, hi[1] * r * g2.y, hi[2] * r * g2.z, hi[3] * r * g2.w); *(float4*)(y + 132) = make_float4(hi[4] * r * g3.x, hi[5] * r * g3.y, hi[6] * r * g3.z, hi[7] * r * g3.w);
    }
}

DEV void convpool_issue(const Prm& p, int l, int item, float4 (&vc)[8], float4 (&vp)[6]) {
    const int tid = opaque_tid();
    const bool samp = item >= 512; const int NT = samp ? 4 : 32;
    int m0, t0 = 0, req = 0;
    if (!samp) { m0 = item * 32; t0 = m0 % T_; } else { req = item - 512; m0 = MP + req * 4; }
#pragma unroll
    for (int i = 0; i < 8; ++i) { const int idx = tid + NTHR * i, r = idx >> 6, c4 = (idx & 63) * 4, rel = r - 30; float4 v = make_float4(0.f, 0.f, 0.f, 0.f);
        if (r < NT + 30) { if (!samp) { if (t0 + rel >= 0) v = *(const float4*)(p.G + (size_t)(m0 + rel) * 256 + c4); }
            else { if (rel < 0) v = *(const float4*)(p.state_conv + ((size_t)(l * NREQ + req) * 30 + r) * 256 + c4); else v = *(const float4*)(p.G + (size_t)(m0 + rel) * 256 + c4); } }
        vc[i] = v; }
#pragma unroll
    for (int i = 0; i < 6; ++i) { const int idx = tid + NTHR * i, r = idx >> 6, c4 = (idx & 63) * 4, rel = r - 15; float4 v = make_float4(0.f, 0.f, 0.f, 0.f);
        if (r < NT + 15) { if (!samp) { if (t0 + rel >= 0) v = *(const float4*)(p.U + (size_t)(m0 + rel) * 256 + c4); }
            else { if (rel < 0) v = *(const float4*)(p.state_pool + ((size_t)(l * NREQ + req) * 15 + r) * 256 + c4); else v = *(const float4*)(p.U + (size_t)(m0 + rel) * 256 + c4); } }
        vp[i] = v; }
}
DEV void convpool_item(const Prm& p, int l, int item, float* sm, float4 (&vc)[8], float4 (&vp)[6], int next_item) {
    float* cbuf = sm; float* pbuf = sm + 62 * 256; float* yb = sm + (62 + 47) * 256;
    const int tid = opaque_tid(), c = tid & 255, half = tid >> 8, wave = tid >> 6, lane = tid & 63;
    const bool samp = item >= 512; const int NT = samp ? 4 : 32, ntok = NT / 2;
    int m0, t0 = 0, req = 0;
    if (!samp) { m0 = item * 32; t0 = m0 % T_; } else { req = item - 512; m0 = MP + req * 4; }
    __syncthreads();
    {
#pragma unroll
        for (int i = 0; i < 8; ++i) { const int idx = tid + NTHR * i, r = idx >> 6, c4 = (idx & 63) * 4; if (r < NT + 30) *(float4*)(cbuf + r * 256 + c4) = vc[i]; }
#pragma unroll
        for (int i = 0; i < 6; ++i) { const int idx = tid + NTHR * i, r = idx >> 6, c4 = (idx & 63) * 4; if (r < NT + 15) *(float4*)(pbuf + r * 256 + c4) = vp[i]; }
        if (next_item >= 0) convpool_issue(p, l, next_item, vc, vp);
    }
    __syncthreads();
    {
        const float cbias = p.conv_b[l * 256 + c];
        float dw[31];
#pragma unroll
        for (int w = 0; w < 31; ++w) dw[w] = p.conv_dw[(size_t)(l * 31 + w) * 256 + c];
        const float* bp = cbuf + (half * ntok) * 256 + c;
        if (!samp) {
#pragma unroll 1
            for (int k4 = 0; k4 < 4; ++k4) {
                float a0 = cbias, a1 = cbias, a2 = cbias, a3 = cbias;
#pragma unroll
                for (int rr = 0; rr < 34; ++rr) {
                    const float v = bp[(k4 * 4 + rr) * 256];
                    if (rr < 31) a0 += v * dw[rr];
                    if (rr >= 1 && rr < 32) a1 += v * dw[rr - 1];
                    if (rr >= 2 && rr < 33) a2 += v * dw[rr - 2];
                    if (rr >= 3) a3 += v * dw[rr - 3];
                }
                float* yo = yb + (half * ntok + k4 * 4) * 256 + c; yo[0] = a0; yo[256] = a1; yo[512] = a2; yo[768] = a3;
            }
        } else {
            float a0 = cbias, a1 = cbias;
#pragma unroll
            for (int rr = 0; rr < 32; ++rr) { const float v = bp[rr * 256]; if (rr < 31) a0 += v * dw[rr]; if (rr >= 1) a1 += v * dw[rr - 1]; }
            float* yo = yb + (half * ntok) * 256 + c; yo[0] = a0; yo[256] = a1;
        }
    }
    if (samp) {
        for (int idx = tid; idx < 26 * 256; idx += NTHR) p.out[O_CONVS + ((size_t)(l * NREQ + req) * 30) * 256 + idx] = cbuf[4 * 256 + idx];
        for (int idx = tid; idx < 11 * 256; idx += NTHR) p.out[O_POOLS + ((size_t)(l * NREQ + req) * 15) * 256 + idx] = pbuf[4 * 256 + idx];
    }
    __syncthreads();
    for (int tok = wave; tok < NT; tok += 8) {
        const float4 v = *(const float4*)(yb + tok * 256 + lane * 4);
        const float mean = wave_sum((v.x + v.y) + (v.z + v.w)) * (1.f / 256.f);
        const float x0 = v.x - mean, x1 = v.y - mean, x2 = v.z - mean, x3 = v.w - mean;
        const float var = wave_sum((x0 * x0 + x1 * x1) + (x2 * x2 + x3 * x3)) * (1.f / 256.f);
        const float r = rsqrtf(var + 1e-6f);
        const float4 g = *(const float4*)(p.conv_ln_g + l * 256 + lane * 4), bb = *(const float4*)(p.conv_ln_b + l * 256 + lane * 4);
        float y0 = x0 * r * g.x + bb.x, y1 = x1 * r * g.y + bb.y, y2 = x2 * r * g.z + bb.z, y3 = x3 * r * g.w + bb.w;
        y0 *= sigmoidf_(y0); y1 *= sigmoidf_(y1); y2 *= sigmoidf_(y2); y3 *= sigmoidf_(y3);
        uint2 w; w.x = pack2(y0, y1); w.y = pack2(y2, y3);
        *(uint2*)(p.MIX + (size_t)(m0 + tok) * D_ + lane * 4) = w;
    }
    __syncthreads();
    {
        const int w = 2 << (c >> 6);
#pragma unroll 1
        for (int k = 0; k < ntok; ++k) {
            const int tok = half * ntok + k; float v[16];
#pragma unroll
            for (int i = 0; i < 16; ++i) v[i] = pbuf[(tok + 15 - i) * 256 + c];
            float sacc = v[0] + v[1];
#pragma unroll
            for (int i = 2; i < 16; ++i) sacc += i < w ? v[i] : 0.f;
            const int cnt = samp ? w : min(w, t0 + tok + 1);
            yb[tok * 256 + c] = sacc / (float)cnt - v[0];
        }
    }
    __syncthreads();
    {
        const int e = tid & 63, g = (tid >> 6) & 3; const float sc = p.pool_scale[l * 256 + g * 64 + e];
        const float* wp = p.pool_w + (size_t)(l * 4 + g) * 64 * 64 + e;
        float wr[64];
#pragma unroll
        for (int cc = 0; cc < 64; ++cc) wr[cc] = wp[cc * 64];
#pragma unroll 1
        for (int k = 0; k < ntok; ++k) {
            const int tok = half * ntok + k; float acc = 0.f; const float* yr = yb + tok * 256 + g * 64;
#pragma unroll
            for (int c4 = 0; c4 < 16; ++c4) { const float4 y = *(const float4*)(yr + c4 * 4); acc += y.x * wr[c4 * 4] + y.y * wr[c4 * 4 + 1] + y.z * wr[c4 * 4 + 2] + y.w * wr[c4 * 4 + 3]; }
            p.MIX[(size_t)(m0 + tok) * D_ + 256 + g * 64 + e] = f2bf(acc * sc);
        }
    }
}
typedef short bf16x8_t __attribute__((ext_vector_type(8)));
typedef short s16x4_t __attribute__((ext_vector_type(4)));
typedef float f32x16_t __attribute__((ext_vector_type(16)));
DEV unsigned off64(unsigned row, unsigned ch) { return 1024u * (row >> 3) + 512u * (ch >> 2) + 64u * (row & 7) + 16u * ((ch & 3) ^ ((row >> 2) & 3)); }
enum { AM_FAR = 0, AM_NEAR = 1, AM_DIAG = 2, AM_WINFIRST = 3, AM_CMP = 4 };
constexpr int AT_RING = 6, AT_KB = 0, AT_VB = AT_RING * 8192, AT_BT = 2 * AT_RING * 8192, AT_PA = AT_BT + 2048, AT_SELM = AT_PA + 32768, AT_LDS = AT_SELM + 512;
static_assert(AT_LDS <= LDS_BYTES - 16, "attention LDS map");

struct AttnState { f32x16_t O0, O1; float m, l; };

template <bool PRIO = false> DEV void attn_qk(const unsigned char* kb, unsigned ka0, const bf16x8_t (&qf)[4], f32x16_t& S0, f32x16_t& S1) {
#pragma unroll
    for (int i = 0; i < 16; ++i) { S0[i] = 0.f; S1[i] = 0.f; }
    if (PRIO) __builtin_amdgcn_s_setprio(1);
#pragma unroll
    for (int ks = 0; ks < 4; ++ks) {
        const unsigned a = (ka0 ^ ((ks & 1) ? 32u : 0u)) + 512u * (ks >> 1);
        const bf16x8_t a0 = *(const bf16x8_t*)(kb + a), a1 = *(const bf16x8_t*)(kb + a + 4096);
        S0 = __builtin_amdgcn_mfma_f32_32x32x16_bf16(a0, qf[ks], S0, 0, 0, 0);
        S1 = __builtin_amdgcn_mfma_f32_32x32x16_bf16(a1, qf[ks], S1, 0, 0, 0);
    }
    if (PRIO) __builtin_amdgcn_s_setprio(0);
}
template <bool PRIO = false> DEV void attn_pv(unsigned vbase, unsigned va_rel, const f32x16_t& pa, const f32x16_t& pb, f32x16_t& O0, f32x16_t& O1) {
    const unsigned vb_addr0 = vbase + va_rel, vb1 = vbase + (va_rel ^ 32u) + 1024u;
#pragma unroll
    for (int k4 = 0; k4 < 4; ++k4) {
        const f32x16_t& P = (k4 < 2) ? pa : pb; const int s = k4 & 1;
        unsigned w[4];
#pragma unroll
        for (int i = 0; i < 4; ++i) w[i] = cvt_pk_bf16(P[8 * s + 2 * i], P[8 * s + 2 * i + 1]);
        bf16x8_t pf; { typedef unsigned u32x4_t __attribute__((ext_vector_type(4))); u32x4_t t = {w[0], w[1], w[2], w[3]}; pf = __builtin_bit_cast(bf16x8_t, t); }
        s16x4_t v00, v01, v10, v11;
        asm volatile("ds_read_b64_tr_b16 %0, %4 offset:%6\n\tds_read_b64_tr_b16 %1, %5 offset:%6\n\tds_read_b64_tr_b16 %2, %4 offset:%7\n\tds_read_b64_tr_b16 %3, %5 offset:%7\n\ts_waitcnt lgkmcnt(0)"
                     : "=&v"(v00), "=&v"(v01), "=&v"(v10), "=&v"(v11) : "v"(vb_addr0), "v"(vb1), "i"(2048 * k4), "i"(2048 * k4 + 512) : "memory");
        const bf16x8_t a0 = __builtin_shufflevector(v00, v01, 0, 1, 2, 3, 4, 5, 6, 7), a1 = __builtin_shufflevector(v10, v11, 0, 1, 2, 3, 4, 5, 6, 7);
        if (PRIO) __builtin_amdgcn_s_setprio(1);
        O0 = __builtin_amdgcn_mfma_f32_32x32x16_bf16(a0, pf, O0, 0, 0, 0);
        O1 = __builtin_amdgcn_mfma_f32_32x32x16_bf16(a1, pf, O1, 0, 0, 0);
        if (PRIO) __builtin_amdgcn_s_setprio(0);
    }
}
template <int MODE> DEV void attn_bias(f32x16_t& S0, f32x16_t& S1, int dl, float lb, const float* bt_r) {
    constexpr int STEP = MODE == AM_CMP ? 16 : 1;
#pragma unroll
    for (int u = 0; u < 2; ++u)
#pragma unroll
        for (int v = 0; v < 16; ++v) {
            float s = u ? S1[v] : S0[v];
            const int dist = dl - STEP * (32 * u + (v & 3) + 8 * (v >> 2));
            if (MODE == AM_FAR) s += lb;
            else if (MODE == AM_WINFIRST) s = dist < 512 ? s + lb : -1e30f;
            else if (MODE == AM_NEAR) s += bt_r[min(max(dist, 0), 127)] + lb;
            else s = dist >= 0 ? s + bt_r[min(max(dist, 0), 127)] : -1e30f;
            if (u) S1[v] = s; else S0[v] = s;
        }
}
template <bool MASKED> DEV float attn_tilemax(const f32x16_t& S0, const f32x16_t& S1) {
    float t = fmaxf(S0[0], S1[0]);
#pragma unroll
    for (int v = 1; v < 16; ++v) t = fmaxf(t, fmaxf(S0[v], S1[v]));
    return fmaxf(t, __shfl_xor(t, 32));
}
template <bool MASKED> DEV float attn_exp(f32x16_t& S0, f32x16_t& S1, float mref, float scale) {
    float sum = 0.f;
#pragma unroll
    for (int v = 0; v < 16; ++v) {
        float e0 = __builtin_amdgcn_exp2f(S0[v] - mref), e1 = __builtin_amdgcn_exp2f(S1[v] - mref);
        if (MASKED) { e0 = S0[v] > -1e29f ? e0 : 0.f; e1 = S1[v] > -1e29f ? e1 : 0.f; }
        e0 *= scale; e1 *= scale;
        S0[v] = e0; S1[v] = e1; sum += e0 + e1;
    }
    return sum;
}
template <int MODE> DEV void attn_tile(const unsigned char* kb, unsigned ka0, unsigned vbase, unsigned va_rel, const bf16x8_t (&qf)[4], AttnState& st, int dl, float lb, const float* bt_r) {
    constexpr bool MASKED = MODE >= AM_DIAG;
    f32x16_t S0, S1;
    attn_qk(kb, ka0, qf, S0, S1);
    attn_bias<MODE>(S0, S1, dl, lb, bt_r);
    const float tm = attn_tilemax<MASKED>(S0, S1);
    const float mn = fmaxf(st.m, tm), alpha = __builtin_amdgcn_exp2f(st.m - mn);
    st.m = mn;
    const float ps = attn_exp<MASKED>(S0, S1, mn, 1.f);
    st.l = st.l * alpha + ps;
#pragma unroll
    for (int v = 0; v < 16; ++v) { st.O0[v] *= alpha; st.O1[v] *= alpha; }
    attn_pv(vbase, va_rel, S0, S1, st.O0, st.O1);
}

DEV void attn_prompt_unit(const Prm& p, int l, int b, int g, int qb, unsigned char* lds) {
    const int tid = opaque_tid(), w = tid >> 6, lane = tid & 63, c = lane & 31, h = lane >> 5, qi = c >> 2, r = c & 3;
    float* BT = (float*)(lds + AT_BT); float* PA = (float*)(lds + AT_PA) + w * 1024; float* PB = PA + 512;
    unsigned* SELM = (unsigned*)(lds + AT_SELM) + w * 16;
    __syncthreads();
    BT[tid] = p.BIASL2[g * 512 + tid];
#pragma unroll
    for (int i = 0; i < 16; ++i) ((float*)(lds + AT_PA))[tid + 512 * i] = 0.f;
    const int tq = 64 * qb + 8 * w + qi; const size_t mrow = (size_t)b * T_ + tq;
    bf16x8_t qf[4];
#pragma unroll
    for (int ks = 0; ks < 4; ++ks) qf[ks] = *(const bf16x8_t*)(p.Q + mrow * 512 + g * 256 + r * 64 + ks * 16 + 8 * h);
    const float gc = p.GATES[mrow * 24 + g * 4 + r], gs = p.GATES[mrow * 24 + 8 + g * 4 + r], gw = p.GATES[mrow * 24 + 16 + g * 4 + r];
    const float* bt_r = BT + r * 128;
    const unsigned ka0 = 1024u * ((unsigned)c >> 3) + 64u * (c & 7) + 16u * ((unsigned)h ^ (((unsigned)c >> 2) & 3u));
    const unsigned blk = (lane >> 4) & 1, q4 = (lane & 15) >> 2, pp = lane & 3;
    const unsigned va_rel = 64u * (4u * h + q4) + 8u * (pp & 1) + 16u * ((2u * blk + (pp >> 1)) ^ (unsigned)h);
    const unsigned lds_base = (unsigned)(size_t)(LAS unsigned char*)lds;
    const bf16_t* KCb = p.KC + (((size_t)b * 2 + g) * 2 + 0) * 256 * 64; const bf16_t* VCb = KCb + 256 * 64;
    const bf16_t* KSb = p.KVB + ((((size_t)(1 * 2 + 0) * NB_ + b) * 2 + g) * T_) * 64; const bf16_t* VSb = p.KVB + ((((size_t)(1 * 2 + 1) * NB_ + b) * 2 + g) * T_) * 64;
    const bf16_t* KWb = p.KVB + ((((size_t)(2 * 2 + 0) * NB_ + b) * 2 + g) * T_) * 64; const bf16_t* VWb = p.KVB + ((((size_t)(2 * 2 + 1) * NB_ + b) * 2 + g) * T_) * 64;
    const int nC = (4 * qb + 66) >> 6, nS = qb + 1, w0 = qb > 8 ? qb - 8 : 0, nW = qb - w0 + 1, J = 2 * nC + nS + nW;
    const int ws = __builtin_amdgcn_readfirstlane(w);
    const int ldrow = 8 * ws + ((lane >> 2) & 7), ldch = 4 * (lane >> 5) + ((lane & 3) ^ ((2 * ws + ((lane >> 4) & 1)) & 3));
    const size_t ldsrc = (size_t)ldrow * 64 + ldch * 8;
    auto job_src = [&](int ji, const bf16_t*& kp, const bf16_t*& vp) {
        if (ji < nC) { kp = KCb + (size_t)ji * 4096; vp = VCb + (size_t)ji * 4096; }
        else if (ji < 2 * nC) { kp = KCb + (size_t)(ji - nC) * 4096; vp = VCb + (size_t)(ji - nC) * 4096; }
        else if (ji < 2 * nC + nS) { kp = KSb + (size_t)(ji - 2 * nC) * 4096; vp = VSb + (size_t)(ji - 2 * nC) * 4096; }
        else { kp = KWb + (size_t)(w0 + ji - 2 * nC - nS) * 4096; vp = VWb + (size_t)(w0 + ji - 2 * nC - nS) * 4096; }
    };
    auto dma = [&](int ji) {
        const bf16_t* kp; const bf16_t* vp; job_src(ji, kp, vp); const int bufo = (ji % AT_RING) * 8192 + ws * 1024;
        __builtin_amdgcn_global_load_lds((const unsigned*)(kp + ldsrc), (LAS unsigned*)(lds + AT_KB + bufo), 16, 0, 0);
        __builtin_amdgcn_global_load_lds((const unsigned*)(vp + ldsrc), (LAS unsigned*)(lds + AT_VB + bufo), 16, 0, 0);
    };
    dma(0); dma(1); dma(2); dma(3);
    asm volatile("s_waitcnt vmcnt(4) lgkmcnt(0)" ::: "memory");
    __builtin_amdgcn_s_barrier();
    asm volatile("" ::: "memory");
    const float b31 = bt_r[127];
    AttnState st;
#pragma unroll
    for (int v = 0; v < 16; ++v) { st.O0[v] = 0.f; st.O1[v] = 0.f; }
    st.m = -1e30f; st.l = 0.f;
    f32x16_t A0, A1;
#pragma unroll
    for (int v = 0; v < 16; ++v) { A0[v] = 0.f; A1[v] = 0.f; }
    float mC = -1e30f, invC = 0.f; unsigned mlo = 0xffffffffu, mhi = 0xffffffffu;
    for (int jp = 0; jp < J; jp += 2) {
      const int nnew = (jp + 4 < J ? 1 : 0) + (jp + 5 < J ? 1 : 0);
      if (jp + 4 < J) dma(jp + 4);
      if (jp + 5 < J) dma(jp + 5);
#pragma unroll 1
      for (int ji = jp; ji < jp + 2 && ji < J; ++ji) {
        const unsigned char* kb = lds + AT_KB + (ji % AT_RING) * 8192; const unsigned vbase = lds_base + AT_VB + (ji % AT_RING) * 8192;
        if (ji < nC) {
            const int dl = tq - 31 - 1024 * ji - 64 * h;
            f32x16_t S0, S1; attn_qk(kb, ka0, qf, S0, S1); attn_bias<AM_CMP>(S0, S1, dl, 0.f, bt_r);
            const float tm = attn_tilemax<true>(S0, S1); const float mn = fmaxf(st.m, tm), alpha = __builtin_amdgcn_exp2f(st.m - mn); st.m = mn;
            st.l = st.l * alpha + attn_exp<true>(S0, S1, mn, 1.f);
            if (ji == nC - 1) { const float lt = st.l + __shfl_xor(st.l, 32); mC = st.m; invC = lt > 0.f ? 1.f / lt : 0.f; }
        } else if (ji < 2 * nC) {
            const int ct = ji - nC; const int dl = tq - 31 - 1024 * ct - 64 * h;
            f32x16_t S0, S1; attn_qk(kb, ka0, qf, S0, S1); attn_bias<AM_CMP>(S0, S1, dl, 0.f, bt_r);
            (void)attn_exp<true>(S0, S1, mC, invC);
            if (qb >= 16) {
#pragma unroll
                for (int u = 0; u < 2; ++u)
#pragma unroll
                    for (int qd = 0; qd < 4; ++qd) {
                        const f32x16_t& P = u ? S1 : S0;
                        float qs = (P[4 * qd] + P[4 * qd + 1]) + (P[4 * qd + 2] + P[4 * qd + 3]), ls = P[4 * qd + 3];
                        qs += __shfl_xor(qs, 1); qs += __shfl_xor(qs, 2); ls += __shfl_xor(ls, 1); ls += __shfl_xor(ls, 2);
                        const int jq = 16 * ct + 8 * u + 2 * qd + h;
                        if (r == 0) { PA[qi * 64 + jq] = qs; if (jq + 1 < 64) PB[qi * 64 + jq + 1] = ls; }
                    }
            }
            attn_pv(vbase, va_rel, S0, S1, st.O0, st.O1);
        } else if (ji < 2 * nC + nS) {
            const int j = ji - 2 * nC; const int dl = tq - 64 * j - 4 * h;
            const bool sel = j < 32 ? ((mlo >> j) & 1u) : ((mhi >> (j - 32)) & 1u);
            if (j == qb) attn_tile<AM_DIAG>(kb, ka0, vbase, va_rel, qf, st, dl, 0.f, bt_r);
            else if (__ballot(sel) != 0ull) {
                if (j >= qb - 2) attn_tile<AM_NEAR>(kb, ka0, vbase, va_rel, qf, st, dl, sel ? 0.f : -1e30f, bt_r);
                else attn_tile<AM_FAR>(kb, ka0, vbase, va_rel, qf, st, dl, sel ? b31 : -1e30f, bt_r);
            }
        } else {
            const int kbi = w0 + ji - 2 * nC - nS; const int dl = tq - 64 * kbi - 4 * h;
            if (kbi == qb) attn_tile<AM_DIAG>(kb, ka0, vbase, va_rel, qf, st, dl, 0.f, bt_r);
            else if (kbi >= qb - 2) attn_tile<AM_NEAR>(kb, ka0, vbase, va_rel, qf, st, dl, 0.f, bt_r);
            else if (kbi == qb - 8) attn_tile<AM_WINFIRST>(kb, ka0, vbase, va_rel, qf, st, dl, b31, bt_r);
            else attn_tile<AM_FAR>(kb, ka0, vbase, va_rel, qf, st, dl, b31, bt_r);
        }
        if (ji == jp + 1 || ji == J - 1) {
            if (nnew == 2) asm volatile("s_waitcnt vmcnt(4) lgkmcnt(0)" ::: "memory"); else if (nnew == 1) asm volatile("s_waitcnt vmcnt(2) lgkmcnt(0)" ::: "memory"); else asm volatile("s_waitcnt vmcnt(0) lgkmcnt(0)" ::: "memory");
            __builtin_amdgcn_s_barrier();
            asm volatile("" ::: "memory");
        }
        if (ji == 2 * nC - 1) {
#pragma unroll
            for (int v = 0; v < 16; ++v) { A0[v] = gc * st.O0[v]; A1[v] = gc * st.O1[v]; st.O0[v] = 0.f; st.O1[v] = 0.f; }
            st.m = -1e30f; st.l = 0.f;
            __syncthreads();
            if (qb >= 16) {
                for (int q = 0; q < 8; ++q) {
                    const bool cand = lane >= 1 && lane <= qb - 2;
                    const float sc = cand ? PA[q * 64 + lane] + PB[q * 64 + lane] : -1.f;
                    int cnt = 0;
                    for (int i = 1; i <= qb - 2; ++i) { const float si = __builtin_bit_cast(float, __builtin_amdgcn_readlane(__builtin_bit_cast(int, sc), i)); cnt += (si > sc || (si == sc && i < lane)) ? 1 : 0; }
                    const unsigned long long bal = __ballot(cand && cnt < 13) | 1ull | (1ull << qb) | (1ull << (qb - 1));
                    if (lane == 0) { SELM[q * 2] = (unsigned)bal; SELM[q * 2 + 1] = (unsigned)(bal >> 32); }
                }
            }
            __syncthreads();
            if (qb >= 16) { mlo = SELM[qi * 2]; mhi = SELM[qi * 2 + 1]; }
        }
        if (ji == 2 * nC + nS - 1 || ji == J - 1) {
            const float lt = st.l + __shfl_xor(st.l, 32); const float sc = (ji == J - 1 ? gw : gs) * (lt > 0.f ? 1.f / lt : 0.f);
#pragma unroll
            for (int v = 0; v < 16; ++v) { A0[v] += sc * st.O0[v]; A1[v] += sc * st.O1[v]; st.O0[v] = 0.f; st.O1[v] = 0.f; }
            st.m = -1e30f; st.l = 0.f;
        }
      }
    }
    bf16_t* o = p.MIX + mrow * D_ + 512 + g * 256 + r * 64 + 4 * h;
#pragma unroll
    for (int dt = 0; dt < 2; ++dt)
#pragma unroll
        for (int qd = 0; qd < 4; ++qd) {
            const f32x16_t& A = dt ? A1 : A0; uint2 wv; wv.x = cvt_pk_bf16(A[4 * qd], A[4 * qd + 1]); wv.y = cvt_pk_bf16(A[4 * qd + 2], A[4 * qd + 3]);
            *(uint2*)(o + 32 * dt + 8 * qd) = wv;
        }
}

constexpr int CS_G = 17408, CS_BUF = 2 * CS_G, CS_B = 2 * CS_BUF, CS_BB = 16384;
DEV void cmp_sample_item(const Prm& p, int l, int req, int type, unsigned char* lds) {
    const int tid = opaque_tid(), w = tid >> 6, lane = tid & 63, c = lane & 31, h = lane >> 5, g = w >> 2, ib = w & 3;
    const int cidx = tid & 15, rsub = tid >> 4, lg = cidx >> 3, lch = cidx & 7;
    __syncthreads();
    if (tid < 64) { const int bufi = tid >> 5, gg = (tid >> 4) & 1, ch = tid & 7; if ((tid & 15) < 8) *(uint4*)(lds + bufi * CS_BUF + gg * CS_G + off64(128, ch)) = make_uint4(0u, 0u, 0u, 0u); }
    const float* src[4]; unsigned dst[4];
#pragma unroll
    for (int ps = 0; ps < 4; ++ps) { const int i = ps * 32 + rsub; const int page = p.page_table[req * NPG + (i >> 3)];
        src[ps] = p.cache_cmp + (((((size_t)l * NPHYS + page) * 128 + (i & 7) * 16) * 2 + type) * 2) * 64 + cidx * 8; dst[ps] = lg * CS_G + off64(i, lch); }
    const bf16_t* wsrc = p.Wct + (size_t)(l * 2 + type) * 128 * 1024 + (size_t)(tid >> 2) * 1024 + (tid & 3) * 16;
    const unsigned wdst0 = CS_B + off64(tid >> 2, (tid & 3) * 2), wdst1 = CS_B + off64(tid >> 2, (tid & 3) * 2 + 1);
    float4 ra[4], rb[4], rc[4], rd[4]; uint4 wq0, wq1, wq2, wq3;
#pragma unroll
    for (int ps = 0; ps < 4; ++ps) { rc[ps] = *(const float4*)(src[ps]); rd[ps] = *(const float4*)(src[ps] + 4); }
    wq2 = *(const uint4*)(wsrc); wq3 = *(const uint4*)(wsrc + 8);
#pragma unroll
    for (int ps = 0; ps < 4; ++ps) { ra[ps] = *(const float4*)(src[ps] + 256); rb[ps] = *(const float4*)(src[ps] + 256 + 4); }
    wq0 = *(const uint4*)(wsrc + 64); wq1 = *(const uint4*)(wsrc + 64 + 8);
#pragma unroll
    for (int ps = 0; ps < 4; ++ps) { uint4 wv; wv.x = cvt_pk_bf16(rc[ps].x, rc[ps].y); wv.y = cvt_pk_bf16(rc[ps].z, rc[ps].w); wv.z = cvt_pk_bf16(rd[ps].x, rd[ps].y); wv.w = cvt_pk_bf16(rd[ps].z, rd[ps].w); *(uint4*)(lds + dst[ps]) = wv; }
    *(uint4*)(lds + wdst0) = wq2; *(uint4*)(lds + wdst1) = wq3;
    __syncthreads();
    f32x16_t acc0, acc1;
#pragma unroll
    for (int v = 0; v < 16; ++v) { acc0[v] = 0.f; acc1[v] = 0.f; }
    const unsigned alo = g * CS_G + off64(32 * ib + c, h), ahi = g * CS_G + off64(32 * ib + c + 1, h);
    const unsigned bo = CS_B + off64(c, h);
#define CS_ISSUE(RA, RB, W0, W1, st) do { _Pragma("unroll") for (int ps = 0; ps < 4; ++ps) { RA[ps] = *(const float4*)(src[ps] + (size_t)(st) * 256); RB[ps] = *(const float4*)(src[ps] + (size_t)(st) * 256 + 4); } \
        W0 = *(const uint4*)(wsrc + (st) * 64); W1 = *(const uint4*)(wsrc + (st) * 64 + 8); } while (0)
#define CS_COMMIT(RA, RB, W0, W1, st) do { unsigned char* nb = lds + ((st) & 1) * CS_BUF; _Pragma("unroll") for (int ps = 0; ps < 4; ++ps) { uint4 wv; wv.x = cvt_pk_bf16(RA[ps].x, RA[ps].y); wv.y = cvt_pk_bf16(RA[ps].z, RA[ps].w); \
        wv.z = cvt_pk_bf16(RB[ps].x, RB[ps].y); wv.w = cvt_pk_bf16(RB[ps].z, RB[ps].w); *(uint4*)(nb + dst[ps]) = wv; } \
        *(uint4*)(lds + ((st) & 1) * CS_BB + wdst0) = W0; *(uint4*)(lds + ((st) & 1) * CS_BB + wdst1) = W1; } while (0)
#define CS_COMPUTE(st) do { const unsigned char* ab = lds + ((st) & 1) * CS_BUF; const unsigned char* bb = lds + ((st) & 1) * CS_BB; _Pragma("unroll") for (int ks = 0; ks < 4; ++ks) { \
        const unsigned sw = (ks & 1) ? 32u : 0u, ad = 512u * (ks >> 1); \
        const bf16x8_t fa = *(const bf16x8_t*)(ab + (alo ^ sw) + ad), fb = *(const bf16x8_t*)(ab + (ahi ^ sw) + ad); \
        const unsigned char* bk = bb + (bo ^ sw) + ad; \
        const bf16x8_t b00 = *(const bf16x8_t*)(bk), b01 = *(const bf16x8_t*)(bk + 4096), b10 = *(const bf16x8_t*)(bk + 8192), b11 = *(const bf16x8_t*)(bk + 12288); \
        acc0 = __builtin_amdgcn_mfma_f32_32x32x16_bf16(fa, b00, acc0, 0, 0, 0); acc1 = __builtin_amdgcn_mfma_f32_32x32x16_bf16(fa, b01, acc1, 0, 0, 0); \
        acc0 = __builtin_amdgcn_mfma_f32_32x32x16_bf16(fb, b10, acc0, 0, 0, 0); acc1 = __builtin_amdgcn_mfma_f32_32x32x16_bf16(fb, b11, acc1, 0, 0, 0); } } while (0)
#pragma unroll 1
    for (int ll = 0; ll < 16; ll += 2) {
        if (ll + 2 < 16) CS_ISSUE(rc, rd, wq2, wq3, ll + 2);
        CS_COMPUTE(ll);
        CS_COMMIT(ra, rb, wq0, wq1, ll + 1);
        __syncthreads();
        if (ll + 3 < 16) CS_ISSUE(ra, rb, wq0, wq1, ll + 3);
        CS_COMPUTE(ll + 1);
        if (ll + 2 < 16) CS_COMMIT(rc, rd, wq2, wq3, ll + 2);
        __syncthreads();
    }
#undef CS_ISSUE
#undef CS_COMMIT
#undef CS_COMPUTE
    bf16_t* o = p.KCS + (((((size_t)l * NREQ + req) * 2 + g) * 2 + type) * 128) * 64;
    const float cb0 = cb_val(p.cb, (l * 2 + type) * 64 + c), cb1 = cb_val(p.cb, (l * 2 + type) * 64 + 32 + c);
#pragma unroll
    for (int v = 0; v < 16; ++v) {
        const int i = 32 * ib + (v & 3) + 8 * (v >> 2) + 4 * h;
        o[(size_t)i * 64 + c] = i == 127 ? (bf16_t)0 : f2bf(acc0[v] + cb0); o[(size_t)i * 64 + 32 + c] = i == 127 ? (bf16_t)0 : f2bf(acc1[v] + cb1);
    }
}
DEV void cmp_sample_fast(const Prm& p, int l, unsigned char* lds) {
    for (int it = blockIdx.x; it < NREQ * 2; it += gridDim.x) cmp_sample_item(p, l, it >> 1, it & 1, lds);
}

constexpr int AS_BT = 131072, AS_PA = AS_BT + 2048, AS_SELM = AS_PA + 4096, AS_PARK = AS_SELM + 64, AS_PARK2 = AS_PARK + 8 * 2048, AS_LDS = AS_PARK2 + 8 * 256;
static_assert(AS_LDS <= LDS_BYTES - 32, "sample attention LDS map");
template <int NH = 2, class RowFn, class DstFn> DEV void as_load_f32(unsigned char* kt, unsigned char* vt, int lane, RowFn rowp, DstFn dstp) {
    const int rsub = lane >> 4, li = lane & 15;
    constexpr int NI = 16 / NH;
#pragma unroll 1
    for (int hf = 0; hf < NH; ++hf) {
        float4 kx[NI], vx[NI];
#pragma unroll
        for (int it = 0; it < NI; ++it) { const float* rp = rowp(32 * hf + 4 * it + rsub);
            if (rp) { kx[it] = *(const float4*)(rp + li * 4); vx[it] = *(const float4*)(rp + 128 + li * 4); } else { kx[it] = make_float4(0.f, 0.f, 0.f, 0.f); vx[it] = kx[it]; } }
#pragma unroll
        for (int it = 0; it < NI; ++it) { const unsigned o = off64(32 * hf + 4 * it + rsub, li >> 1) + 8 * (li & 1);
            uint2 a, b; a.x = cvt_pk_bf16(kx[it].x, kx[it].y); a.y = cvt_pk_bf16(kx[it].z, kx[it].w); b.x = cvt_pk_bf16(vx[it].x, vx[it].y); b.y = cvt_pk_bf16(vx[it].z, vx[it].w);
            *(uint2*)(kt + o) = a; *(uint2*)(vt + o) = b;
            float* dp = dstp(32 * hf + 4 * it + rsub); if (dp) { *(float4*)(dp + li * 4) = kx[it]; *(float4*)(dp + 128 + li * 4) = vx[it]; } }
    }
}
DEV void as_load_bf16(unsigned char* t, const bf16_t* src, int lane) {
    uint4 v[8];
#pragma unroll
    for (int it = 0; it < 8; ++it) v[it] = *(const uint4*)(src + (size_t)(8 * it + (lane >> 3)) * 64 + (lane & 7) * 8);
#pragma unroll
    for (int it = 0; it < 8; ++it) *(uint4*)(t + off64(8 * it + (lane >> 3), lane & 7)) = v[it];
}
template <int MODE, bool FM> DEV void attn_tile_m(const unsigned char* kb, unsigned ka0, unsigned vbase, unsigned va_rel, const bf16x8_t (&qf)[4], AttnState& st, int dl, float lb, const float* bt_r) {
    constexpr bool MASKED = FM || MODE >= AM_DIAG;
    f32x16_t S0, S1;
    attn_qk(kb, ka0, qf, S0, S1);
    attn_bias<MODE>(S0, S1, dl, lb, bt_r);
    const float tm = attn_tilemax<MASKED>(S0, S1);
    const float mn = fmaxf(st.m, tm), alpha = __builtin_amdgcn_exp2f(st.m - mn);
    st.m = mn;
    const float ps = attn_exp<MASKED>(S0, S1, mn, 1.f);
    st.l = st.l * alpha + ps;
#pragma unroll
    for (int v = 0; v < 16; ++v) { st.O0[v] *= alpha; st.O1[v] *= alpha; }
    attn_pv(vbase, va_rel, S0, S1, st.O0, st.O1);
}
#define AS_WAVE_SYNC() do { asm volatile("s_waitcnt lgkmcnt(0)" ::: "memory"); __builtin_amdgcn_wave_barrier(); } while (0)
DEV void attn_sample_item(const Prm& p, int l, int req, int g, unsigned char* lds) {
    const int tid = opaque_tid(), w = __builtin_amdgcn_readfirstlane(tid >> 6), lane = tid & 63, c = lane & 31, h = lane >> 5, qi = (c >> 2) & 3, r = c & 3; const bool real = c < 16;
    float* BT = (float*)(lds + AS_BT); float* PA = (float*)(lds + AS_PA); float* PB = PA + 512; unsigned* SELM = (unsigned*)(lds + AS_SELM);
    unsigned char* kt = lds + w * 16384; unsigned char* vt = kt + 8192;
    __syncthreads();
    BT[tid] = p.BIASL2[g * 512 + tid]; PA[tid] = 0.f; PA[512 + tid] = 0.f;
    const int tq = PAST_ + qi; const size_t mrow = (size_t)MP + req * 4 + qi;
    bf16x8_t qf[4];
#pragma unroll
    for (int ks = 0; ks < 4; ++ks) { qf[ks] = *(const bf16x8_t*)(p.Q + mrow * 512 + g * 256 + r * 64 + ks * 16 + 8 * h); if (!real) qf[ks] = (bf16x8_t){0, 0, 0, 0, 0, 0, 0, 0}; }
    const float gc = p.GATES[mrow * 24 + g * 4 + r], gs = p.GATES[mrow * 24 + 8 + g * 4 + r], gw = p.GATES[mrow * 24 + 16 + g * 4 + r];
    const float* bt_r = BT + r * 128;
    const unsigned ka0 = 1024u * ((unsigned)c >> 3) + 64u * (c & 7) + 16u * ((unsigned)h ^ (((unsigned)c >> 2) & 3u));
    const unsigned blk = (lane >> 4) & 1, q4 = (lane & 15) >> 2, pp = lane & 3;
    const unsigned va_rel = 64u * (4u * h + q4) + 8u * (pp & 1) + 16u * ((2u * blk + (pp >> 1)) ^ (unsigned)h);
    const unsigned vbase = (unsigned)(size_t)(LAS unsigned char*)vt;
    __syncthreads();
    const float b31 = bt_r[127];
    AttnState sw, ss;
#pragma unroll
    for (int v = 0; v < 16; ++v) { sw.O0[v] = 0.f; sw.O1[v] = 0.f; ss.O0[v] = 0.f; ss.O1[v] = 0.f; }
    sw.m = -1e30f; sw.l = 0.f; ss.m = -1e30f; ss.l = 0.f;
    const size_t lr = (size_t)l * NREQ + req;
    const bf16_t* kc = p.KCS + ((lr * 2 + g) * 2 + 0) * 128 * 64; const bf16_t* vc = kc + 128 * 64;
    if (w == 0) {
        uint4 k0[8], k1[8], v0[8], v1[8];
        const int lr8 = lane >> 3, lc8 = (lane & 7) * 8;
#pragma unroll
        for (int it = 0; it < 8; ++it) { const size_t o = (size_t)(8 * it + lr8) * 64 + lc8; k0[it] = *(const uint4*)(kc + o); k1[it] = *(const uint4*)(kc + 4096 + o); }
#pragma unroll
        for (int it = 0; it < 8; ++it) { const unsigned o = off64(8 * it + lr8, lane & 7); *(uint4*)(kt + o) = k0[it]; *(uint4*)(vt + o) = k1[it]; }
        AS_WAVE_SYNC();
        f32x16_t A0, A1, B0, B1;
        attn_qk(kt, ka0, qf, A0, A1); attn_qk(vt, ka0, qf, B0, B1);
        attn_bias<AM_CMP>(A0, A1, tq - 31 - 64 * h, 0.f, bt_r); attn_bias<AM_CMP>(B0, B1, tq - 31 - 1024 - 64 * h, 0.f, bt_r);
        const float mC = fmaxf(attn_tilemax<true>(A0, A1), attn_tilemax<true>(B0, B1));
        float lC = attn_exp<true>(A0, A1, mC, 1.f); lC += attn_exp<true>(B0, B1, mC, 1.f);
        const float lt = lC + __shfl_xor(lC, 32), invC = lt > 0.f ? 1.f / lt : 0.f;
#pragma unroll
        for (int v = 0; v < 16; ++v) { A0[v] *= invC; A1[v] *= invC; B0[v] *= invC; B1[v] *= invC; }
        AS_WAVE_SYNC();
#pragma unroll
        for (int it = 0; it < 8; ++it) { const size_t o = (size_t)(8 * it + lr8) * 64 + lc8; v0[it] = *(const uint4*)(vc + o); v1[it] = *(const uint4*)(vc + 4096 + o); }
#pragma unroll
        for (int it = 0; it < 8; ++it) { const unsigned o = off64(8 * it + lr8, lane & 7); *(uint4*)(kt + o) = v0[it]; *(uint4*)(vt + o) = v1[it]; }
#pragma unroll
        for (int ct = 0; ct < 2; ++ct)
#pragma unroll
            for (int u = 0; u < 2; ++u)
#pragma unroll
                for (int qd = 0; qd < 4; ++qd) {
                    const f32x16_t& P = ct ? (u ? B1 : B0) : (u ? A1 : A0);
                    float qs = (P[4 * qd] + P[4 * qd + 1]) + (P[4 * qd + 2] + P[4 * qd + 3]), ls = P[4 * qd + 3];
                    qs += __shfl_xor(qs, 1); qs += __shfl_xor(qs, 2); ls += __shfl_xor(ls, 1); ls += __shfl_xor(ls, 2);
                    const int jq = 16 * ct + 8 * u + 2 * qd + h;
                    if (r == 0 && real) { PA[qi * 64 + jq] = qs; PB[qi * 64 + jq + 1] = ls; }
                }
        AS_WAVE_SYNC();
        attn_pv((unsigned)(size_t)(LAS unsigned char*)kt, va_rel, A0, A1, sw.O0, sw.O1);
        attn_pv(vbase, va_rel, B0, B1, sw.O0, sw.O1);
        AS_WAVE_SYNC();
    } else {
        for (int t = 0; t < 2; ++t) {
            const int wt = w - 1 + 7 * t; if (wt >= 9) break;
            as_load_f32<1>(kt, vt, lane, [&](int k) -> const float* { const int idx = 64 * wt + k;
                if (idx < 512) return p.cache_win + (lr * 512 + idx) * 256 + g * 64;
                if (idx < 516) return p.out + O_WINS + (lr * 512 + 508 + (idx - 512)) * 256 + g * 64;
                return nullptr; },
                [&](int k) -> float* { const int idx = 64 * wt + k; return (idx >= 4 && idx < 512) ? p.out + O_WINS + (lr * 512 + (idx - 4)) * 256 + g * 64 : nullptr; });
            AS_WAVE_SYNC();
            const int dl = 512 + qi - 64 * wt - 4 * h;
            if (wt == 0) attn_tile_m<AM_WINFIRST, false>(kt, ka0, vbase, va_rel, qf, sw, dl, b31, bt_r);
            else if (wt == 8) attn_tile_m<AM_DIAG, false>(kt, ka0, vbase, va_rel, qf, sw, dl, 0.f, bt_r);
            else if (wt >= 6) attn_tile_m<AM_NEAR, false>(kt, ka0, vbase, va_rel, qf, sw, dl, 0.f, bt_r);
            else attn_tile_m<AM_FAR, false>(kt, ka0, vbase, va_rel, qf, sw, dl, b31, bt_r);
            AS_WAVE_SYNC();
        }
    }
    if (real) {
        unsigned* park = (unsigned*)(lds + AS_PARK + w * 2048) + (h * 16 + (c & 15)) * 16;
        *(float2*)(lds + AS_PARK2 + w * 256 + (h * 16 + (c & 15)) * 8) = make_float2(sw.m, sw.l);
        uint4 q0, q1, q2, q3;
        q0.x = cvt_pk_bf16(sw.O0[0], sw.O0[1]); q0.y = cvt_pk_bf16(sw.O0[2], sw.O0[3]); q0.z = cvt_pk_bf16(sw.O0[4], sw.O0[5]); q0.w = cvt_pk_bf16(sw.O0[6], sw.O0[7]);
        q1.x = cvt_pk_bf16(sw.O0[8], sw.O0[9]); q1.y = cvt_pk_bf16(sw.O0[10], sw.O0[11]); q1.z = cvt_pk_bf16(sw.O0[12], sw.O0[13]); q1.w = cvt_pk_bf16(sw.O0[14], sw.O0[15]);
        q2.x = cvt_pk_bf16(sw.O1[0], sw.O1[1]); q2.y = cvt_pk_bf16(sw.O1[2], sw.O1[3]); q2.z = cvt_pk_bf16(sw.O1[4], sw.O1[5]); q2.w = cvt_pk_bf16(sw.O1[6], sw.O1[7]);
        q3.x = cvt_pk_bf16(sw.O1[8], sw.O1[9]); q3.y = cvt_pk_bf16(sw.O1[10], sw.O1[11]); q3.z = cvt_pk_bf16(sw.O1[12], sw.O1[13]); q3.w = cvt_pk_bf16(sw.O1[14], sw.O1[15]);
        *(uint4*)(park) = q0; *(uint4*)(park + 4) = q1; *(uint4*)(park + 8) = q2; *(uint4*)(park + 12) = q3;
    }
#pragma unroll
    for (int v = 0; v < 16; ++v) { sw.O0[v] = 0.f; sw.O1[v] = 0.f; }
    sw.m = 0.f; sw.l = 0.f;
    if (w == 0) {
        for (int q = 0; q < 4; ++q) {
            const bool cand = lane >= 1 && lane <= 30;
            const float sc = cand ? PA[q * 64 + lane] + PB[q * 64 + lane] : -1.f;
            int cnt = 0;
            for (int i = 1; i <= 30; ++i) { const float si = __builtin_bit_cast(float, __builtin_amdgcn_readlane(__builtin_bit_cast(int, sc), i)); cnt += (si > sc || (si == sc && i < lane)) ? 1 : 0; }
            const unsigned long long bal = __ballot(cand && cnt < 13) | 1ull | (1ull << 31) | (1ull << 32);
            if (lane == 0) { SELM[q * 2] = (unsigned)bal; SELM[q * 2 + 1] = (unsigned)(bal >> 32); }
        }
    }
    __syncthreads();
    unsigned long long um = 0ull;
#pragma unroll
    for (int q = 0; q < 4; ++q) um |= (unsigned long long)SELM[q * 2] | ((unsigned long long)SELM[q * 2 + 1] << 32);
    um = ((unsigned long long)__builtin_amdgcn_readfirstlane((unsigned)(um >> 32)) << 32) | (unsigned)__builtin_amdgcn_readfirstlane((unsigned)um);
    while (um) {
        int j = -1;
        for (int k = 0; k < 8 && um; ++k) { const int jj = __ffsll((long long)um) - 1; um &= um - 1ull; if (k == w) j = jj; }
        if (j >= 0) {
            const int page = j < 32 ? p.page_table[req * NPG + (j >> 1)] : 0;
            const float* sbase = j < 32 ? p.cache_slc + ((((size_t)l * NPHYS + page) * 128 + (j & 1) * 64) * 4 + g) * 64 : p.out + O_SLCS + (lr * 4) * 256 + g * 64;
            const int nrow = j < 32 ? 64 : 4;
            as_load_f32<1>(kt, vt, lane, [&](int k) -> const float* { return k < nrow ? sbase + (size_t)k * 256 : nullptr; }, [](int) -> float* { return nullptr; });
        }
        AS_WAVE_SYNC();
        if (j >= 0) {
            const bool sel = (SELM[qi * 2 + (j >> 5)] >> (j & 31)) & 1u;
            const int dl = tq - 64 * j - 4 * h;
            if (j == 32) attn_tile_m<AM_DIAG, true>(kt, ka0, vbase, va_rel, qf, ss, dl, 0.f, bt_r);
            else if (j >= 30) attn_tile_m<AM_NEAR, true>(kt, ka0, vbase, va_rel, qf, ss, dl, sel ? 0.f : -1e30f, bt_r);
            else attn_tile_m<AM_FAR, true>(kt, ka0, vbase, va_rel, qf, ss, dl, sel ? b31 : -1e30f, bt_r);
        }
        AS_WAVE_SYNC();
    }
    if (real) {
        const unsigned* park = (const unsigned*)(lds + AS_PARK + w * 2048) + (h * 16 + (c & 15)) * 16;
        const float2 ml2 = *(const float2*)(lds + AS_PARK2 + w * 256 + (h * 16 + (c & 15)) * 8); sw.m = ml2.x; sw.l = ml2.y;
        const uint4 q0 = *(const uint4*)(park), q1 = *(const uint4*)(park + 4), q2 = *(const uint4*)(park + 8), q3 = *(const uint4*)(park + 12);
        const unsigned u0[8] = {q0.x, q0.y, q0.z, q0.w, q1.x, q1.y, q1.z, q1.w}, u1[8] = {q2.x, q2.y, q2.z, q2.w, q3.x, q3.y, q3.z, q3.w};
#pragma unroll
        for (int v = 0; v < 8; ++v) { sw.O0[2 * v] = __uint_as_float(u0[v] << 16); sw.O0[2 * v + 1] = __uint_as_float(u0[v] & 0xffff0000u); sw.O1[2 * v] = __uint_as_float(u1[v] << 16); sw.O1[2 * v + 1] = __uint_as_float(u1[v] & 0xffff0000u); }
    }
    float* MO = (float*)(lds + w * 16384);
    float* ML = (float*)(lds + w * 16384 + 8192);
    {
        const float lts = ss.l + __shfl_xor(ss.l, 32), ltw = sw.l + __shfl_xor(sw.l, 32);
        if (real) {
#pragma unroll
            for (int dt = 0; dt < 2; ++dt)
#pragma unroll
                for (int qd = 0; qd < 4; ++qd) {
                    const f32x16_t& A = dt ? ss.O1 : ss.O0; const f32x16_t& B = dt ? sw.O1 : sw.O0; const int d = 32 * dt + 8 * qd + 4 * h;
                    *(float4*)(MO + c * 64 + d) = make_float4(A[4 * qd], A[4 * qd + 1], A[4 * qd + 2], A[4 * qd + 3]);
                    *(float4*)(MO + 1024 + c * 64 + d) = make_float4(B[4 * qd], B[4 * qd + 1], B[4 * qd + 2], B[4 * qd + 3]);
                }
            if (h == 0) { ML[c * 2] = ss.m; ML[c * 2 + 1] = lts; ML[32 + c * 2] = sw.m; ML[32 + c * 2 + 1] = ltw; }
        }
    }
    __syncthreads();
    for (int o = tid; o < 1024; o += NTHR) {
        const int cc = o >> 6, d = o & 63, q = cc >> 2, rr = cc & 3; const size_t mr = (size_t)MP + req * 4 + q;
        float res = p.GATES[mr * 24 + g * 4 + rr] * ((const float*)(lds + 0 * 16384))[1024 + cc * 64 + d];
#pragma unroll
        for (int br = 0; br < 2; ++br) {
            float M = -1e30f;
            for (int ww = (br == 1 ? 1 : 0); ww < 8; ++ww) M = fmaxf(M, ((const float*)(lds + ww * 16384 + 8192))[br * 32 + cc * 2]);
            float num = 0.f, den = 0.f;
            for (int ww = (br == 1 ? 1 : 0); ww < 8; ++ww) { const float* ml = (const float*)(lds + ww * 16384 + 8192) + br * 32 + cc * 2; const float f = __builtin_amdgcn_exp2f(ml[0] - M);
                num += f * ((const float*)(lds + ww * 16384))[br * 1024 + cc * 64 + d]; den += f * ml[1]; }
            res += p.GATES[mr * 24 + (br == 0 ? 8 : 16) + g * 4 + rr] * (den > 0.f ? num / den : 0.f);
        }
        p.MIX[mr * D_ + 512 + g * 256 + rr * 64 + d] = f2bf(res);
    }
}

DEV void cmp_prompt_fast(const Prm& p, int l, float* sm) {
    const int tid = opaque_tid(), w = __builtin_amdgcn_readfirstlane(tid >> 6), lane = tid & 63, c = lane & 31, h = lane >> 5;
    for (int wi = (int)blockIdx.x - ((int)gridDim.x >= 256 ? 128 : 0); wi < 128; wi += gridDim.x) {
        if (wi < 0) continue;
        const int ib = wi & 7, type = (wi >> 3) & 1, g = (wi >> 4) & 1, b = wi >> 5;
        const bf16_t* kv = p.KVB + ((((size_t)(0 * 2 + type) * NB_ + b) * 2 + g) * T_) * 64 + 8 * h;
        const bf16_t* wb = p.Wct + (size_t)(l * 2 + type) * 128 * 1024 + (size_t)c * 1024 + 8 * h;
        f32x16_t acc0, acc1;
#pragma unroll
        for (int v = 0; v < 16; ++v) { acc0[v] = 0.f; acc1[v] = 0.f; }
        const int i0 = 32 * ib + c;
#pragma unroll
        for (int l2 = 0; l2 < 2; ++l2) {
            const int ll = 2 * w + l2; const int tlo = 16 * i0 + ll, thi = min(tlo + 16, T_ - 1);
            bf16x8_t fa[4], fb[4], b00[4], b01[4], b10[4], b11[4];
#pragma unroll
            for (int ks = 0; ks < 4; ++ks) {
                fa[ks] = *(const bf16x8_t*)(kv + (size_t)tlo * 64 + ks * 16); fb[ks] = *(const bf16x8_t*)(kv + (size_t)thi * 64 + ks * 16);
                const bf16_t* wk = wb + ll * 64 + ks * 16;
                b00[ks] = *(const bf16x8_t*)(wk); b01[ks] = *(const bf16x8_t*)(wk + 32 * 1024); b10[ks] = *(const bf16x8_t*)(wk + 64 * 1024); b11[ks] = *(const bf16x8_t*)(wk + 96 * 1024);
            }
#pragma unroll
            for (int ks = 0; ks < 4; ++ks) {
                acc0 = __builtin_amdgcn_mfma_f32_32x32x16_bf16(fa[ks], b00[ks], acc0, 0, 0, 0);
                acc1 = __builtin_amdgcn_mfma_f32_32x32x16_bf16(fa[ks], b01[ks], acc1, 0, 0, 0);
                acc0 = __builtin_amdgcn_mfma_f32_32x32x16_bf16(fb[ks], b10[ks], acc0, 0, 0, 0);
                acc1 = __builtin_amdgcn_mfma_f32_32x32x16_bf16(fb[ks], b11[ks], acc1, 0, 0, 0);
            }
        }
        __syncthreads();
        float* part = sm + w * 2048;
#pragma unroll
        for (int v = 0; v < 16; ++v) { const int i = (v & 3) + 8 * (v >> 2) + 4 * h; part[i * 64 + c] = acc0[v]; part[i * 64 + 32 + c] = acc1[v]; }
        __syncthreads();
        bf16_t* o = p.KC + ((((size_t)b * 2 + g) * 2 + type) * 256 + 32 * ib) * 64;
#pragma unroll
        for (int q = 0; q < 4; ++q) { const int idx = tid + NTHR * q, i = idx >> 6, e = idx & 63; float a = cb_val(p.cb, (l * 2 + type) * 64 + e);
#pragma unroll
            for (int ww = 0; ww < 8; ++ww) a += sm[ww * 2048 + idx];
            o[idx] = (32 * ib + i) == 255 ? (bf16_t)0 : f2bf(a); }
    }
}
DEV void phase_mix1(const Prm& p, int l, float* sm) {
    cmp_prompt_fast(p, l, sm);
    float4 vc[8], vp[6];
    if ((int)blockIdx.x < 512 + NREQ) convpool_issue(p, l, (int)blockIdx.x, vc, vp);
    for (int item = blockIdx.x; item < 512 + NREQ; item += gridDim.x) { const int nx = item + (int)gridDim.x; convpool_item(p, l, item, sm, vc, vp, nx < 512 + NREQ ? nx : -1); }
}
DEV void phase_attn(const Prm& p, int l, float* sm) {
    const int spos = (int)(blockIdx.x % 3u);
    for (int k = blockIdx.x; k < 256; k += gridDim.x) {
        const int bg = k >> 5, pi = k & 31;
#pragma unroll 1
        for (int s = 0; s < 3; ++s) {
            const int what = s == spos ? 2 : (s < spos ? s : s - 1);
            if (what == 2) attn_sample_item(p, l, k >> 1, k & 1, (unsigned char*)sm);
            else attn_prompt_unit(p, l, bg >> 1, bg & 1, what == 0 ? 63 - pi : pi, (unsigned char*)sm);
        }
    }
}
DEV void phase_final(const Prm& p) {
    const int tid = opaque_tid(), wv = tid >> 6, lane = tid & 63;
    float4 g[4];
#pragma unroll
    for (int i = 0; i < 4; ++i) g[i] = *(const float4*)(p.final_norm + i * 256 + lane * 4);
    for (int m0 = (blockIdx.x * 8 + wv) * 2; m0 < MP; m0 += gridDim.x * 16) {
        uint2 v[2][4]; float rs[2];
#pragma unroll
        for (int rr = 0; rr < 2; ++rr) { rs[rr] = row_rs(p.SSb, m0 + rr);
#pragma unroll
            for (int i = 0; i < 4; ++i) v[rr][i] = *(const uint2*)(p.XB + (size_t)(m0 + rr) * D_ + i * 256 + lane * 4); }
#pragma unroll
        for (int rr = 0; rr < 2; ++rr)
#pragma unroll
            for (int i = 0; i < 4; ++i) { const uint2 a = v[rr][i]; const float r = rs[rr];
                const float x0 = __uint_as_float(a.x << 16), x1 = __uint_as_float(a.x & 0xffff0000u), x2 = __uint_as_float(a.y << 16), x3 = __uint_as_float(a.y & 0xffff0000u);
                *(float4*)(p.out + (size_t)(m0 + rr) * D_ + i * 256 + lane * 4) = make_float4(x0 * r * g[i].x, x1 * r * g[i].y, x2 * r * g[i].z, x3 * r * g[i].w); }
    }
}

enum { PH_PREP = 0, PH_IN, PH_MIX1, PH_ATTN, PH_OUT, PH_GU, PH_DOWN, PH_FINAL, PH_DOWNR };
template <int PH> DEV void run_phase(const Prm& p, int l, unsigned char* lds) {
    float* sm = (float*)lds;
    if constexpr (PH == PH_PREP) phase_prep(p, sm);
    if constexpr (PH == PH_IN) { EpiIn e{p, l, nullptr};
        const bool cf = l == 0 && (blockIdx.x & 1);
        if (cf) cmp_sample_fast(p, 0, lds);
        gemm_fast(lds, p.XB, p.Wt_in + (size_t)l * NIN * D_, M_, NIN, D_, e);
        if (l == 0 && !cf) cmp_sample_fast(p, 0, lds);
        if (l == 0) { const int nfull = (M_ / 256) * (NIN / 256) % (int)gridDim.x; if ((int)blockIdx.x >= nfull) prep_weights(p, sm, 576 / 4, 2944 / 4, (int)blockIdx.x - nfull, (int)gridDim.x - nfull); } }
    if constexpr (PH == PH_MIX1) phase_mix1(p, l, sm);
    if constexpr (PH == PH_ATTN) phase_attn(p, l, sm);
    if constexpr (PH == PH_OUT) { EpiRes e{p, 1, p.SSa, true}; gemm_fast(lds, p.MIX, p.Wt_out + (size_t)l * D_ * D_, M_, D_, D_, e);
        if (l == 0 && blockIdx.x >= 8) prep_weights(p, sm, 2944 / 4, 2 * 2944 / 4, (int)blockIdx.x - 8, (int)gridDim.x - 8); }
    if constexpr (PH == PH_GU) { EpiGU e{p, nullptr}; gemm_fast(lds, p.XB, p.Wt_gu + (size_t)l * NGU * D_, M_, NGU, D_, e); }
    if constexpr (PH == PH_DOWN) { EpiRes e{p, 2, p.SSb, l + 1 < NL_}; const bf16_t* W = p.Wt_down + (size_t)l * D_ * DFF;
        const bool cf = l == 0 && (blockIdx.x & 1);
        if (cf) cmp_sample_fast(p, 1, lds);
        gemm_fast(lds, p.ACT, W, MP, D_, DFF, e);
        gemm_split(lds, p.ACT, W, D_, DFF, 256, p.SLAB);
        if (l == 0 && !cf) cmp_sample_fast(p, 1, lds); }
    if constexpr (PH == PH_FINAL) phase_final(p);
    if constexpr (PH == PH_DOWNR) { if (l + 1 < NL_) { EpiRes e{p, 2, p.SSb, true}; gemm_reduce(p.SLAB, D_, DFF / 256, e); } else gemm_reduce_final(p, p.SLAB, DFF / 256); }
}
template <int PH> __global__ void __launch_bounds__(NTHR, 2) k_phase(Prm p, int l) {
    extern __shared__ __attribute__((aligned(16))) unsigned char lds[];
    run_phase<PH>(p, l, lds);
}
__global__ void __launch_bounds__(NTHR, 2) k_mega(Prm p) {
    extern __shared__ __attribute__((aligned(16))) unsigned char lds[];
    if (threadIdx.x == 0) *(uint4*)(lds + LDS_BYTES - 16) = make_uint4(0u, 0u, 0u, 0u);
    __syncthreads();
    const XcdBarrier bar = xcd_barrier_post(p.bar, (volatile LAS unsigned*)(lds + LDS_BYTES - 16));
    run_phase<PH_PREP>(p, 0, lds); xcd_barrier(bar);
#define LAYER(l) do { run_phase<PH_IN>(p, l, lds); xcd_barrier(bar); run_phase<PH_MIX1>(p, l, lds); xcd_barrier(bar); run_phase<PH_ATTN>(p, l, lds); xcd_barrier(bar); \
        run_phase<PH_OUT>(p, l, lds); xcd_barrier(bar); run_phase<PH_GU>(p, l, lds); xcd_barrier(bar); run_phase<PH_DOWN>(p, l, lds); xcd_barrier(bar); run_phase<PH_DOWNR>(p, l, lds); } while (0)
    LAYER(0); xcd_barrier(bar); LAYER(1);
#undef LAYER
    run_phase<PH_FINAL>(p, 0, lds);
}

constexpr bool ONE_LAUNCH = true;
static size_t carve(size_t& off, size_t bytes) { const size_t o = off; off += (bytes + 255) & ~(size_t)255; return o; }
template <int PH> static void launch_phase(const Prm& p, int l, int grid, hipStream_t stream) {
    static bool attr = false;
    if (!attr) { (void)hipFuncSetAttribute((const void*)k_phase<PH>, hipFuncAttributeMaxDynamicSharedMemorySize, LDS_BYTES); attr = true; }
    hipLaunchKernelGGL(k_phase<PH>, dim3(grid), dim3(NTHR), LDS_BYTES, stream, p, l);
}
extern "C" void kernel_launch(void* const* d_in, const int* in_sizes, int n_in, void* d_out, int out_size, void* d_ws, size_t ws_size, hipStream_t stream) {
    Prm p{};
    p.x_prompt = (const float*)d_in[0]; p.x_sample = (const float*)d_in[1]; p.cache_cmp = (const float*)d_in[2]; p.cache_slc = (const float*)d_in[3]; p.cache_win = (const float*)d_in[4];
    p.state_conv = (const float*)d_in[5]; p.state_pool = (const float*)d_in[6]; p.page_table = (const int*)d_in[7]; p.rel_bias = (const float*)d_in[8]; p.norm1 = (const float*)d_in[9];
    p.w_in = (const float*)d_in[10]; p.conv_dw = (const float*)d_in[11]; p.conv_b = (const float*)d_in[12]; p.conv_ln_g = (const float*)d_in[13]; p.conv_ln_b = (const float*)d_in[14];
    p.pool_w = (const float*)d_in[15]; p.pool_scale = (const float*)d_in[16]; p.pe_k = (const float*)d_in[17]; p.wk = (const float*)d_in[18]; p.pe_v = (const float*)d_in[19]; p.wv = (const float*)d_in[20];
    p.w_out = (const float*)d_in[21]; p.norm2 = (const float*)d_in[22]; p.w_gu = (const float*)d_in[23]; p.w_down = (const float*)d_in[24]; p.final_norm = (const float*)d_in[25];
    p.out = (float*)d_out;
    char* ws = (char*)d_ws; size_t off = 0;
    p.bar = (unsigned*)(ws + carve(off, 16384));
    p.Wt_in = (bf16_t*)(ws + carve(off, (size_t)NL_ * NIN * D_ * 2)); p.Wt_out = (bf16_t*)(ws + carve(off, (size_t)NL_ * D_ * D_ * 2));
    p.Wt_gu = (bf16_t*)(ws + carve(off, (size_t)NL_ * NGU * D_ * 2)); p.Wt_down = (bf16_t*)(ws + carve(off, (size_t)NL_ * D_ * DFF * 2));
    p.Wct = (bf16_t*)(ws + carve(off, (size_t)2 * 2 * 128 * 1024 * 2)); p.cb = (float*)(ws + carve(off, 4 * 256 * 4));
    p.XB = (bf16_t*)(ws + carve(off, (size_t)M_ * D_ * 2)); p.SSa = (float*)(ws + carve(off, (size_t)M_ * 16 * 4)); p.SSb = (float*)(ws + carve(off, (size_t)M_ * 16 * 4));
    p.G = (float*)(ws + carve(off, (size_t)M_ * 256 * 4)); p.U = (float*)(ws + carve(off, (size_t)M_ * 256 * 4));
    p.Q = (bf16_t*)(ws + carve(off, (size_t)M_ * 512 * 2)); p.KVB = (bf16_t*)(ws + carve(off, (size_t)3 * 2 * NB_ * 2 * T_ * 64 * 2));
    p.GATES = (float*)(ws + carve(off, (size_t)M_ * 24 * 4));
    p.KC = (bf16_t*)(ws + carve(off, (size_t)NB_ * 2 * 2 * 256 * 64 * 2)); p.KCS = (bf16_t*)(ws + carve(off, (size_t)NL_ * NREQ * 2 * 2 * 128 * 64 * 2));
    p.MIX = (bf16_t*)(ws + carve(off, (size_t)M_ * D_ * 2)); p.X1 = (float*)(ws + carve(off, (size_t)M_ * D_ * 4)); p.X2 = (float*)(ws + carve(off, (size_t)M_ * D_ * 4));
    p.ACT = (bf16_t*)(ws + carve(off, (size_t)M_ * DFF * 2)); p.BIASL2 = (float*)(ws + carve(off, 1024 * 4)); p.SLAB = (float*)(ws + carve(off, (size_t)11 * MS * D_ * 4));
    if (off > ws_size || out_size != (int)O_END) { fprintf(stderr, "kernel_launch: bad sizes (ws %zu need %zu, out %d expect %zu)\n", ws_size, off, out_size, (size_t)O_END); return; }
    static int grid = 0;
    if (!grid) {
        int dev = 0, cus = 0, per_cu = 0;
        (void)hipGetDevice(&dev); (void)hipDeviceGetAttribute(&cus, hipDeviceAttributeMultiprocessorCount, dev);
        (void)hipFuncSetAttribute((const void*)k_mega, hipFuncAttributeMaxDynamicSharedMemorySize, LDS_BYTES);
        (void)hipOccupancyMaxActiveBlocksPerMultiprocessor(&per_cu, (const void*)k_mega, NTHR, LDS_BYTES);
        if (per_cu < 1) fprintf(stderr, "kernel_launch: occupancy query reports %d workgroups per CU\n", per_cu);
        grid = cus > 0 ? cus : 256;
    }
    (void)hipMemsetAsync(p.bar, 0, XCD_BAR_WORDS * sizeof(unsigned), stream);
    if (ONE_LAUNCH) {
        hipLaunchKernelGGL(k_mega, dim3(grid), dim3(NTHR), LDS_BYTES, stream, p);
    } else {
        launch_phase<PH_PREP>(p, 0, grid, stream);
        for (int l = 0; l < NL_; ++l) {
            launch_phase<PH_IN>(p, l, grid, stream); launch_phase<PH_MIX1>(p, l, grid, stream); launch_phase<PH_ATTN>(p, l, grid, stream);
            launch_phase<PH_OUT>(p, l, grid, stream); launch_phase<PH_GU>(p, l, grid, stream); launch_phase<PH_DOWN>(p, l, grid, stream); launch_phase<PH_DOWNR>(p, l, grid, stream);
        }
        launch_phase<PH_FINAL>(p, 0, grid, stream);
    }
}
```
